# Optimizing an MI355X kernel written in HIP

```python
import jax
import jax.numpy as jnp
from jax import lax
import numpy as np

D_MODEL = 1024
BATCH = 2
SEQ = 8192
DEPTH = 1

GRID_W = 64
CTX_LEN = 256
NA_HEAD_DIM = 64
N_NA_HEADS = (D_MODEL // 2) // NA_HEAD_DIM
NA_WIDTH = N_NA_HEADS * NA_HEAD_DIM
NA_WIN_H = 8
NA_WIN_W = 16
NA_QBLOCK_W = 16
NA_KSPAN_W = NA_QBLOCK_W + NA_WIN_W
ROPE_BASE = 10000.0
HG_DK = 128
HG_DV = 128
N_HG_HEADS = (D_MODEL // 2) // HG_DV
HG_KEY_WIDTH = N_HG_HEADS * HG_DK
HG_WIDTH = N_HG_HEADS * HG_DV
HG_CHUNK = 32
MIX_WIDTH = NA_WIDTH + HG_WIDTH
IN_COLS = 3 * NA_WIDTH + 3 * HG_KEY_WIDTH + 2 * HG_WIDTH
N_EXPERTS = 16
EC_CAPACITY_FACTOR = 2
D_EXPERT = ((8 * D_MODEL // 3 + 63) // 64) * 64
RMS_EPS = 1e-6

kernel_name = 'hybrid_na_hgrn2_ec_diffusion_block'


def rms_norm(x, g):
    xf = x.astype(jnp.float32)
    y = xf * lax.rsqrt(jnp.mean(xf * xf, axis=-1, keepdims=True) + RMS_EPS)
    return (y * g.astype(jnp.float32)).astype(x.dtype)


def modulate(h, shift, scale):
    return h * (1.0 + scale) + shift


def to_heads(x, n_heads):
    b, t, w = x.shape
    return x.reshape(b, t, n_heads, w // n_heads).transpose(0, 2, 1, 3)


def from_heads(x):
    b, h, t, d = x.shape
    return x.transpose(0, 2, 1, 3).reshape(b, t, h * d)


def split_cols(p):
    sizes = (NA_WIDTH, NA_WIDTH, NA_WIDTH, HG_KEY_WIDTH, HG_KEY_WIDTH, HG_KEY_WIDTH, HG_WIDTH, HG_WIDTH)
    bounds = []
    acc = 0
    for s in sizes[:-1]:
        acc += s
        bounds.append(acc)
    return jnp.split(p, bounds, axis=-1)


def rope_1d(x, pos):
    d = x.shape[-1]
    inv_freq = ROPE_BASE ** (-jnp.arange(0, d, 2, dtype=jnp.float32) / d)
    ang = pos[:, None] * inv_freq[None, :]
    cos = jnp.cos(ang).astype(x.dtype)
    sin = jnp.sin(ang).astype(x.dtype)
    x1, x2 = x[..., : d // 2], x[..., d // 2:]
    return jnp.concatenate([x1 * cos - x2 * sin, x1 * sin + x2 * cos], axis=-1)


def axial_rope(x, row_pos, col_pos):
    half = x.shape[-1] // 2
    return jnp.concatenate([rope_1d(x[..., :half], row_pos), rope_1d(x[..., half:], col_pos)], axis=-1)


def neighbourhood_attention(q, k, v, k_ctx, v_ctx, rpb):
    bsz, nh, seq, dh = q.shape
    rows = seq // GRID_W
    kh = min(NA_WIN_H, rows)
    ncb = GRID_W // NA_QBLOCK_W
    scale = dh ** -0.5
    t = jnp.arange(seq)
    row_pos = (t // GRID_W).astype(jnp.float32)
    col_pos = (t % GRID_W).astype(jnp.float32)
    q_rot = axial_rope(q, row_pos, col_pos)
    k_rot = axial_rope(k, row_pos, col_pos)
    r = jnp.arange(rows)
    r0 = jnp.clip(r - kh // 2, 0, rows - kh)
    key_rows = r0[:, None] + jnp.arange(kh)[None, :]
    j = jnp.arange(ncb)
    c0 = jnp.clip(j * NA_QBLOCK_W - NA_WIN_W // 2, 0, GRID_W - NA_KSPAN_W)
    key_cols = c0[:, None] + jnp.arange(NA_KSPAN_W)[None, :]
    tok = key_rows[:, None, :, None] * GRID_W + key_cols[None, :, None, :]
    k_blk = k_rot[:, :, tok]
    v_blk = v[:, :, tok]
    q_cols = j[:, None] * NA_QBLOCK_W + jnp.arange(NA_QBLOCK_W)[None, :]
    win_c0 = jnp.clip(q_cols - NA_WIN_W // 2, 0, GRID_W - NA_WIN_W)
    kc = key_cols[:, None, :]
    in_win = (kc >= win_c0[:, :, None]) & (kc < win_c0[:, :, None] + NA_WIN_W)
    dr_idx = key_rows - r[:, None] + NA_WIN_H - 1
    dc_idx = jnp.clip(kc - q_cols[:, :, None] + NA_WIN_W - 1, 0, 2 * NA_WIN_W - 2)
    bias = rpb[:, dr_idx[:, None, None, :, None], dc_idx[None, :, :, None, :]]
    q_blk = q_rot.reshape(bsz, nh, rows, ncb, NA_QBLOCK_W, dh)
    s_win = jnp.einsum('bhrjqd,bhrjakd->bhrjqak', q_blk, k_blk).astype(jnp.float32) * scale
    s_win = jnp.where(in_win[:, :, None, :], s_win + bias.astype(jnp.float32), -jnp.inf)
    q_plain = q.reshape(bsz, nh, rows, ncb, NA_QBLOCK_W, dh)
    s_ctx = jnp.einsum('bhrjqd,bhld->bhrjql', q_plain, k_ctx).astype(jnp.float32) * scale
    n_win = kh * NA_KSPAN_W
    s_all = jnp.concatenate([s_win.reshape(bsz, nh, rows, ncb, NA_QBLOCK_W, n_win), s_ctx], axis=-1)
    p = jax.nn.softmax(s_all, axis=-1).astype(v.dtype)
    p_win = p[..., :n_win].reshape(bsz, nh, rows, ncb, NA_QBLOCK_W, kh, NA_KSPAN_W)
    o = (jnp.einsum('bhrjqak,bhrjakd->bhrjqd', p_win, v_blk)
         + jnp.einsum('bhrjql,bhld->bhrjqd', p[..., n_win:], v_ctx))
    return from_heads(o.reshape(bsz, nh, seq, dh))


def context_attention(q, k, v):
    scale = q.shape[-1] ** -0.5
    s = jnp.einsum('bhld,bhmd->bhlm', q, k).astype(jnp.float32) * scale
    p = jax.nn.softmax(s, axis=-1).astype(v.dtype)
    return jnp.einsum('bhlm,bhmd->bhld', p, v)


def log_forget(z, lb):
    lb_h = lb.reshape(N_HG_HEADS, 1, HG_DK)
    return jnp.log(lb_h + (1.0 - lb_h) * jax.nn.sigmoid(z.astype(jnp.float32)))


def gla_chunked(q, k, v, log_f, s0):
    bsz, nh, seq, dk = q.shape
    dv = v.shape[-1]
    n = seq // HG_CHUNK
    qc = q.astype(jnp.float32).reshape(bsz, nh, n, HG_CHUNK, dk)
    kc = k.astype(jnp.float32).reshape(bsz, nh, n, HG_CHUNK, dk)
    vc = v.astype(jnp.float32).reshape(bsz, nh, n, HG_CHUNK, dv)
    b = jnp.cumsum(log_f.reshape(bsz, nh, n, HG_CHUNK, dk), axis=3)
    b_end = b[:, :, :, -1:, :]
    q_dec = qc * jnp.exp(b)
    k_dec = kc * jnp.exp(-b)
    idx = jnp.arange(HG_CHUNK)
    lower = idx[:, None] >= idx[None, :]
    a = jnp.where(lower, jnp.einsum('bhnck,bhnsk->bhncs', q_dec, k_dec), 0.0)
    o_intra = jnp.einsum('bhncs,bhnsv->bhncv', a, vc)
    kv = jnp.einsum('bhnck,bhncv->bhnkv', kc * jnp.exp(b_end - b), vc)
    decay = jnp.exp(b_end[:, :, :, 0, :])

    def step(s, inp):
        dec, upd = inp
        return dec[..., None] * s + upd, s

    s_fin, s_prev = lax.scan(step, s0.astype(jnp.float32),
                             (jnp.moveaxis(decay, 2, 0), jnp.moveaxis(kv, 2, 0)))
    s_prev = jnp.moveaxis(s_prev, 0, 2)
    o_inter = jnp.einsum('bhnck,bhnkv->bhncv', q_dec, s_prev)
    return (o_intra + o_inter).reshape(bsz, nh, seq, dv), s_fin


def hgrn2_bidir(q, z_fwd, z_bwd, i, lb, s0_fwd, s0_bwd):
    lf_f = log_forget(z_fwd, lb)
    lf_b = log_forget(z_bwd, lb)
    o_f, s_f = gla_chunked(q, -jnp.expm1(lf_f), i, lf_f, s0_fwd)
    flip = lambda t: jnp.flip(t, axis=2)
    o_b, s_b = gla_chunked(flip(q), flip(-jnp.expm1(lf_b)), flip(i), flip(lf_b), s0_bwd)
    return o_f + flip(o_b), s_f, s_b


def hgrn2_readout(o, g, norm_g):
    return from_heads(rms_norm(o.astype(g.dtype), norm_g) * jax.nn.sigmoid(g))


def ec_moe(h, w_router, w_gate, w_up, w_down):
    bsz, n_tok, d = h.shape
    cap = EC_CAPACITY_FACTOR * n_tok // N_EXPERTS
    aff = jax.nn.softmax(jnp.einsum('btd,de->bte', h, w_router).astype(jnp.float32), axis=-1)
    gate, idx = lax.top_k(jnp.swapaxes(aff, 1, 2), cap)
    xs = jax.vmap(lambda hb, ib: hb[ib])(h, idx)
    hid = (jax.nn.silu(jnp.einsum('becd,edf->becf', xs, w_gate))
           * jnp.einsum('becd,edf->becf', xs, w_up))
    y = jnp.einsum('becf,efd->becd', hid, w_down) * gate[..., None].astype(h.dtype)
    return jax.vmap(lambda yb, ib: jnp.zeros((n_tok, d), y.dtype).at[ib.reshape(-1)].add(yb.reshape(-1, d)))(y, idx)


def setup_inputs(seed: int = 0) -> dict:
    key = jax.random.key(seed)
    ks = jax.random.split(key, 19)
    nrm = jax.random.normal
    d = D_MODEL
    f32 = jnp.float32
    return {
        'x': nrm(ks[0], (BATCH, SEQ, d), f32),
        'c': nrm(ks[1], (BATCH, d), f32),
        'ctx': nrm(ks[2], (BATCH, CTX_LEN, d), f32),
        'c_ctx': nrm(ks[3], (d,), f32),
        'w_mod': 0.5 * d ** -0.5 * nrm(ks[4], (DEPTH, d, 6 * d), f32),
        'b_mod': 0.01 * nrm(ks[5], (DEPTH, 6 * d), f32),
        'g_pre1': 1.0 + 0.05 * nrm(ks[6], (DEPTH, d), f32),
        'g_post1': 1.0 + 0.05 * nrm(ks[7], (DEPTH, d), f32),
        'g_pre2': 1.0 + 0.05 * nrm(ks[8], (DEPTH, d), f32),
        'g_post2': 1.0 + 0.05 * nrm(ks[9], (DEPTH, d), f32),
        'w_in': d ** -0.5 * nrm(ks[10], (DEPTH, d, IN_COLS), f32),
        'w_out': MIX_WIDTH ** -0.5 * nrm(ks[11], (DEPTH, MIX_WIDTH, d), f32),
        'na_rpb': 0.1 * nrm(ks[12], (DEPTH, N_NA_HEADS, 2 * NA_WIN_H - 1, 2 * NA_WIN_W - 1), f32),
        'hg_lb_logits': 0.5 * nrm(ks[13], (DEPTH + 1, HG_KEY_WIDTH), f32),
        'hg_norm': 1.0 + 0.05 * nrm(ks[14], (DEPTH, HG_DV), f32),
        'w_router': d ** -0.5 * nrm(ks[15], (DEPTH, d, N_EXPERTS), f32),
        'w_gate': d ** -0.5 * nrm(ks[16], (DEPTH, N_EXPERTS, d, D_EXPERT), f32),
        'w_up': d ** -0.5 * nrm(ks[17], (DEPTH, N_EXPERTS, d, D_EXPERT), f32),
        'w_down': D_EXPERT ** -0.5 * nrm(ks[18], (DEPTH, N_EXPERTS, D_EXPERT, d), f32),
    }


def reference(x, c, ctx, c_ctx, w_mod, b_mod, g_pre1, g_post1, g_pre2, g_post2, w_in, w_out,
              na_rpb, hg_lb_logits, hg_norm, w_router, w_gate, w_up, w_down):
    bsz = x.shape[0]
    silu_c = jax.nn.silu(c)
    silu_cc = jax.nn.silu(c_ctx)
    lb_all = jnp.cumsum(jax.nn.softmax(hg_lb_logits.astype(jnp.float32), axis=0), axis=0)
    for l in range(DEPTH):
        mod = silu_c @ w_mod[l] + b_mod[l]
        mod_c = silu_cc @ w_mod[l] + b_mod[l]
        sh1, sc1, gt1, sh2, sc2, gt2 = jnp.split(mod[:, None, :], 6, axis=-1)
        sh1c, sc1c, gt1c, sh2c, sc2c, gt2c = jnp.split(mod_c, 6)
        lb = lb_all[l]

        h = modulate(rms_norm(x, g_pre1[l]), sh1, sc1)
        hc = modulate(rms_norm(ctx, g_pre1[l]), sh1c, sc1c)
        qn, kn, vn, qh, zf, zb, ih, gh = split_cols(h @ w_in[l])
        qn_c, kn_c, vn_c, qh_c, zf_c, zb_c, ih_c, gh_c = split_cols(hc @ w_in[l])
        kn_ch = to_heads(kn_c, N_NA_HEADS)
        vn_ch = to_heads(vn_c, N_NA_HEADS)

        na_o = neighbourhood_attention(to_heads(qn, N_NA_HEADS), to_heads(kn, N_NA_HEADS),
                                       to_heads(vn, N_NA_HEADS), kn_ch, vn_ch, na_rpb[l])

        s0 = jnp.zeros((bsz, N_HG_HEADS, HG_DK, HG_DV), jnp.float32)
        o_hc, s_cf, s_cb = hgrn2_bidir(to_heads(qh_c, N_HG_HEADS), to_heads(zf_c, N_HG_HEADS),
                                       to_heads(zb_c, N_HG_HEADS), to_heads(ih_c, N_HG_HEADS), lb, s0, s0)
        o_hl, _, _ = hgrn2_bidir(to_heads(qh, N_HG_HEADS), to_heads(zf, N_HG_HEADS),
                                 to_heads(zb, N_HG_HEADS), to_heads(ih, N_HG_HEADS), lb, s_cf, s_cb)
        hg_o = hgrn2_readout(o_hl, to_heads(gh, N_HG_HEADS), hg_norm[l])

        mix = jnp.concatenate([na_o, hg_o], axis=-1) @ w_out[l]
        x = x + gt1 * rms_norm(mix, g_post1[l])

        h2 = modulate(rms_norm(x, g_pre2[l]), sh2, sc2)
        x = x + gt2 * rms_norm(ec_moe(h2, w_router[l], w_gate[l], w_up[l], w_down[l]), g_post2[l])

        if l < DEPTH - 1:
            o_cna = context_attention(to_heads(qn_c, N_NA_HEADS), kn_ch, vn_ch)
            hg_oc = hgrn2_readout(o_hc, to_heads(gh_c, N_HG_HEADS), hg_norm[l])
            mix_c = jnp.concatenate([from_heads(o_cna), hg_oc], axis=-1) @ w_out[l]
            ctx = ctx + gt1c * rms_norm(mix_c, g_post1[l])
            hc2 = modulate(rms_norm(ctx, g_pre2[l]), sh2c, sc2c)
            ctx = ctx + gt2c * rms_norm(ec_moe(hc2, w_router[l], w_gate[l], w_up[l], w_down[l]), g_post2[l])
    return x
```

```cpp
#include <hip/hip_runtime.h>
#include <cstdio>
#include <cstdint>
#include <cmath>
namespace pg8 {
#define PG8_LAS __attribute__((address_space(3)))
typedef unsigned short bf16_t;
typedef short bf16x8 __attribute__((ext_vector_type(8)));
typedef float f32x4 __attribute__((ext_vector_type(4)));
typedef unsigned u32x4 __attribute__((ext_vector_type(4)));
constexpr int BM = 256, BK = 64, HALF = 128, HTB = HALF * BK * 2  , STAGE_BYTES = 8 * HTB, NXCD = 8, WGM = 8;

__host__ __device__ __forceinline__ int lds_byte(int r, int c) { const int st = (r >> 4) * 2 + (c >> 5), rr = r & 15, cc = c & 31, ob = rr * 64 + cc * 2; return st * 1024 + (ob ^ (((ob >> 9) & 1) << 5)); }
__host__ __device__ __forceinline__ void stage_rc(int b, int& R, int& C) { const int st = b / 1024, sb = b % 1024, swz = sb ^ (((sb >> 9) & 1) << 5); R = (st >> 1) * 16 + swz / 64; C = (st & 1) * 32 + (swz % 64) / 2; }
__host__ __device__ __forceinline__ int perm32(int rho) { const int n = rho >> 4, i = rho & 15; return 8 * (i >> 2) + 4 * n + (i & 3); }

struct Unit { int pm, pn; };
struct Gemm { const bf16_t* A; const bf16_t* Bt; int M, N, K; int gshift; size_t gstride; int glds; };

struct StaticOrder {
    int nM, nN, nwg, G, c;
    __host__ __device__ void init(int M, int N, int G_, int c_) { nM = M / BM; nN = N / BM; nwg = nM * nN; G = G_; c = c_; }
    __host__ __device__ bool next(int i, Unit& u) const {
        const long L = (long)i * G + c; if (L >= nwg) return false;
        int wgid = (int)L; { const int q = nwg / NXCD, r = nwg % NXCD, xcd = wgid % NXCD, off = wgid / NXCD; wgid = (xcd < r ? xcd * (q + 1) : r * (q + 1) + (xcd - r) * q) + off; }
        const int nig = WGM * nN, gid = wgid / nig, fm = gid * WGM, gsz = (nM - fm) < WGM ? (nM - fm) : WGM;
        u.pm = fm + ((wgid % nig) % gsz); u.pn = (wgid % nig) / gsz; return true;
    }
    __device__ __forceinline__ void a_ready(const Unit&) const {}
    __device__ __forceinline__ void done(const Unit&) const {}
};


typedef int i32x4 __attribute__((ext_vector_type(4)));
typedef int i32x8 __attribute__((ext_vector_type(8)));
__device__ __forceinline__ i32x8 cat8(bf16x8 a, bf16x8 b) { return __builtin_shufflevector(__builtin_bit_cast(i32x4, a), __builtin_bit_cast(i32x4, b), 0, 1, 2, 3, 4, 5, 6, 7); }
template <class Epi, class Sched, bool ALIGN_EPI = false, bool SP2 = false, bool GATHER = false, bool FP8 = false>
__device__ __forceinline__ void gemm_phase(PG8_LAS unsigned char* lds, const Gemm g, const Sched& S, const Epi& E) {
    const int tid = threadIdx.x, wid = __builtin_amdgcn_readfirstlane(tid >> 6), lane = tid & 63, wr = wid >> 2, wc = wid & 3, fr = lane & 15, fq = lane >> 4;
    const int K = g.K, nt = K / BK;
    unsigned voffA[2], voffB[2];
#pragma unroll
    for (int i = 0; i < 2; ++i) { int R, C; stage_rc(tid * 16 + i * 8192, R, C); const int Rb = Epi::PERM ? ((R & ~31) + perm32(R & 31)) : R;
        voffA[i] = (unsigned)(R * K + C) * 2u; voffB[i] = (unsigned)(Rb * K + C) * 2u; }
    unsigned vc0[2] = {0u, 0u}, vc1[2] = {0u, 0u}, vn0[2] = {0u, 0u}, vn1[2] = {0u, 0u}; int gR[2] = {0, 0}; unsigned gC2[2] = {0u, 0u};
    if constexpr (GATHER) {
#pragma unroll
        for (int i = 0; i < 2; ++i) { int R, C; stage_rc(tid * 16 + i * 8192, R, C); gR[i] = R; gC2[i] = (unsigned)C * 2u; } }
#define PG8_GATHER_OFFS(ui_, o0, o1) do { const PG8_LAS int* ip_ = (const PG8_LAS int*)(lds + g.glds) + (ui_) * 256; \
        _Pragma("unroll") for (int i_ = 0; i_ < 2; ++i_) { o0[i_] = (unsigned)ip_[gR[i_]] * (unsigned)(K * 2) + gC2[i_]; o1[i_] = (unsigned)ip_[128 + gR[i_]] * (unsigned)(K * 2) + gC2[i_]; } } while (0)
#define PG8_STAGE_A0(bufoff, gbase, nx) do { if constexpr (GATHER) { if (nx) PG8_STAGE(bufoff, gbase, vn0); else PG8_STAGE(bufoff, gbase, vc0); } else PG8_STAGE(bufoff, gbase, voffA); } while (0)
#define PG8_STAGE_A1(bufoff, gbase, nx) do { if constexpr (GATHER) { if (nx) PG8_STAGE(bufoff, gbase, vn1); else PG8_STAGE(bufoff, gbase, vc1); } else PG8_STAGE(bufoff, (gbase) + hstep, voffA); } while (0)
    const size_t kstep = (size_t)(BK * 2);
    const size_t hstep = (size_t)HALF * K * 2;
    const size_t tstep = 2 * hstep;
    const unsigned ldsw = (unsigned)wid * 1024u;
    const int aoff = lds_byte(wr * 64 + fr, fq * 8), boff = lds_byte(wc * 32 + fr, fq * 8);
#define PG8_SA(b, h) (((b) * 2 + (h)) * HTB)
#define PG8_SB(b, h) ((4 + (b) * 2 + (h)) * HTB)
#define PG8_STAGE(bufoff, gbase, voff) do { _Pragma("unroll") for (int _i = 0; _i < 2; ++_i) \
        __builtin_amdgcn_global_load_lds((const unsigned*)((const char*)(gbase) + (voff)[_i]), (PG8_LAS unsigned*)(lds + (bufoff) + ldsw + _i * 8192), 16, 0, 0); } while (0)
#define PG8_LDA(dst, b, h) do { _Pragma("unroll") for (int m = 0; m < 4; ++m) { dst[m].lo = *(const PG8_LAS i32x4*)(lds + PG8_SA(b, h) + aoff + m * 2048); dst[m].hi = *(const PG8_LAS i32x4*)(lds + PG8_SA(b, h) + aoff + m * 2048 + 1024); } } while (0)
#define PG8_LDB(dst, b, h) do { _Pragma("unroll") for (int n = 0; n < 2; ++n) { dst[n].lo = *(const PG8_LAS i32x4*)(lds + PG8_SB(b, h) + boff + n * 2048); dst[n].hi = *(const PG8_LAS i32x4*)(lds + PG8_SB(b, h) + boff + n * 2048 + 1024); } } while (0)
#define PG8_MMA(ai, bj, At, Bt) do { __builtin_amdgcn_s_setprio(1); _Pragma("unroll") for (int m = 0; m < 4; ++m) _Pragma("unroll") for (int n = 0; n < 2; ++n) { \
        if constexpr (FP8) asm volatile("v_mfma_scale_f32_16x16x128_f8f6f4 %0, %1, %2, %0, %3, %3 op_sel_hi:[0,0,0]" : "+v"(acc[ai][bj][m][n]) : "v"(Bt[n]), "v"(At[m]), "v"(sc1));   \
        else { acc[ai][bj][m][n] = __builtin_amdgcn_mfma_f32_16x16x32_bf16(__builtin_bit_cast(bf16x8, (i32x4)Bt[n].lo), __builtin_bit_cast(bf16x8, (i32x4)At[m].lo), acc[ai][bj][m][n], 0, 0, 0); \
               acc[ai][bj][m][n] = __builtin_amdgcn_mfma_f32_16x16x32_bf16(__builtin_bit_cast(bf16x8, (i32x4)Bt[n].hi), __builtin_bit_cast(bf16x8, (i32x4)At[m].hi), acc[ai][bj][m][n], 0, 0, 0); } } \
        __builtin_amdgcn_s_setprio(0); } while (0)
#define PG8_WAIT_V(n) asm volatile("s_waitcnt vmcnt(" #n ")" ::: "memory")
#define PG8_WAIT_L(n) asm volatile("s_waitcnt lgkmcnt(" #n ")" ::: "memory")
#define PG8_BAR __builtin_amdgcn_s_barrier()
#define PG8_SCHED __builtin_amdgcn_sched_barrier(0)
    Unit cur, nxt; int ui = 0;
    if (!S.next(0, cur)) return;
    f32x4 acc[2][2][4][2];
#pragma unroll
    for (int a = 0; a < 2; ++a)
#pragma unroll
        for (int b = 0; b < 2; ++b)
#pragma unroll
            for (int m = 0; m < 4; ++m)
#pragma unroll
                for (int n = 0; n < 2; ++n) acc[a][b][m][n] = (f32x4){0.f, 0.f, 0.f, 0.f};
    int sc1 = 0x7f7f7f7f; asm volatile("" : "+v"(sc1));
    i32x8 At[4], B0[2], B1[2];
    const char* cA = (const char*)g.A + (GATHER ? (size_t)0 : (size_t)cur.pm * tstep); if constexpr (GATHER) PG8_GATHER_OFFS(0, vc0, vc1);
    const char* cB = (const char*)g.Bt + (size_t)cur.pn * tstep + (size_t)(cur.pm >> g.gshift) * g.gstride;
    S.a_ready(cur);
    if constexpr (SP2) {
        PG8_STAGE(PG8_SB(0, 0), cB, voffB); PG8_STAGE(PG8_SB(0, 1), cB + hstep, voffB); PG8_STAGE_A0(PG8_SA(0, 0), cA, false); PG8_STAGE_A1(PG8_SA(0, 1), cA, false);
        if (wr == 1) PG8_BAR;
        PG8_WAIT_V(2); PG8_BAR;
        PG8_STAGE(PG8_SB(1, 0), cB + kstep, voffB); PG8_STAGE_A0(PG8_SA(1, 0), cA + kstep, false); PG8_STAGE(PG8_SB(1, 1), cB + hstep + kstep, voffB);
        PG8_WAIT_V(6); PG8_BAR;
    } else {
        PG8_STAGE(PG8_SB(0, 0), cB, voffB); PG8_STAGE(PG8_SA(0, 0), cA, voffA); PG8_STAGE(PG8_SB(0, 1), cB + hstep, voffB); PG8_STAGE(PG8_SA(0, 1), cA + hstep, voffA);
        if (wr == 1) PG8_BAR;
        PG8_WAIT_V(4); PG8_BAR;
        PG8_STAGE(PG8_SB(1, 0), cB + kstep, voffB); PG8_STAGE(PG8_SA(1, 0), cA + kstep, voffA); PG8_STAGE(PG8_SB(1, 1), cB + hstep + kstep, voffB);
        PG8_WAIT_V(6); PG8_BAR;
    }
    for (;;) {
        const bool has_next = S.next(ui + 1, nxt);
        const char* nA = (has_next && !GATHER) ? (const char*)g.A + (size_t)nxt.pm * tstep : cA;
        if constexpr (GATHER) { if (has_next) PG8_GATHER_OFFS(ui + 1, vn0, vn1); else { vn0[0] = vc0[0]; vn0[1] = vc0[1]; vn1[0] = vc1[0]; vn1[1] = vc1[1]; } } const char* nB = has_next ? (const char*)g.Bt + (size_t)nxt.pn * tstep + (size_t)(nxt.pm >> g.gshift) * g.gstride : cB;
        for (int t = 0; t < nt; t += 2) {
            const bool last = (t == nt - 2);
            const char* a1 = cA + (size_t)(t + 1) * kstep;
            const char* a2 = last ? nA : cA + (size_t)(t + 2) * kstep; const char* b2 = last ? nB : cB + (size_t)(t + 2) * kstep;
            const char* a3 = a2 + kstep; const char* b3 = b2 + kstep;
            if (last && has_next) S.a_ready(nxt);
            if constexpr (SP2) {
            PG8_LDB(B0, 0, 0); PG8_LDB(B1, 0, 1); PG8_SCHED; PG8_LDA(At, 0, 0); PG8_STAGE_A1(PG8_SA(1, 1), a1, false);
            PG8_WAIT_V(8); PG8_WAIT_L(0); PG8_BAR; PG8_MMA(0, 0, At, B0); PG8_MMA(0, 1, At, B1); PG8_BAR; PG8_SCHED;
            PG8_LDA(At, 0, 1); PG8_STAGE(PG8_SB(0, 0), b2, voffB); PG8_STAGE(PG8_SB(0, 1), b2 + hstep, voffB); PG8_STAGE_A0(PG8_SA(0, 0), a2, last);
            PG8_WAIT_V(8); PG8_WAIT_L(0); PG8_BAR; PG8_MMA(1, 0, At, B0); PG8_MMA(1, 1, At, B1); PG8_BAR; PG8_SCHED;
            PG8_LDB(B0, 1, 0); PG8_LDB(B1, 1, 1); PG8_SCHED; PG8_LDA(At, 1, 0); PG8_STAGE_A1(PG8_SA(0, 1), a2, last);
            PG8_WAIT_V(8); PG8_WAIT_L(0); PG8_BAR; PG8_MMA(0, 0, At, B0); PG8_MMA(0, 1, At, B1); PG8_BAR; PG8_SCHED;
            PG8_LDA(At, 1, 1); PG8_STAGE(PG8_SB(1, 0), b3, voffB); PG8_STAGE(PG8_SB(1, 1), b3 + hstep, voffB); PG8_STAGE_A0(PG8_SA(1, 0), a3, last);
            PG8_WAIT_V(8); PG8_WAIT_L(0); PG8_BAR; PG8_MMA(1, 0, At, B0); PG8_MMA(1, 1, At, B1); PG8_BAR; PG8_SCHED;
            } else {
            PG8_LDB(B0, 0, 0); PG8_SCHED; PG8_LDA(At, 0, 0); PG8_STAGE(PG8_SA(1, 1), a1 + hstep, voffA);
            PG8_WAIT_L(8); PG8_BAR; PG8_WAIT_L(0); PG8_MMA(0, 0, At, B0); PG8_BAR; PG8_SCHED;
            PG8_LDB(B1, 0, 1); PG8_STAGE(PG8_SB(0, 0), b2, voffB);
            PG8_BAR; PG8_WAIT_L(0); PG8_MMA(0, 1, At, B1); PG8_BAR;
            PG8_LDA(At, 0, 1); PG8_STAGE(PG8_SA(0, 0), a2, voffA);
            PG8_BAR; PG8_WAIT_L(0); PG8_MMA(1, 0, At, B0); PG8_BAR; PG8_SCHED;
            PG8_STAGE(PG8_SB(0, 1), b2 + hstep, voffB);
            PG8_WAIT_V(6); PG8_BAR; PG8_MMA(1, 1, At, B1); PG8_BAR;
            PG8_LDB(B0, 1, 0); PG8_SCHED; PG8_LDA(At, 1, 0); PG8_STAGE(PG8_SA(0, 1), a2 + hstep, voffA);
            PG8_WAIT_L(8); PG8_BAR; PG8_WAIT_L(0); PG8_MMA(0, 0, At, B0); PG8_BAR; PG8_SCHED;
            PG8_LDB(B1, 1, 1); PG8_STAGE(PG8_SB(1, 0), b3, voffB);
            PG8_BAR; PG8_WAIT_L(0); PG8_MMA(0, 1, At, B1); PG8_BAR;
            PG8_LDA(At, 1, 1); PG8_STAGE(PG8_SA(1, 0), a3, voffA);
            PG8_BAR; PG8_WAIT_L(0); PG8_MMA(1, 0, At, B0); PG8_BAR; PG8_SCHED;
            PG8_STAGE(PG8_SB(1, 1), b3 + hstep, voffB);
            PG8_WAIT_V(6); PG8_BAR; PG8_MMA(1, 1, At, B1); PG8_BAR;
            }
        }
        if constexpr (ALIGN_EPI) { if (wr == 0) PG8_BAR; }
        if constexpr (FP8) asm volatile("s_nop 15\n\ts_nop 15" ::: "memory");
        if constexpr (!Epi::AFTER_DRAIN) { E(acc, cur, wr, wc, fr, fq); S.done(cur); }
        if (!has_next) break;
#pragma unroll
        for (int a = 0; a < 2; ++a)
#pragma unroll
            for (int b = 0; b < 2; ++b)
#pragma unroll
                for (int m = 0; m < 4; ++m)
#pragma unroll
                    for (int n = 0; n < 2; ++n) acc[a][b][m][n] = (f32x4){0.f, 0.f, 0.f, 0.f};
        cur = nxt; cA = nA; cB = nB; ++ui;
        if constexpr (GATHER) { vc0[0] = vn0[0]; vc0[1] = vn0[1]; vc1[0] = vn1[0]; vc1[1] = vn1[1]; }
        if constexpr (ALIGN_EPI) { if (wr == 1) PG8_BAR; }
    }
    PG8_WAIT_V(0);
    if constexpr (!ALIGN_EPI) { if (wr == 0) PG8_BAR; }
    PG8_BAR;
    if constexpr (Epi::AFTER_DRAIN) { E.fused(acc, cur, wr, wc, fr, fq, lds, wid, lane); S.done(cur); }
#undef PG8_SA
#undef PG8_SB
#undef PG8_STAGE
#undef PG8_STAGE_A0
#undef PG8_STAGE_A1
#undef PG8_GATHER_OFFS
#undef PG8_LDA
#undef PG8_LDB
#undef PG8_MMA
#undef PG8_WAIT_V
#undef PG8_WAIT_L
#undef PG8_BAR
#undef PG8_SCHED
}
}

#define LAS __attribute__((address_space(3)))
typedef unsigned short bf16;
typedef unsigned u32x4 __attribute__((ext_vector_type(4)));
typedef unsigned u32x2 __attribute__((ext_vector_type(2)));
typedef float f32x4 __attribute__((ext_vector_type(4)));
typedef float f32x2 __attribute__((ext_vector_type(2)));

constexpr int NWAVES = 8, NTHR = 512;
constexpr int DM = 1024, NB = 2, SEQ = 8192, CTXL = 256;
constexpr int MROWS = NB * SEQ;
constexpr int MCTX = NB * CTXL;
constexpr int MTOT = MROWS + MCTX;
constexpr int NINC = 4096;
constexpr int NE = 16, CAP = 1024, FE = 2752, FEP = 2816, N1P = 5632;
constexpr int MEXP = NE * NB * CAP;
constexpr float RMS_EPS = 1e-6f;
constexpr int NPHASE = 12;
#ifndef PHMASK
#define PHMASK 0xFFF
#endif
#define PH_ON(k) ((PHMASK >> (k)) & 1)
#ifndef REPMASK
#define REPMASK 0x0
#endif
#define REP_ON(k) ((REPMASK >> (k)) & 1)
#ifndef MK_N_LAUNCHES
#define MK_N_LAUNCHES 1
#endif

constexpr size_t MiB = 1u << 20, KiB = 1u << 10;
constexpr size_t WS_CTL = 0, CTL_ZERO_BYTES = 1 * MiB;
constexpr size_t WS_MODP = 1 * MiB;
constexpr size_t WS_MODF = 1 * MiB + 640 * KiB;
constexpr size_t WS_LB = 1 * MiB + 768 * KiB;
constexpr size_t WS_COS = 1 * MiB + 800 * KiB;
constexpr size_t WS_SIN = 1 * MiB + 808 * KiB;
constexpr size_t WS_WRT = 1 * MiB + 832 * KiB;
constexpr size_t WS_AFF = 2 * MiB;
constexpr size_t WS_IDX = 3 * MiB;
constexpr size_t WS_GATEV = 3 * MiB + 256 * KiB;
constexpr size_t WS_SLOT = 4 * MiB;
constexpr size_t WS_H2 = 8 * MiB;
constexpr size_t WS_WINT = 72 * MiB;
constexpr size_t WS_WOUTT = 80 * MiB;
constexpr size_t WS_W1T = 82 * MiB;
constexpr size_t WS_W2T = 258 * MiB;
constexpr size_t WS_H = 346 * MiB;
constexpr size_t WS_QP = 379 * MiB;
constexpr size_t WS_QR = 395 * MiB;
constexpr size_t WS_KR = 411 * MiB;
constexpr size_t WS_V = 428 * MiB;
constexpr size_t WS_QH = 445 * MiB;
constexpr size_t WS_LFF = 462 * MiB;
constexpr size_t WS_LFB = 495 * MiB;
constexpr size_t WS_IH = 528 * MiB;
constexpr size_t WS_GH = 545 * MiB;
constexpr size_t WS_MIXIN = 561 * MiB;
constexpr size_t WS_HID = 346 * MiB;
constexpr size_t WS_MIX = 593 * MiB;
constexpr size_t WS_YS = 593 * MiB;
constexpr size_t WS_END = 657 * MiB;
static_assert(WS_HID + (size_t)MEXP * FEP * 2 <= WS_MIXIN + 32 * MiB, "hid overlay");
static_assert(WS_W1T + (size_t)NE * N1P * DM * 2 <= WS_W2T && WS_W2T + (size_t)NE * DM * FEP * 2 <= WS_H, "weights");

constexpr int CW_BAR = 4096;
constexpr int LDSCTL_BYTES = 512, LDS_BYTES = 155648;

#define LDS_WAIT() asm volatile("s_waitcnt lgkmcnt(0)" ::: "memory")
#define VM_WAIT() asm volatile("s_waitcnt vmcnt(0)" ::: "memory")
__device__ __forceinline__ unsigned f2bf(float f) { unsigned u = __builtin_bit_cast(unsigned, f); return (u + 0x7fffu + ((u >> 16) & 1u)) >> 16; }
__device__ __forceinline__ unsigned pk2(float lo, float hi) { return f2bf(lo) | (f2bf(hi) << 16); }
__device__ __forceinline__ float bf2f(unsigned h) { return __builtin_bit_cast(float, h << 16); }
__device__ __forceinline__ float bflo(unsigned w) { return __builtin_bit_cast(float, w << 16); }
__device__ __forceinline__ float bfhi(unsigned w) { return __builtin_bit_cast(float, w & 0xffff0000u); }
__device__ __forceinline__ float wave_sum(float v) {
#pragma unroll
    for (int o = 1; o < 64; o <<= 1) v += __shfl_xor(v, o);
    return v;
}
__device__ __forceinline__ float wave_max(float v) {
#pragma unroll
    for (int o = 1; o < 64; o <<= 1) v = fmaxf(v, __shfl_xor(v, o));
    return v;
}
__device__ __forceinline__ unsigned pk4_fp8(float a, float b, float c, float d) { int w = 0; w = __builtin_amdgcn_cvt_pk_fp8_f32(a, b, w, false); w = __builtin_amdgcn_cvt_pk_fp8_f32(c, d, w, true); return (unsigned)w; }
constexpr float W2_SCALE = 32.f, HID_SCALE = 8.f;
constexpr float W1_SCALE = 32.f, H2_SCALE = 4.f;
__device__ __forceinline__ float sigmoidf_(float x) { return __builtin_amdgcn_rcpf(1.0f + __expf(-x)); }

#define XB_TMO      128
#define XB_XCNT(j)  (256  + 64 * (j))
#define XB_XSUB(j)  (1280 + 64 * (j))
#define XB_XGEN(j)  (2304 + 64 * (j))
#define XB_TOP      3328
#define XB_TOPGEN   3392
#define XCD_BAR_WORDS 3456
#define XB_SPIN_CAP (1u << 20)
__device__ __forceinline__ unsigned xb_ld(unsigned* p)              { return __hip_atomic_load(p, __ATOMIC_RELAXED, __HIP_MEMORY_SCOPE_AGENT); }
__device__ __forceinline__ unsigned xb_add(unsigned* p, unsigned v) { return __hip_atomic_fetch_add(p, v, __ATOMIC_RELAXED, __HIP_MEMORY_SCOPE_AGENT); }
__device__ __forceinline__ unsigned xb_xcc_id() { return (unsigned)__builtin_amdgcn_s_getreg((3 << 11) | 20) & 0xFu; }
#define XB_SPIN(cond, bar) do { unsigned _sp = 0; while (cond) { __builtin_amdgcn_s_sleep(1); \
    if ((++_sp & 255u) == 0u) { if (xb_ld(&(bar)[XB_TMO])) break; if (_sp > XB_SPIN_CAP) { atomicAdd(&(bar)[XB_TMO], 1u); break; } } } } while (0)
struct XcdBarrier { unsigned* bar; unsigned x; volatile LAS unsigned* st; };
__device__ __forceinline__ XcdBarrier xcd_barrier_post(unsigned* bar, volatile LAS unsigned* st) {
    XcdBarrier b; b.bar = bar; b.x = xb_xcc_id(); b.st = st;
    if (threadIdx.x == 0) (void)xb_add(&bar[XB_XCNT(b.x)], 1u);
    return b;
}
__device__ __forceinline__ void xcd_barrier_complete(unsigned* bar, unsigned x, unsigned& nloc, unsigned& nx) {
    const unsigned G = gridDim.x * gridDim.y * gridDim.z;
    unsigned sum, cnt, mine, sp = 0u;
    for (;;) {
        sum = 0u; cnt = 0u; mine = 0u;
#pragma unroll
        for (unsigned j = 0; j < 16; ++j) { const unsigned c = xb_ld(&bar[XB_XCNT(j)]); sum += c; cnt += (c > 0u) ? 1u : 0u; mine = (j == x) ? c : mine; }
        if (sum == G) break;
        __builtin_amdgcn_s_sleep(1);
        if ((++sp & 255u) == 0u) { if (xb_ld(&bar[XB_TMO])) break; if (sp > XB_SPIN_CAP) { atomicAdd(&bar[XB_TMO], 1u); break; } }
    }
    nloc = mine > 0u ? mine : 1u; nx = cnt > 0u ? cnt : 1u;
}
__device__ __forceinline__ void xcd_barrier(const XcdBarrier& b) {
    asm volatile("s_waitcnt vmcnt(0)" ::: "memory");
    __syncthreads();
    if (threadIdx.x == 0) {
        unsigned* bar = b.bar;
        __builtin_amdgcn_s_waitcnt(0);
        unsigned nloc = b.st[0], nx = b.st[1];
        if (nloc == 0u) { xcd_barrier_complete(bar, b.x, nloc, nx); b.st[0] = nloc; b.st[1] = nx; }
        const unsigned old = xb_add(&bar[XB_XSUB(b.x)], 1u);
        const unsigned gen = old / nloc;
        if (old + 1u == (gen + 1u) * nloc) {
            __builtin_amdgcn_fence(__ATOMIC_RELEASE, "agent");
            asm volatile("s_waitcnt vmcnt(0)" ::: "memory");
            const unsigned og = xb_add(&bar[XB_TOP], 1u);
            const unsigned tg = og / nx;
            if (og + 1u == (tg + 1u) * nx) xb_add(&bar[XB_TOPGEN], 1u);
            else XB_SPIN(xb_ld(&bar[XB_TOPGEN]) == tg, bar);
            __builtin_amdgcn_fence(__ATOMIC_ACQUIRE, "agent");
            xb_add(&bar[XB_XGEN(b.x)], 1u);
            asm volatile("s_waitcnt vmcnt(0)" ::: "memory");
        } else {
            XB_SPIN(xb_ld(&bar[XB_XGEN(b.x)]) == gen, bar);
            __builtin_amdgcn_fence(__ATOMIC_ACQUIRE, "agent");
            asm volatile("s_waitcnt vmcnt(0)" ::: "memory");
        }
    }
    __syncthreads();
}

struct Args { const float* in[19]; float* out; unsigned char* ws; int ph_lo, ph_hi; };
enum { I_X = 0, I_C, I_CTX, I_CCTX, I_WMOD, I_BMOD, I_GPRE1, I_GPOST1, I_GPRE2, I_GPOST2, I_WIN, I_WOUT, I_RPB, I_LBL, I_HGN, I_WROUTER, I_WGATE, I_WUP, I_WDOWN };

struct Ctx {
    LAS unsigned char* lds; int tid, lane, wave, G;
    Args a; unsigned char* ws;
};
template <class T> __device__ __forceinline__ T* wsp(const Ctx& C, size_t off) { return (T*)(C.ws + off); }

constexpr int CV_T_IN = 8 * 32, CV_T_OUT = 8 * 8, CV_T_G = 8 * 22, CV_T_D = 22 * 8, CV_T_E = 2 * CV_T_G + CV_T_D, CV_NT = CV_T_IN + CV_T_OUT + NE * CV_T_E;
constexpr int CV_D2 = 1568;
constexpr int CV_P0_END = CV_T_IN + CV_T_OUT, CV_D1_END = CV_NT - CV_D2;
__device__ __forceinline__ void convert_tiles(const Ctx& C, int first, int last, int start, int stride) {
    const Args& a = C.a;
    int tid_ = C.tid; asm volatile("" : "+v"(tid_));
    constexpr int T_IN = CV_T_IN, T_OUT = CV_T_OUT, T_G = CV_T_G, T_E = CV_T_E;
    {
        LAS float* scr = (LAS float*)C.lds;
#define SCR(k_, n_) (*(const LAS float*)((const LAS unsigned char*)scr + (k_) * 512 + (((((n_) >> 2) ^ (k_) ^ ((k_) >> 4)) & 31) << 4) + ((n_) & 3) * 4))
        struct Item { const float* src; bf16* dst; int N, ldk, k0, n0, kval, nval, which; float f8scale; };
        auto decode = [&](int it, Item& I) {
            int r = it;
            if (r < T_IN) { I = Item{a.in[I_WIN], wsp<bf16>(C, WS_WINT), NINC, DM, 128 * (r >> 5), 128 * (r & 31), DM, NINC, -1, 0.f}; return; }
            r -= T_IN;
            if (r < T_OUT) { I = Item{a.in[I_WOUT], wsp<bf16>(C, WS_WOUTT), DM, DM, 128 * (r >> 3), 128 * (r & 7), DM, DM, -1, 0.f}; return; }
            r -= T_OUT;
            const int e = r / T_E; r %= T_E;
            if (r < 2 * T_G) { const int which = r / T_G; r %= T_G;
                I = Item{(which ? a.in[I_WUP] : a.in[I_WGATE]) + (size_t)e * DM * FE, (bf16*)(C.ws + WS_W1T + (size_t)e * N1P * DM), FE, DM, 128 * (r / 22), 128 * (r % 22), DM, FE, which, W1_SCALE}; return; }
            r -= 2 * T_G;
            I = Item{a.in[I_WDOWN] + (size_t)e * FE * DM, (bf16*)(C.ws + WS_W2T + (size_t)e * DM * FEP), DM, FEP, 128 * (r >> 3), 128 * (r & 7), FE, DM, -1, W2_SCALE};
        };
        auto loadt = [&](const Item& I, f32x4 (&v)[8]) {
#pragma unroll
            for (int i = 0; i < 8; ++i) { const int idx = tid_ + 512 * i, row = idx >> 5, c4 = idx & 31; const int k = I.k0 + row, n = I.n0 + 4 * c4;
                v[i] = (k < I.kval && n < I.nval) ? __builtin_nontemporal_load((const f32x4*)(I.src + (size_t)k * I.N + n)) : (f32x4){0.f, 0.f, 0.f, 0.f}; }
        };
        Item I0, I1; f32x4 v0[8], v1[8];
        int it = first + start;
        if (it < last) { decode(it, I0); loadt(I0, v0); }
        if (it + stride < last) { decode(it + stride, I1); loadt(I1, v1); }
        auto step = [&](Item& I, f32x4 (&v)[8], int itn) {
            __syncthreads();
#pragma unroll
            for (int i = 0; i < 8; ++i) { const int idx = tid_ + 512 * i, row = idx >> 5, c4 = idx & 31; *(LAS f32x4*)((LAS unsigned char*)scr + row * 512 + (((c4 ^ row ^ (row >> 4)) & 31) << 4)) = v[i]; }
            const Item cur = I;
            if (itn < last) { decode(itn, I); loadt(I, v); }
            __syncthreads();
            if (cur.f8scale != 0.f) {
#pragma unroll
                for (int i = 0; i < 2; ++i) { const int idx = tid_ + 512 * i, nl = idx >> 3, c = idx & 7; const float sc = cur.f8scale; float t[16];
#pragma unroll
                    for (int kk = 0; kk < 16; ++kk) { t[kk] = SCR(16 * c + kk, nl) * sc; if ((kk & 7) == 7) asm volatile("" ::: "memory"); }
                    u32x4 o;
                    o.x = pk4_fp8(t[0], t[1], t[2], t[3]); o.y = pk4_fp8(t[4], t[5], t[6], t[7]); o.z = pk4_fp8(t[8], t[9], t[10], t[11]); o.w = pk4_fp8(t[12], t[13], t[14], t[15]);
                    const int f = cur.n0 + nl; const int rowd = cur.which < 0 ? f : 32 * (f >> 4) + 16 * cur.which + (f & 15);
                    __builtin_nontemporal_store(o, (u32x4*)((unsigned char*)cur.dst + (size_t)rowd * cur.ldk + cur.k0 + 16 * c)); }
            } else {
#pragma unroll
                for (int i = 0; i < 4; ++i) { const int idx = tid_ + 512 * i, nl = idx >> 4, c = idx & 15;
                    u32x4 o; o.x = pk2(SCR(8 * c, nl), SCR(8 * c + 1, nl)); o.y = pk2(SCR(8 * c + 2, nl), SCR(8 * c + 3, nl)); o.z = pk2(SCR(8 * c + 4, nl), SCR(8 * c + 5, nl)); o.w = pk2(SCR(8 * c + 6, nl), SCR(8 * c + 7, nl));
                    const int f = cur.n0 + nl; const int rowd = cur.which < 0 ? f : 32 * (f >> 4) + 16 * cur.which + (f & 15);
                    *(u32x4*)(cur.dst + (size_t)rowd * cur.ldk + cur.k0 + 8 * c) = o; }
            }
        };
        for (; it < last; it += 2 * stride) { step(I0, v0, it + 2 * stride); if (it + stride < last) step(I1, v1, it + 3 * stride); }
#undef SCR
    }
}

__device__ __forceinline__ void phase_prologue(const Ctx& C) {
    const Args& a = C.a;
    if (blockIdx.x < 192) {
        const int cc = blockIdx.x % 24, ks = blockIdx.x / 24;
        LAS float* sv = (LAS float*)C.lds;
        LAS float* red = sv + 384;
        if (C.tid < 384) { const int i = C.tid >> 7, k = C.tid & 127; const float cv = (i < 2) ? a.in[I_C][i * DM + ks * 128 + k] : a.in[I_CCTX][ks * 128 + k]; sv[C.tid] = cv / (1.0f + expf(-cv)); }
        __syncthreads();
        const int cl = C.tid & 255, col = cc * 256 + cl, kh = C.tid >> 8;
        float a0 = 0.f, a1 = 0.f, a2 = 0.f;
        const float* wp = a.in[I_WMOD] + (size_t)(ks * 128 + kh * 64) * 6144 + col;
#pragma unroll 8
        for (int kk = 0; kk < 64; ++kk) { const float w = wp[(size_t)kk * 6144]; const int k = kh * 64 + kk; a0 += sv[k] * w; a1 += sv[128 + k] * w; a2 += sv[256 + k] * w; }
        if (kh == 1) { red[cl] = a0; red[256 + cl] = a1; red[512 + cl] = a2; }
        __syncthreads();
        if (kh == 0) { float* mp = wsp<float>(C, WS_MODP) + (size_t)ks * 18432 + col; mp[0] = a0 + red[cl]; mp[6144] = a1 + red[256 + cl]; mp[12288] = a2 + red[512 + cl]; }
        __syncthreads();
    }
    if (blockIdx.x == 255 % C.G) {
        const float* lg = a.in[I_LBL]; float* lb = wsp<float>(C, WS_LB);
        if (C.tid < 512) { const float l0 = lg[C.tid], l1 = lg[512 + C.tid]; lb[C.tid] = 1.0f / (1.0f + expf(l1 - l0)); }
    }
    if (blockIdx.x == 253 % C.G) {
        float* wrt = wsp<float>(C, WS_WRT);
        for (int idx = C.tid; idx < 16384; idx += NTHR) wrt[(idx & 15) * 1024 + (idx >> 4)] = a.in[I_WROUTER][idx];
    }
    if (blockIdx.x == 254 % C.G) {
        float* ct = wsp<float>(C, WS_COS); float* st = wsp<float>(C, WS_SIN);
        for (int idx = C.tid; idx < 2048; idx += NTHR) { const int pos = idx >> 4, i = idx & 15; const float inv = powf(10000.0f, -(float)i / 16.0f); const float ang = (float)pos * inv; ct[idx] = cosf(ang); st[idx] = sinf(ang); }
    }
    convert_tiles(C, 0, C.G > 32 ? CV_P0_END : CV_NT, (int)blockIdx.x, C.G);
}

__device__ __forceinline__ void phase_hrows(const Ctx& C) {
    const Args& a = C.a;
    const float* modp = wsp<float>(C, WS_MODP); const float* bmod = a.in[I_BMOD];
    { float* modf = wsp<float>(C, WS_MODF);
      for (int idx = blockIdx.x * NTHR + C.tid; idx < 18432; idx += C.G * NTHR) { float s = bmod[idx % 6144];
#pragma unroll
          for (int ks = 0; ks < 8; ++ks) s += modp[ks * 18432 + idx];
          modf[idx] = s; } }
    LAS float* sm = (LAS float*)C.lds;
    for (int j4 = C.tid; j4 < 1536; j4 += NTHR) { const int i = j4 >> 9, ci = (j4 & 511) * 4; f32x4 s = *(const f32x4*)(bmod + ci);
#pragma unroll
        for (int ks = 0; ks < 8; ++ks) s = s + *(const f32x4*)(modp + ks * 18432 + i * 6144 + ci);
        *(LAS f32x4*)(sm + i * 2048 + ci) = s; }
    __syncthreads();
    const int gw = blockIdx.x * NWAVES + C.wave, NGW = C.G * NWAVES;
    const int row_lo = 0, row_hi = MTOT;
    const float* gpre = a.in[I_GPRE1];
    bf16* H = wsp<bf16>(C, WS_H);
    for (int row0 = row_lo + 3 * gw; row0 < row_hi; row0 += 3 * NGW) {
        f32x4 v[3][4]; float ss[3];
#pragma unroll
        for (int r = 0; r < 3; ++r) { const int row = row0 + r; const float* src = row < MROWS ? a.in[I_X] + (size_t)row * DM : a.in[I_CTX] + (size_t)(row - MROWS) * DM;
#pragma unroll
            for (int j = 0; j < 4; ++j) v[r][j] = *(const f32x4*)(src + 4 * (C.lane + 64 * j)); }
#pragma unroll
        for (int r = 0; r < 3; ++r) { float s = 0.f;
#pragma unroll
            for (int j = 0; j < 4; ++j) s += (v[r][j].x * v[r][j].x + v[r][j].y * v[r][j].y) + (v[r][j].z * v[r][j].z + v[r][j].w * v[r][j].w);
            ss[r] = s; }
#pragma unroll
        for (int o = 1; o < 64; o <<= 1) {
#pragma unroll
            for (int r = 0; r < 3; ++r) ss[r] += __shfl_xor(ss[r], o); }
#pragma unroll
        for (int r = 0; r < 3; ++r) { const int row = row0 + r; const int vi = row < MROWS ? (row >> 13) : 2; const float rstd = 1.0f / sqrtf(ss[r] * (1.0f / DM) + RMS_EPS);
#pragma unroll
            for (int j = 0; j < 4; ++j) { const int ch = 4 * (C.lane + 64 * j);
                const f32x4 g = *(const f32x4*)(gpre + ch); const f32x4 sh = *(const LAS f32x4*)(sm + vi * 2048 + ch), sc = *(const LAS f32x4*)(sm + vi * 2048 + 1024 + ch);
                const f32x4 h = v[r][j] * rstd * g * (1.0f + sc) + sh;
                u32x2 o; o.x = pk2(h.x, h.y); o.y = pk2(h.z, h.w); *(u32x2*)(H + (size_t)row * DM + ch) = o; } }
    }
}

__device__ __forceinline__ void st_bf4(bf16* p, f32x4 v) { u32x2 o; o.x = pk2(v.x, v.y); o.y = pk2(v.z, v.w); *(u32x2*)p = o; }

struct EpiIn {
    static constexpr bool PERM = false, AFTER_DRAIN = false;
    bf16 *QP, *QR, *KR, *V, *QH, *IH, *GH; float *LFF, *LFB; const LAS float *lb, *cosT, *sinT;
    __device__ __forceinline__ void operator()(const f32x4 (&acc)[2][2][4][2], const pg8::Unit& u, int wr, int wc, int fr, int fq) const {
        const int stream = u.pn >> 1; const bool isctx = u.pm >= 64;
        if (isctx && (stream == 0 || stream == 7)) return;
#pragma unroll
        for (int ai = 0; ai < 2; ++ai)
#pragma unroll
            for (int m = 0; m < 4; ++m) {
                const int row = u.pm * 256 + ai * 128 + wr * 64 + m * 16 + fr;
#pragma unroll
                for (int bj = 0; bj < 2; ++bj) {
                    const int cs = (u.pn & 1) * 256 + bj * 128 + wc * 32 + 4 * fq;
                    const f32x4 x1 = acc[ai][bj][m][0], x2 = acc[ai][bj][m][1];
                    const size_t o = (size_t)row * 512 + cs;
                    if (stream <= 1) {
                        const int t = row & 8191, pos = (wc & 1) ? (t & 63) : (t >> 6);
                        const f32x4 c4 = *(const LAS f32x4*)(cosT + pos * 16 + 4 * fq), s4 = *(const LAS f32x4*)(sinT + pos * 16 + 4 * fq);
                        const f32x4 r1 = x1 * c4 - x2 * s4, r2 = x1 * s4 + x2 * c4;
                        if (stream == 0) { st_bf4(QP + o, x1 * 0.125f); st_bf4(QP + o + 16, x2 * 0.125f); st_bf4(QR + o, r1 * 0.125f); st_bf4(QR + o + 16, r2 * 0.125f); }
                        else if (isctx) { st_bf4(KR + o, x1); st_bf4(KR + o + 16, x2); }
                        else { st_bf4(KR + o, r1); st_bf4(KR + o + 16, r2); }
                    } else if (stream == 2) { st_bf4(V + o, x1); st_bf4(V + o + 16, x2); }
                    else if (stream == 3) { st_bf4(QH + o, x1); st_bf4(QH + o + 16, x2); }
                    else if (stream == 4 || stream == 5) {
                        float* LF = stream == 4 ? LFF : LFB;
                        const f32x4 l1 = *(const LAS f32x4*)(lb + cs), l2 = *(const LAS f32x4*)(lb + cs + 16);
                        f32x4 y1, y2;
#pragma unroll
                        for (int j = 0; j < 4; ++j) { y1[j] = __logf(l1[j] + (1.0f - l1[j]) * sigmoidf_(x1[j])); y2[j] = __logf(l2[j] + (1.0f - l2[j]) * sigmoidf_(x2[j])); }
                        *(f32x4*)(LF + o) = y1; *(f32x4*)(LF + o + 16) = y2;
                    } else if (stream == 6) { st_bf4(IH + o, x1); st_bf4(IH + o + 16, x2); }
                    else { st_bf4(GH + o, x1); st_bf4(GH + o + 16, x2); }
                }
            }
    }
};
struct EpiF32 {
    static constexpr bool PERM = false, AFTER_DRAIN = false;
    float* O; int ldc;
    __device__ __forceinline__ void operator()(const f32x4 (&acc)[2][2][4][2], const pg8::Unit& u, int wr, int wc, int fr, int fq) const {
#pragma unroll
        for (int ai = 0; ai < 2; ++ai)
#pragma unroll
            for (int m = 0; m < 4; ++m) { float* rp = O + (size_t)(u.pm * 256 + ai * 128 + wr * 64 + m * 16 + fr) * ldc + u.pn * 256 + wc * 32 + 4 * fq;
#pragma unroll
                for (int bj = 0; bj < 2; ++bj)
#pragma unroll
                    for (int n = 0; n < 2; ++n) *(f32x4*)(rp + bj * 128 + n * 16) = acc[ai][bj][m][n]; }
    }
};
struct EpiHid {
    static constexpr bool PERM = false, AFTER_DRAIN = false;
    unsigned char* HID;
    __device__ __forceinline__ void operator()(const f32x4 (&acc)[2][2][4][2], const pg8::Unit& u, int wr, int wc, int fr, int fq) const {
#pragma unroll
        for (int ai = 0; ai < 2; ++ai)
#pragma unroll
            for (int m = 0; m < 4; ++m) { unsigned char* rp = HID + (size_t)(u.pm * 256 + ai * 128 + wr * 64 + m * 16 + fr) * FEP + u.pn * 128 + wc * 16 + 4 * fq;
#pragma unroll
                for (int bj = 0; bj < 2; ++bj) { const f32x4 g = acc[ai][bj][m][0] * (1.0f / (W1_SCALE * H2_SCALE)), up = acc[ai][bj][m][1] * (HID_SCALE / (W1_SCALE * H2_SCALE)); f32x4 hv;
#pragma unroll
                    for (int j = 0; j < 4; ++j) hv[j] = __builtin_amdgcn_fmed3f(g[j] * sigmoidf_(g[j]) * up[j], -448.f, 448.f);
                    *(unsigned*)(rp + bj * 64) = pk4_fp8(hv[0], hv[1], hv[2], hv[3]); } }
    }
};
struct EpiYs {
    static constexpr bool PERM = false, AFTER_DRAIN = false;
    bf16* YS; const float* gate;
    __device__ __forceinline__ void operator()(const f32x4 (&acc)[2][2][4][2], const pg8::Unit& u, int wr, int wc, int fr, int fq) const {
#pragma unroll
        for (int ai = 0; ai < 2; ++ai)
#pragma unroll
            for (int m = 0; m < 4; ++m) { const int row = u.pm * 256 + ai * 128 + wr * 64 + m * 16 + fr; const float gv = gate[row] * (1.0f / (W2_SCALE * HID_SCALE));
                bf16* rp = YS + (size_t)row * DM + u.pn * 256 + wc * 32 + 4 * fq;
#pragma unroll
                for (int bj = 0; bj < 2; ++bj)
#pragma unroll
                    for (int n = 0; n < 2; ++n) st_bf4(rp + bj * 128 + n * 16, acc[ai][bj][m][n] * gv); }
    }
};

typedef short bf16x8 __attribute__((ext_vector_type(8)));
typedef short s16x4 __attribute__((ext_vector_type(4)));
constexpr int NA_KW = 0, NA_VW = NA_KW + 5 * 64 * 128, NA_KC = NA_VW + 5 * 64 * 128, NA_VC = NA_KC + 256 * 128, NA_SB = NA_VC + 256 * 128, NA_END = NA_SB + 15 * 64 * 4;
static_assert(NA_END + LDSCTL_BYTES <= LDS_BYTES, "NA LDS map");
__device__ __forceinline__ int voff(int key, int c  ) { return (key >> 3) * 1024 + (c >> 1) * 256 + (key & 7) * 32 + (c & 1) * 16; }
__device__ __forceinline__ int kswz(int row, int chunk) { return row * 128 + ((chunk ^ (row & 7)) << 4); }
__device__ __forceinline__ s16x4 lds_tr16(const LAS unsigned char* p) { return __builtin_bit_cast(s16x4, __builtin_amdgcn_ds_read_tr16_b64_v4i16((LAS s16x4*)p)); }
__device__ __forceinline__ int clampi(int v, int lo, int hi) { return min(max(v, lo), hi); }
__device__ __forceinline__ bf16x8 pack8(f32x4 a, f32x4 b) { u32x4 w; w.x = pk2(a.x, a.y); w.y = pk2(a.z, a.w); w.z = pk2(b.x, b.y); w.w = pk2(b.z, b.w); return __builtin_bit_cast(bf16x8, w); }

__device__ __forceinline__ void phase_na(const Ctx& C) {
    const Args& a_ = C.a;
    const bf16 *QP = wsp<bf16>(C, WS_QP), *QR = wsp<bf16>(C, WS_QR), *KR = wsp<bf16>(C, WS_KR), *V = wsp<bf16>(C, WS_V);
    bf16* MIXIN = wsp<bf16>(C, WS_MIXIN); const float* rpb = a_.in[I_RPB];
    LAS unsigned char* L = C.lds; LAS float* sB = (LAS float*)(L + NA_SB);
    const int UPB = (1024 + C.G - 1) / C.G, u_lo = blockIdx.x * UPB, u_hi = min(1024, u_lo + UPB);
    const int q = C.lane & 15, g = C.lane >> 4;
    int cur_bh = -1;
    u32x4 tk[5], tv[5];
    auto issue = [&](int uu, int grp) {
        const int bh = uu >> 6, b = bh >> 3, h = bh & 7, row0 = clampi(2 * (uu & 63) - 4, 0, 120) + 4 * grp;
#pragma unroll
        for (int i = 0; i < 5; ++i) { const int idx = C.tid + NTHR * i, kidx = idx >> 3, c = idx & 7; const size_t tok = (size_t)b * SEQ + min(row0 * 64 + kidx, SEQ - 1);
            tk[i] = *(const u32x4*)(KR + tok * 512 + h * 64 + 8 * c); tv[i] = *(const u32x4*)(V + tok * 512 + h * 64 + 8 * c); }
    };
    if (u_lo < u_hi) issue(u_lo, 0);
    for (int u = u_lo; u < u_hi; ++u) {
        const int bh = u >> 6, b = bh >> 3, h = bh & 7, r = 2 * (u & 63);
        const int rlo = clampi(r - 4, 0, 120);
        const int rr = r + (C.wave >> 2), j = C.wave & 3;
        const int r0q = clampi(rr - 4, 0, 120), c0 = clampi(16 * j - 8, 0, 32), cq = 16 * j + q, wc0 = clampi(cq - 8, 0, 48);
        const size_t mq = (size_t)b * SEQ + rr * 64 + cq;
        const bf16x8 qr0 = *(const bf16x8*)(QR + mq * 512 + h * 64 + 8 * g), qr1 = *(const bf16x8*)(QR + mq * 512 + h * 64 + 32 + 8 * g);
        const bf16x8 qp0 = *(const bf16x8*)(QP + mq * 512 + h * 64 + 8 * g), qp1 = *(const bf16x8*)(QP + mq * 512 + h * 64 + 32 + 8 * g);
        float mrun = -INFINITY, lrun = 0.f;
        f32x4 o[4];
#pragma unroll
        for (int dt = 0; dt < 4; ++dt) o[dt] = (f32x4){0.f, 0.f, 0.f, 0.f};
        const int slot0 = r0q - rlo;
        const int kw = slot0 * 64 + c0 + 4 * g + (q >> 2);
        const LAS unsigned char* vwb = L + NA_VW + (kw >> 3) * 1024 + (kw & 7) * 32 + (q & 3) * 8;
        const LAS unsigned char* kwb0 = L + NA_KW + kswz(slot0 * 64 + c0 + q, g), *kwb1 = L + NA_KW + kswz(slot0 * 64 + c0 + q, 4 + g);
        const int kx = 4 * g + (q >> 2);
        const LAS unsigned char* vcb = L + NA_VC + (kx >> 3) * 1024 + (kx & 7) * 32 + (q & 3) * 8;
        const LAS unsigned char* kc0 = L + NA_KC + kswz(q, g), *kc1 = L + NA_KC + kswz(q, 4 + g);
        const LAS float* bl = sB + (r0q - rr + 7) * 64 + (c0 + 4 * g - cq + 15 + 16);
        const int kcl = c0 + 4 * g - wc0;
        __syncthreads();
        if (bh != cur_bh) {
            cur_bh = bh;
            { u32x4 tk[4], tv[4];
#pragma unroll
              for (int i = 0; i < 4; ++i) { const int idx = C.tid + NTHR * i, l = idx >> 3, c = idx & 7; const size_t row = (size_t)MROWS + b * CTXL + l;
                  tk[i] = *(const u32x4*)(KR + row * 512 + h * 64 + 8 * c); tv[i] = *(const u32x4*)(V + row * 512 + h * 64 + 8 * c); }
#pragma unroll
              for (int i = 0; i < 4; ++i) { const int idx = C.tid + NTHR * i, l = idx >> 3, c = idx & 7;
                  *(LAS u32x4*)(L + NA_KC + kswz(l, c)) = tk[i]; *(LAS u32x4*)(L + NA_VC + voff(l, c)) = tv[i]; } }
            for (int idx = C.tid; idx < 15 * 64; idx += NTHR) { const int dr = idx >> 6, dc = (idx & 63) - 16; sB[idx] = (dc >= 0 && dc < 31) ? rpb[(h * 15 + dr) * 31 + dc] : 0.f; }
        }
#pragma unroll 1
        for (int grp = 0; grp < 2; ++grp) {
            if (grp == 1) __syncthreads();
            {
#pragma unroll
              for (int i = 0; i < 5; ++i) { const int idx = C.tid + NTHR * i, kidx = idx >> 3, c = idx & 7;
                  *(LAS u32x4*)(L + NA_KW + kswz(kidx, c)) = tk[i]; *(LAS u32x4*)(L + NA_VW + voff(kidx, c)) = tv[i]; } }
            issue(grp == 0 ? u : min(u + 1, u_hi - 1), grp ^ 1);
            __syncthreads();
            if (grp == 0) {
                f32x4 sc[16];
#pragma unroll
                for (int tt = 0; tt < 16; ++tt) {
                    const bf16x8 k0 = *(const LAS bf16x8*)(kc0 + 2048 * tt), k1 = *(const LAS bf16x8*)(kc1 + 2048 * tt);
                    f32x4 z = {0.f, 0.f, 0.f, 0.f}; z = __builtin_amdgcn_mfma_f32_16x16x32_bf16(k0, qp0, z, 0, 0, 0); sc[tt] = __builtin_amdgcn_mfma_f32_16x16x32_bf16(k1, qp1, z, 0, 0, 0); }
                float mx = -INFINITY;
#pragma unroll
                for (int tt = 0; tt < 16; ++tt)
#pragma unroll
                    for (int i = 0; i < 4; ++i) mx = fmaxf(mx, sc[tt][i]);
                mx = fmaxf(mx, __shfl_xor(mx, 16)); mx = fmaxf(mx, __shfl_xor(mx, 32));
                float ls = 0.f;
#pragma unroll
                for (int tt = 0; tt < 16; ++tt)
#pragma unroll
                    for (int i = 0; i < 4; ++i) { const float p = __expf(sc[tt][i] - mx); sc[tt][i] = p; ls += p; }
                ls += __shfl_xor(ls, 16); ls += __shfl_xor(ls, 32);
                mrun = mx; lrun = ls;
#pragma unroll
                for (int uu = 0; uu < 8; ++uu) { const bf16x8 pf = pack8(sc[2 * uu], sc[2 * uu + 1]);
#pragma unroll
                    for (int dt = 0; dt < 4; ++dt) { const s16x4 lo = lds_tr16(vcb + uu * 4096 + dt * 256), hi = lds_tr16(vcb + uu * 4096 + 2048 + dt * 256);
                        const bf16x8 af = {lo[0], lo[1], lo[2], lo[3], hi[0], hi[1], hi[2], hi[3]}; o[dt] = __builtin_amdgcn_mfma_f32_16x16x32_bf16(af, pf, o[dt], 0, 0, 0); } }
            }
            f32x4 sw[8];
#pragma unroll
            for (int tt = 0; tt < 8; ++tt) { const int al = tt >> 1, cg = tt & 1;
                const bf16x8 k0 = *(const LAS bf16x8*)(kwb0 + (al * 64 + 16 * cg) * 128), k1 = *(const LAS bf16x8*)(kwb1 + (al * 64 + 16 * cg) * 128);
                f32x4 z = {0.f, 0.f, 0.f, 0.f}; z = __builtin_amdgcn_mfma_f32_16x16x32_bf16(k0, qr0, z, 0, 0, 0); sw[tt] = __builtin_amdgcn_mfma_f32_16x16x32_bf16(k1, qr1, z, 0, 0, 0); }
            float mx = mrun;
            const LAS float* blg = bl + grp * 256;
#pragma unroll
            for (int tt = 0; tt < 8; ++tt) { const int al = tt >> 1, cg = tt & 1;
#pragma unroll
                for (int i = 0; i < 4; ++i) { const unsigned rel = (unsigned)(kcl + 16 * cg + i); const float s = rel < 16u ? sw[tt][i] + blg[al * 64 + 16 * cg + i] : -INFINITY; sw[tt][i] = s; mx = fmaxf(mx, s); } }
            mx = fmaxf(mx, __shfl_xor(mx, 16)); mx = fmaxf(mx, __shfl_xor(mx, 32));
            const float scale = __expf(mrun - mx); mrun = mx;
            float ls = 0.f;
#pragma unroll
            for (int tt = 0; tt < 8; ++tt)
#pragma unroll
                for (int i = 0; i < 4; ++i) { const float p = __expf(sw[tt][i] - mx); sw[tt][i] = p; ls += p; }
            ls += __shfl_xor(ls, 16); ls += __shfl_xor(ls, 32);
            lrun = lrun * scale + ls;
#pragma unroll
            for (int dt = 0; dt < 4; ++dt) o[dt] = o[dt] * scale;
#pragma unroll
            for (int al = 0; al < 4; ++al) { const bf16x8 pf = pack8(sw[2 * al], sw[2 * al + 1]);
#pragma unroll
                for (int dt = 0; dt < 4; ++dt) { const s16x4 lo = lds_tr16(vwb + al * 8192 + dt * 256), hi = lds_tr16(vwb + al * 8192 + 2048 + dt * 256);
                    const bf16x8 af = {lo[0], lo[1], lo[2], lo[3], hi[0], hi[1], hi[2], hi[3]}; o[dt] = __builtin_amdgcn_mfma_f32_16x16x32_bf16(af, pf, o[dt], 0, 0, 0); } }
        }
        const float inv = 1.0f / lrun;
#pragma unroll
        for (int dt = 0; dt < 4; ++dt) st_bf4(MIXIN + mq * DM + h * 64 + 16 * dt + 4 * g, o[dt] * inv);
    }
}

__device__ __forceinline__ int hg_row(int b, int dir, int c, int j) {
    const int tt = (c < 4 ? 64 * c : 64 * (c - 4)) + j;
    return c < 4 ? MROWS + b * CTXL + (dir ? 255 - tt : tt) : b * SEQ + (dir ? 8191 - tt : tt);
}

constexpr size_t WS_DSEG = 5 * MiB;
constexpr size_t WS_KVSEG = 8 * MiB;
constexpr size_t WS_SINS = 40 * MiB;
constexpr int HG_QD = 0, HG_KD = 16384, HG_KET = 32768, HG_VT = 49152, HG_AT = 65536, HG_ST = 73728, HG_DEC = 75776, HG_END = 76288;
__device__ __forceinline__ int off256(int row, int c) { return row * 256 + ((c ^ (row & 15)) << 4); }
__device__ __forceinline__ int off128(int row, int c) { return row * 128 + ((c ^ ((row >> 1) & 7)) << 4); }

struct HgRaw { float lf[16]; unsigned qv[16], vv[16]; };
template <bool FULL>
__device__ __forceinline__ void hg_load(const Ctx& C, int b, int h, int dir, int c, const float* LF, const bf16* QH, const bf16* IH, HgRaw& r) {
    const int ch = C.tid & 127, tq = C.tid >> 7;
#pragma unroll
    for (int i = 0; i < 16; ++i) { const size_t o = (size_t)hg_row(b, dir, c, 16 * tq + i) * 512 + h * 128 + ch; r.lf[i] = LF[o]; r.vv[i] = IH[o]; r.qv[i] = FULL ? (unsigned)QH[o] : 0u; }
}
template <bool FULL>
__device__ __forceinline__ float hg_prep(const Ctx& C, const HgRaw& r) {
    LAS unsigned char* L = C.lds; LAS float* sT = (LAS float*)(L + HG_ST); LAS float* sDec = (LAS float*)(L + HG_DEC);
    const int ch = C.tid & 127, tq = C.tid >> 7;
    float bl[16]; float run = 0.f;
#pragma unroll
    for (int i = 0; i < 16; ++i) { run += r.lf[i]; bl[i] = run; }
    sT[tq * 128 + ch] = run;
    __syncthreads();
    float off = 0.f, tot = 0.f;
#pragma unroll
    for (int t = 0; t < 4; ++t) { const float x = sT[t * 128 + ch]; off += (t < tq) ? x : 0.f; tot += x; }
    unsigned ke[8], vt[8];
#pragma unroll
    for (int i = 0; i < 16; i += 2) {
        const float b0 = off + bl[i], b1 = off + bl[i + 1];
        const float k0 = 1.0f - __expf(r.lf[i]), k1 = 1.0f - __expf(r.lf[i + 1]);
        ke[i >> 1] = pk2(k0 * __expf(tot - b0), k1 * __expf(tot - b1));
        vt[i >> 1] = r.vv[i] | (r.vv[i + 1] << 16);
        if (FULL) {
            const int t0 = 16 * tq + i;
            *(LAS unsigned short*)(L + HG_QD + off256(t0, ch >> 3) + (ch & 7) * 2) = (unsigned short)f2bf(bf2f(r.qv[i]) * __expf(b0));
            *(LAS unsigned short*)(L + HG_QD + off256(t0 + 1, ch >> 3) + (ch & 7) * 2) = (unsigned short)f2bf(bf2f(r.qv[i + 1]) * __expf(b1));
            *(LAS unsigned short*)(L + HG_KD + off256(t0, ch >> 3) + (ch & 7) * 2) = (unsigned short)f2bf(k0 * __expf(-b0));
            *(LAS unsigned short*)(L + HG_KD + off256(t0 + 1, ch >> 3) + (ch & 7) * 2) = (unsigned short)f2bf(k1 * __expf(-b1));
        }
    }
    *(LAS u32x4*)(L + HG_KET + off128(ch, 2 * tq)) = (u32x4){ke[0], ke[1], ke[2], ke[3]};
    *(LAS u32x4*)(L + HG_KET + off128(ch, 2 * tq + 1)) = (u32x4){ke[4], ke[5], ke[6], ke[7]};
    *(LAS u32x4*)(L + HG_VT + off128(ch, 2 * tq)) = (u32x4){vt[0], vt[1], vt[2], vt[3]};
    *(LAS u32x4*)(L + HG_VT + off128(ch, 2 * tq + 1)) = (u32x4){vt[4], vt[5], vt[6], vt[7]};
    if (tq == 0) sDec[ch] = __expf(tot);
    return tot;
}
__device__ __forceinline__ void hg_update(const Ctx& C, f32x4 (&S)[8]) {
    LAS unsigned char* L = C.lds; const LAS float* sDec = (const LAS float*)(L + HG_DEC);
    const int q = C.lane & 15, g = C.lane >> 4, v0 = 16 * C.wave;
    const bf16x8 vb0 = *(const LAS bf16x8*)(L + HG_VT + off128(v0 + q, g)), vb1 = *(const LAS bf16x8*)(L + HG_VT + off128(v0 + q, 4 + g));
#pragma unroll
    for (int kt = 0; kt < 8; ++kt) { const f32x4 d4 = *(const LAS f32x4*)(sDec + 16 * kt + 4 * g); f32x4 acc = S[kt] * d4;
        const bf16x8 a0 = *(const LAS bf16x8*)(L + HG_KET + off128(16 * kt + q, g)), a1 = *(const LAS bf16x8*)(L + HG_KET + off128(16 * kt + q, 4 + g));
        acc = __builtin_amdgcn_mfma_f32_16x16x32_bf16(a0, vb0, acc, 0, 0, 0); S[kt] = __builtin_amdgcn_mfma_f32_16x16x32_bf16(a1, vb1, acc, 0, 0, 0); }
}

__device__ __forceinline__ void phase_hg_agg(const Ctx& C) {
    const float* LFF = wsp<float>(C, WS_LFF); const float* LFB = wsp<float>(C, WS_LFB); const bf16 *QH = wsp<bf16>(C, WS_QH), *IH = wsp<bf16>(C, WS_IH);
    float* DSEG = wsp<float>(C, WS_DSEG); float* KVSEG = wsp<float>(C, WS_KVSEG);
    const int UPB = (512 + C.G - 1) / C.G, u_lo = blockIdx.x * UPB, u_hi = min(512, u_lo + UPB);
    const int q = C.lane & 15, g = C.lane >> 4;
    const int nsteps = (u_hi - u_lo) * 4;
    HgRaw raw;
    if (nsteps > 0) { const int bhd = u_lo >> 5, seg = u_lo & 31; hg_load<false>(C, bhd >> 3, (bhd >> 1) & 3, bhd & 1, 4 * seg, (bhd & 1) ? LFB : LFF, QH, IH, raw); }
    f32x4 S[8]; float total = 0.f;
#pragma unroll 1
    for (int t = 0; t < nsteps; ++t) {
        const int u = u_lo + (t >> 2), cc = t & 3;
        if (cc == 0) { total = 0.f;
#pragma unroll
            for (int kt = 0; kt < 8; ++kt) S[kt] = (f32x4){0.f, 0.f, 0.f, 0.f}; }
        total += hg_prep<false>(C, raw);
        if (t + 1 < nsteps) { const int un = u_lo + ((t + 1) >> 2), bhd = un >> 5, seg = un & 31; hg_load<false>(C, bhd >> 3, (bhd >> 1) & 3, bhd & 1, 4 * seg + ((t + 1) & 3), (bhd & 1) ? LFB : LFF, QH, IH, raw); }
        __syncthreads();
        hg_update(C, S);
        if (cc == 3) {
            if (C.tid < 128) DSEG[(size_t)u * 128 + C.tid] = __expf(total);
            float* kv = KVSEG + (size_t)u * 16384 + 16 * C.wave + q;
#pragma unroll
            for (int kt = 0; kt < 8; ++kt)
#pragma unroll
                for (int i = 0; i < 4; ++i) kv[(16 * kt + 4 * g + i) * 128] = S[kt][i];
        }
    }
}
__device__ __forceinline__ void phase_hg_scan(const Ctx& C) {
    const float* DSEG = wsp<float>(C, WS_DSEG); const float* KVSEG = wsp<float>(C, WS_KVSEG); float* SIN = wsp<float>(C, WS_SINS);
    for (int e2 = blockIdx.x * NTHR + C.tid; e2 < 16 * 8192; e2 += C.G * NTHR) {
        const int bhd = e2 >> 13, el = (e2 & 8191) * 2, k = el >> 7;
        const float* kv = KVSEG + (size_t)bhd * 32 * 16384 + el; const float* ds = DSEG + (size_t)bhd * 32 * 128 + k; float* so = SIN + (size_t)bhd * 32 * 16384 + el;
        f32x2 cur = *(const f32x2*)kv; *(f32x2*)so = cur;
        f32x2 kvn[8]; float dn[8];
#pragma unroll 1
        for (int s0 = 1; s0 < 32; s0 += 8) {
#pragma unroll
            for (int i = 0; i < 8; ++i) { const int s = min(s0 + i, 31); kvn[i] = *(const f32x2*)(kv + (size_t)s * 16384); dn[i] = ds[s * 128]; }
#pragma unroll
            for (int i = 0; i < 8; ++i) if (s0 + i < 32) { cur = dn[i] * cur + kvn[i]; *(f32x2*)(so + (size_t)(s0 + i) * 16384) = cur; }
        }
    }
}
constexpr int HG_OFS = HG_END;
constexpr int HG_OS = HG_QD;
static_assert(HG_OFS + 256 * 128 * 2 + LDSCTL_BYTES <= LDS_BYTES && 64 * 128 * 4 <= HG_KET, "hg_out LDS map");
__device__ __forceinline__ void phase_hg_out(const Ctx& C) {
    const Args& a = C.a;
    const float* LFF = wsp<float>(C, WS_LFF); const float* LFB = wsp<float>(C, WS_LFB); const bf16 *QH = wsp<bf16>(C, WS_QH), *IH = wsp<bf16>(C, WS_IH), *GH = wsp<bf16>(C, WS_GH);
    const float* SIN = wsp<float>(C, WS_SINS); const float* hgn = a.in[I_HGN]; bf16* MIXIN = wsp<bf16>(C, WS_MIXIN);
    LAS unsigned char* L = C.lds;
    const int UPB = (256 + C.G - 1) / C.G, u_lo = blockIdx.x * UPB, u_hi = min(256, u_lo + UPB);
    const int q = C.lane & 15, g = C.lane >> 4, v0 = 16 * C.wave;
    for (int u = u_lo; u < u_hi; ++u) {
        const int bh = u >> 5, ls = u & 31, b = bh >> 2, h = bh & 3;
        HgRaw raw;
        hg_load<true>(C, b, h, 0, 4 + 4 * ls, LFF, QH, IH, raw);
        f32x4 S[8];
#pragma unroll 1
        for (int step = 0; step < 8; ++step) {
            const int dir = step >> 2, cc = step & 3;
            {
                const int bhd = bh * 2 + dir, segl = dir ? 31 - ls : ls;
                if (cc == 0) { const float* si = SIN + ((size_t)bhd * 32 + segl) * 16384 + v0 + q;
#pragma unroll
                  for (int kt = 0; kt < 8; ++kt)
#pragma unroll
                      for (int i = 0; i < 4; ++i) S[kt][i] = si[(16 * kt + 4 * g + i) * 128]; }
                (void)hg_prep<true>(C, raw);
                if (step < 7) { const int dn = (step + 1) >> 2, sn = dn ? 31 - ls : ls; hg_load<true>(C, b, h, dn, 4 + 4 * sn + ((step + 1) & 3), dn ? LFB : LFF, QH, IH, raw); }
                __syncthreads();
#pragma unroll
                for (int t2 = 0; t2 < 2; ++t2) { const int id = 2 * C.wave + t2, st = id >> 2, jt = id & 3;
                    f32x4 acc = {0.f, 0.f, 0.f, 0.f};
                    if (st <= jt) {
#pragma unroll
                        for (int ks = 0; ks < 4; ++ks) { const bf16x8 ka = *(const LAS bf16x8*)(L + HG_KD + off256(16 * st + q, 4 * ks + g)), qb = *(const LAS bf16x8*)(L + HG_QD + off256(16 * jt + q, 4 * ks + g));
                            acc = __builtin_amdgcn_mfma_f32_16x16x32_bf16(ka, qb, acc, 0, 0, 0); }
#pragma unroll
                        for (int i = 0; i < 4; ++i) if (16 * st + 4 * g + i > 16 * jt + q) acc[i] = 0.f;
                    }
                    u32x2 w; w.x = pk2(acc[0], acc[1]); w.y = pk2(acc[2], acc[3]);
                    *(LAS u32x2*)(L + HG_AT + off128(16 * jt + q, 2 * st + (g >> 1)) + (g & 1) * 8) = w; }
                __syncthreads();
                f32x4 o[4];
#pragma unroll
                for (int jt = 0; jt < 4; ++jt) o[jt] = (f32x4){0.f, 0.f, 0.f, 0.f};
                { const bf16x8 vb0 = *(const LAS bf16x8*)(L + HG_VT + off128(v0 + q, g)), vb1 = *(const LAS bf16x8*)(L + HG_VT + off128(v0 + q, 4 + g));
#pragma unroll
                  for (int jt = 0; jt < 4; ++jt) { const bf16x8 a0 = *(const LAS bf16x8*)(L + HG_AT + off128(16 * jt + q, g)), a1 = *(const LAS bf16x8*)(L + HG_AT + off128(16 * jt + q, 4 + g));
                      o[jt] = __builtin_amdgcn_mfma_f32_16x16x32_bf16(a0, vb0, o[jt], 0, 0, 0); o[jt] = __builtin_amdgcn_mfma_f32_16x16x32_bf16(a1, vb1, o[jt], 0, 0, 0); } }
#pragma unroll
                for (int sp = 0; sp < 4; ++sp) { const bf16x8 sb = pack8(S[2 * sp], S[2 * sp + 1]);
#pragma unroll
                    for (int jt = 0; jt < 4; ++jt) { const int row = 16 * jt + q;
                        const s16x4 lo = *(const LAS s16x4*)(L + HG_QD + off256(row, 4 * sp + (g >> 1)) + (g & 1) * 8), hi = *(const LAS s16x4*)(L + HG_QD + off256(row, 4 * sp + 2 + (g >> 1)) + (g & 1) * 8);
                        const bf16x8 af = {lo[0], lo[1], lo[2], lo[3], hi[0], hi[1], hi[2], hi[3]};
                        o[jt] = __builtin_amdgcn_mfma_f32_16x16x32_bf16(af, sb, o[jt], 0, 0, 0); } }
                if (dir == 0) {
#pragma unroll
                    for (int jt = 0; jt < 4; ++jt)
#pragma unroll
                        for (int i = 0; i < 4; ++i) *(LAS unsigned short*)(L + HG_OFS + (64 * cc + 16 * jt + 4 * g + i) * 256 + (v0 + q) * 2) = (unsigned short)f2bf(o[jt][i]);
                    if (cc < 3) hg_update(C, S);
                } else {
#pragma unroll
                    for (int jt = 0; jt < 4; ++jt)
#pragma unroll
                        for (int i = 0; i < 4; ++i) o[jt][i] += bf2f(*(const LAS unsigned short*)(L + HG_OFS + (255 - 64 * cc - (16 * jt + 4 * g + i)) * 256 + (v0 + q) * 2));
                    if (cc < 3) hg_update(C, S);
                    __syncthreads();
#pragma unroll
                    for (int jt = 0; jt < 4; ++jt)
#pragma unroll
                        for (int i = 0; i < 4; ++i) *(LAS float*)(L + HG_OS + ((16 * jt + 4 * g + i) * 128 + v0 + q) * 4) = o[jt][i];
                    unsigned gwp[8];
#pragma unroll
                    for (int jj = 0; jj < 8; ++jj) { const size_t row = (size_t)b * SEQ + 256 * ls + 255 - 64 * cc - (8 * C.wave + jj); gwp[jj] = *(const unsigned*)(GH + row * 512 + h * 128 + 2 * C.lane); }
                    __syncthreads();
#pragma unroll
                    for (int jj = 0; jj < 8; ++jj) { const int j = 8 * C.wave + jj; const size_t row = (size_t)b * SEQ + 256 * ls + 255 - 64 * cc - j;
                        const f32x2 ov = *(const LAS f32x2*)(L + HG_OS + (j * 128 + 2 * C.lane) * 4);
                        const float rstd = 1.0f / sqrtf(wave_sum(ov.x * ov.x + ov.y * ov.y) * (1.0f / 128.0f) + RMS_EPS);
                        const unsigned gw2 = gwp[jj]; const f32x2 nn = *(const f32x2*)(hgn + 2 * C.lane);
                        *(unsigned*)(MIXIN + row * DM + 512 + h * 128 + 2 * C.lane) = pk2(ov.x * rstd * nn.x * sigmoidf_(bflo(gw2)), ov.y * rstd * nn.y * sigmoidf_(bfhi(gw2))); }
                }
            }
        }
    }
}

__device__ __forceinline__ void phase_rowpass(const Ctx& C) {
    const Args& a = C.a;
    LAS float* sW = (LAS float*)C.lds;
    { const float* WRT = wsp<float>(C, WS_WRT);
#pragma unroll 4
      for (int i = 0; i < 8; ++i) { const int idx = C.tid + 512 * i; *(LAS f32x4*)(sW + 4 * idx) = *(const f32x4*)(WRT + 4 * idx); } }
    __syncthreads();
    const float *MIX = wsp<float>(C, WS_MIX), *modf = wsp<float>(C, WS_MODF); float* AFF = wsp<float>(C, WS_AFF); unsigned char* H2 = C.ws + WS_H2;
    const int gw = blockIdx.x * NWAVES + C.wave, NGW = C.G * NWAVES;
    const int b5 = (C.lane >> 5) & 1, b4 = (C.lane >> 4) & 1, b3 = (C.lane >> 3) & 1, b2 = (C.lane >> 2) & 1, myexp = 8 * b5 + 4 * b4 + 2 * b3 + b2;
    f32x4 mx[2][4], xv[2][4], mxn[2][4], xvn[2][4];
    if (2 * gw < MROWS) {
#pragma unroll
        for (int r = 0; r < 2; ++r)
#pragma unroll
            for (int j = 0; j < 4; ++j) { const size_t o = (size_t)(2 * gw + r) * DM + 4 * (C.lane + 64 * j); mxn[r][j] = *(const f32x4*)(MIX + o); xvn[r][j] = *(const f32x4*)(a.in[I_X] + o); } }
    for (int row0 = 2 * gw; row0 < MROWS; row0 += 2 * NGW) {
        const int b = row0 >> 13; const float* mf = modf + b * 6144;
        float ss[2];
#pragma unroll
        for (int r = 0; r < 2; ++r) { ss[r] = 0.f;
#pragma unroll
            for (int j = 0; j < 4; ++j) { mx[r][j] = mxn[r][j]; xv[r][j] = xvn[r][j]; } }
        if (row0 + 2 * NGW < MROWS) {
#pragma unroll
            for (int r = 0; r < 2; ++r)
#pragma unroll
                for (int j = 0; j < 4; ++j) { const size_t o = (size_t)(row0 + 2 * NGW + r) * DM + 4 * (C.lane + 64 * j); mxn[r][j] = *(const f32x4*)(MIX + o); xvn[r][j] = *(const f32x4*)(a.in[I_X] + o); } }
#pragma unroll
        for (int r = 0; r < 2; ++r)
#pragma unroll
            for (int j = 0; j < 4; ++j) ss[r] += (mx[r][j].x * mx[r][j].x + mx[r][j].y * mx[r][j].y) + (mx[r][j].z * mx[r][j].z + mx[r][j].w * mx[r][j].w);
#pragma unroll
        for (int o = 1; o < 64; o <<= 1) { ss[0] += __shfl_xor(ss[0], o); ss[1] += __shfl_xor(ss[1], o); }
        float ss2[2] = {0.f, 0.f};
#pragma unroll
        for (int j = 0; j < 4; ++j) { const int ch = 4 * (C.lane + 64 * j); const f32x4 c1 = *(const f32x4*)(a.in[I_GPOST1] + ch) * *(const f32x4*)(mf + 2048 + ch);
#pragma unroll
            for (int r = 0; r < 2; ++r) { const float rstd1 = 1.0f / sqrtf(ss[r] * (1.0f / DM) + RMS_EPS);
                xv[r][j] = xv[r][j] + c1 * (mx[r][j] * rstd1); *(f32x4*)(a.out + (size_t)(row0 + r) * DM + ch) = xv[r][j];
                ss2[r] += (xv[r][j].x * xv[r][j].x + xv[r][j].y * xv[r][j].y) + (xv[r][j].z * xv[r][j].z + xv[r][j].w * xv[r][j].w); } }
#pragma unroll
        for (int o = 1; o < 64; o <<= 1) { ss2[0] += __shfl_xor(ss2[0], o); ss2[1] += __shfl_xor(ss2[1], o); }
#pragma unroll
        for (int j = 0; j < 4; ++j) { const int ch = 4 * (C.lane + 64 * j); const f32x4 c2 = *(const f32x4*)(a.in[I_GPRE2] + ch) * (1.0f + *(const f32x4*)(mf + 4096 + ch)), sh = *(const f32x4*)(mf + 3072 + ch);
#pragma unroll
            for (int r = 0; r < 2; ++r) { const float rstd2 = 1.0f / sqrtf(ss2[r] * (1.0f / DM) + RMS_EPS);
                xv[r][j] = xv[r][j] * (rstd2 * c2) + sh; *(unsigned*)(H2 + (size_t)(row0 + r) * DM + ch) = pk4_fp8(xv[r][j].x * H2_SCALE, xv[r][j].y * H2_SCALE, xv[r][j].z * H2_SCALE, xv[r][j].w * H2_SCALE); } }
#pragma unroll
        for (int r = 0; r < 2; ++r) {
            float lg[16];
#pragma unroll
            for (int e = 0; e < 16; ++e) { float p = 0.f;
#pragma unroll
                for (int j = 0; j < 4; ++j) { const f32x4 w = *(const LAS f32x4*)(sW + e * 1024 + 4 * (C.lane + 64 * j)); const f32x4 h = xv[r][j]; p += (h.x * w.x + h.y * w.y) + (h.z * w.z + h.w * w.w); }
                lg[e] = p; if ((e & 3) == 3) asm volatile("" ::: "memory"); }
            float l8[8], l4[4], l2[2], l1;
#pragma unroll
            for (int e = 0; e < 8; ++e) { const float keep = b5 ? lg[e + 8] : lg[e], send = b5 ? lg[e] : lg[e + 8]; l8[e] = keep + __shfl_xor(send, 32); }
#pragma unroll
            for (int e = 0; e < 4; ++e) { const float keep = b4 ? l8[e + 4] : l8[e], send = b4 ? l8[e] : l8[e + 4]; l4[e] = keep + __shfl_xor(send, 16); }
#pragma unroll
            for (int e = 0; e < 2; ++e) { const float keep = b3 ? l4[e + 2] : l4[e], send = b3 ? l4[e] : l4[e + 2]; l2[e] = keep + __shfl_xor(send, 8); }
            { const float keep = b2 ? l2[1] : l2[0], send = b2 ? l2[0] : l2[1]; l1 = keep + __shfl_xor(send, 4); }
            l1 += __shfl_xor(l1, 2); l1 += __shfl_xor(l1, 1);
            float mxl = l1;
#pragma unroll
            for (int o = 4; o < 64; o <<= 1) mxl = fmaxf(mxl, __shfl_xor(mxl, o));
            const float p = expf(l1 - mxl); float den = p;
#pragma unroll
            for (int o = 4; o < 64; o <<= 1) den += __shfl_xor(den, o);
            if ((C.lane & 3) == 0) AFF[((size_t)b * 16 + myexp) * SEQ + ((row0 + r) & 8191)] = p / den;
        }
    }
}

__device__ __forceinline__ void phase_topk(const Ctx& C) {
    if (blockIdx.x >= 32) { convert_tiles(C, CV_D1_END, CV_NT, (int)blockIdx.x - 32, C.G - 32); return; }
    const int list = blockIdx.x, b = list >> 4, e = list & 15;
    LAS unsigned* keys = (LAS unsigned*)C.lds;
    LAS unsigned* hist = keys + 8192;
    volatile LAS unsigned* misc = hist + 256;
    LAS unsigned* wtot = hist + 256 + 8;
    const float* AFF = wsp<float>(C, WS_AFF) + (size_t)list * SEQ;
#pragma unroll
    for (int i = 0; i < 4; ++i) *(LAS u32x4*)(keys + 4 * (C.tid + 512 * i)) = *(const u32x4*)(AFF + 4 * (C.tid + 512 * i));
    if (C.tid == 0) { misc[0] = 0u; misc[1] = (unsigned)CAP; }
    __syncthreads();
    unsigned prefix = 0u, mask = 0u;
    for (int pass = 3; pass >= 0; --pass) {
        if (C.tid < 256) hist[C.tid] = 0u;
        __syncthreads();
#pragma unroll
        for (int i = 0; i < 16; ++i) { const unsigned key = keys[C.tid + 512 * i]; if ((key & mask) == prefix) atomicAdd((unsigned*)&hist[(key >> (8 * pass)) & 255u], 1u); }
        __syncthreads();
        if (C.wave == 0) {
            const u32x4 h4 = *(const LAS u32x4*)(hist + 4 * C.lane); const unsigned s = h4.x + h4.y + h4.z + h4.w; unsigned inc = s;
#pragma unroll
            for (int o = 1; o < 64; o <<= 1) { const unsigned t = __shfl_down(inc, o); if (C.lane + o < 64) inc += t; }
            const unsigned need = misc[1]; unsigned cum = inc - s;
            int chosen = -1; unsigned nn = 0u;
            if (cum < need && need <= cum + h4.w) { chosen = 4 * C.lane + 3; nn = need - cum; } cum += h4.w;
            if (cum < need && need <= cum + h4.z) { chosen = 4 * C.lane + 2; nn = need - cum; } cum += h4.z;
            if (cum < need && need <= cum + h4.y) { chosen = 4 * C.lane + 1; nn = need - cum; } cum += h4.y;
            if (cum < need && need <= cum + h4.x) { chosen = 4 * C.lane + 0; nn = need - cum; }
            if (chosen >= 0) { misc[0] = prefix | ((unsigned)chosen << (8 * pass)); misc[1] = nn; }
        }
        __syncthreads();
        prefix = misc[0]; mask |= 0xFFu << (8 * pass);
    }
    const unsigned T = prefix, need_eq = misc[1];
    const int base = C.tid * 16; unsigned cgt = 0u, ceq = 0u; unsigned kk[16];
#pragma unroll
    for (int i = 0; i < 4; ++i) { const u32x4 k4 = *(const LAS u32x4*)(keys + base + 4 * i); kk[4 * i] = k4.x; kk[4 * i + 1] = k4.y; kk[4 * i + 2] = k4.z; kk[4 * i + 3] = k4.w; }
#pragma unroll
    for (int i = 0; i < 16; ++i) { cgt += kk[i] > T ? 1u : 0u; ceq += kk[i] == T ? 1u : 0u; }
    unsigned ig = cgt, ie = ceq;
#pragma unroll
    for (int o = 1; o < 64; o <<= 1) { const unsigned tg = __shfl_up(ig, o), te = __shfl_up(ie, o); if (C.lane >= o) { ig += tg; ie += te; } }
    if (C.lane == 63) { wtot[C.wave] = ig; wtot[8 + C.wave] = ie; }
    __syncthreads();
    unsigned gpre = ig - cgt, epre = ie - ceq;
    for (int w = 0; w < C.wave; ++w) { gpre += wtot[w]; epre += wtot[8 + w]; }
    int* IDX = wsp<int>(C, WS_IDX) + list * CAP; float* GATEV = wsp<float>(C, WS_GATEV) + (e * 2 + b) * CAP; int* SLOT = wsp<int>(C, WS_SLOT);
#pragma unroll
    for (int i = 0; i < 16; ++i) { const int t = base + i; const unsigned key = kk[i]; int pos = -1;
        if (key > T) { pos = (int)(gpre + min(epre, need_eq)); ++gpre; }
        else if (key == T) { if (epre < need_eq) pos = (int)(gpre + epre); ++epre; }
        if (pos >= 0) { IDX[pos] = t; GATEV[pos] = __builtin_bit_cast(float, key); }
        SLOT[((size_t)b * SEQ + t) * 16 + e] = pos; }
}

__device__ __forceinline__ void phase_final(const Ctx& C) {
    const Args& a = C.a;
    const int gw = blockIdx.x * NWAVES + C.wave, NGW = C.G * NWAVES;
    const int* SLOT = wsp<int>(C, WS_SLOT); const bf16* YS = wsp<bf16>(C, WS_YS); const float* modf = wsp<float>(C, WS_MODF);
    for (int row = gw; row < MROWS; row += NGW) {
        const int b = row >> 13; const float* mf = modf + b * 6144;
        const int sv = SLOT[(size_t)row * 16 + (C.lane & 15)];
        f32x4 x1[4];
#pragma unroll
        for (int j = 0; j < 4; ++j) x1[j] = *(const f32x4*)(a.out + (size_t)row * DM + 4 * (C.lane + 64 * j));
        unsigned long long mask = __ballot(sv >= 0) & 0xFFFFull;
        f32x4 acc[4];
#pragma unroll
        for (int j = 0; j < 4; ++j) acc[j] = (f32x4){0.f, 0.f, 0.f, 0.f};
        while (mask) {
            const int e0 = __builtin_ctzll(mask); mask &= mask - 1; const bool two = mask != 0ull; const int e1 = two ? __builtin_ctzll(mask) : e0; mask &= mask - 1;
            const bf16* y0 = YS + ((size_t)(e0 * 2 + b) * CAP + __builtin_amdgcn_readlane(sv, e0)) * DM; const bf16* y1 = YS + ((size_t)(e1 * 2 + b) * CAP + __builtin_amdgcn_readlane(sv, e1)) * DM;
            u32x2 w0[4], w1[4];
#pragma unroll
            for (int j = 0; j < 4; ++j) { w0[j] = *(const u32x2*)(y0 + 4 * (C.lane + 64 * j)); w1[j] = *(const u32x2*)(y1 + 4 * (C.lane + 64 * j)); }
            const float f1 = two ? 1.f : 0.f;
#pragma unroll
            for (int j = 0; j < 4; ++j) { acc[j].x += bflo(w0[j].x) + f1 * bflo(w1[j].x); acc[j].y += bfhi(w0[j].x) + f1 * bfhi(w1[j].x); acc[j].z += bflo(w0[j].y) + f1 * bflo(w1[j].y); acc[j].w += bfhi(w0[j].y) + f1 * bfhi(w1[j].y); } }
        float ss = 0.f;
#pragma unroll
        for (int j = 0; j < 4; ++j) ss += (acc[j].x * acc[j].x + acc[j].y * acc[j].y) + (acc[j].z * acc[j].z + acc[j].w * acc[j].w);
        const float rstd = 1.0f / sqrtf(wave_sum(ss) * (1.0f / DM) + RMS_EPS);
#pragma unroll
        for (int j = 0; j < 4; ++j) { const int ch = 4 * (C.lane + 64 * j);
            const f32x4 gp = *(const f32x4*)(a.in[I_GPOST2] + ch), gt = *(const f32x4*)(mf + 5120 + ch);
            *(f32x4*)(a.out + (size_t)row * DM + ch) = x1[j] + gt * (acc[j] * rstd * gp); }
    }
}

constexpr int GTAB_OFF = 131072;
__device__ __forceinline__ void phase_gemm_in(const Ctx& C) {
    const int Mg = MTOT;
    pg8::Gemm g{wsp<bf16>(C, WS_H), wsp<bf16>(C, WS_WINT), Mg, NINC, DM, 0, 0, 0}; pg8::StaticOrder S; S.init(Mg, NINC, C.G, (int)blockIdx.x);
    LAS float* tb = (LAS float*)(C.lds + GTAB_OFF);
    for (int i = C.tid; i < 2048; i += NTHR) { tb[i] = wsp<float>(C, WS_COS)[i]; tb[2048 + i] = wsp<float>(C, WS_SIN)[i]; }
    if (C.tid < 512) tb[4096 + C.tid] = wsp<float>(C, WS_LB)[C.tid];
    __syncthreads();
    EpiIn E{wsp<bf16>(C, WS_QP), wsp<bf16>(C, WS_QR), wsp<bf16>(C, WS_KR), wsp<bf16>(C, WS_V), wsp<bf16>(C, WS_QH), wsp<bf16>(C, WS_IH), wsp<bf16>(C, WS_GH),
            wsp<float>(C, WS_LFF), wsp<float>(C, WS_LFB), tb + 4096, tb, tb + 2048};
    const int nt_ = (Mg / 256) * (NINC / 256), rounds = (nt_ + C.G - 1) / C.G, lrt = nt_ - (rounds - 1) * C.G; const bool allc = lrt >= C.G;
    const bool conv = C.G > 32 && (allc || (int)blockIdx.x >= lrt); const int widx = allc ? (int)blockIdx.x : (int)blockIdx.x - lrt, nconv = allc ? C.G : C.G - lrt;
    if (conv && (widx & 1) == 0) { convert_tiles(C, CV_P0_END, CV_D1_END, widx, nconv); __syncthreads(); }
    pg8::gemm_phase<EpiIn, pg8::StaticOrder, true, true>(C.lds, g, S, E);
    if (conv && (widx & 1) == 1) convert_tiles(C, CV_P0_END, CV_D1_END, widx, nconv);
}
__device__ __forceinline__ void phase_gemm_out(const Ctx& C) {
    pg8::Gemm g{wsp<bf16>(C, WS_MIXIN), wsp<bf16>(C, WS_WOUTT), MROWS, DM, DM, 0, 0, 0}; pg8::StaticOrder S; S.init(MROWS, DM, C.G, (int)blockIdx.x);
    EpiF32 E{wsp<float>(C, WS_MIX), DM};
    pg8::gemm_phase<EpiF32, pg8::StaticOrder, true, true>(C.lds, g, S, E);
}
static_assert(LDSCTL_BYTES + GTAB_OFF + 23 * 1024 <= LDS_BYTES, "gather table");
__device__ __forceinline__ void phase_gemm1(const Ctx& C) {
    pg8::StaticOrder S; S.init(MEXP, N1P, C.G, (int)blockIdx.x);
    {
        const int* IDX = wsp<int>(C, WS_IDX); LAS int* tab = (LAS int*)(C.lds + GTAB_OFF); pg8::Unit u;
        for (int i = 0; i < 23 && S.next(i, u); ++i)
            if (C.tid < 256) { const int e = u.pm >> 3, b = (u.pm >> 2) & 1; tab[i * 256 + C.tid] = b * SEQ + IDX[(b * 16 + e) * CAP + (u.pm & 3) * 256 + C.tid]; }
        __syncthreads();
    }
    pg8::Gemm g{wsp<bf16>(C, WS_H2), wsp<bf16>(C, WS_W1T), MEXP, N1P, DM / 2, 3, (size_t)N1P * DM, GTAB_OFF};
    EpiHid E{C.ws + WS_HID};
    pg8::gemm_phase<EpiHid, pg8::StaticOrder, true, true, true, true>(C.lds, g, S, E);
}
__device__ __forceinline__ void phase_gemm2(const Ctx& C) {
    pg8::Gemm g{wsp<bf16>(C, WS_HID), wsp<bf16>(C, WS_W2T), MEXP, DM, FEP / 2, 3, (size_t)DM * FEP, 0}; pg8::StaticOrder S; S.init(MEXP, DM, C.G, (int)blockIdx.x);
    EpiYs E{wsp<bf16>(C, WS_YS), wsp<float>(C, WS_GATEV)};
    pg8::gemm_phase<EpiYs, pg8::StaticOrder, true, true, false, true>(C.lds, g, S, E);
}

__global__ void __launch_bounds__(NTHR, 2) fwd_kernel(Args args) {
    extern __shared__ __attribute__((aligned(16))) unsigned char lds_raw[];
    Ctx C; C.lds = (LAS unsigned char*)lds_raw + LDSCTL_BYTES; C.tid = threadIdx.x; C.lane = C.tid & 63; C.wave = __builtin_amdgcn_readfirstlane(C.tid >> 6); C.G = gridDim.x; C.a = args; C.ws = args.ws;
    if (C.tid < LDSCTL_BYTES / 4) ((LAS unsigned*)lds_raw)[C.tid] = 0u;
    __syncthreads();
    const bool multi = (args.ph_hi - args.ph_lo) > 1;
    XcdBarrier bar; bar.bar = (unsigned*)(C.ws + WS_CTL) + CW_BAR; bar.x = 0; bar.st = nullptr;
    if (multi) bar = xcd_barrier_post((unsigned*)(C.ws + WS_CTL) + CW_BAR, (volatile LAS unsigned*)((LAS unsigned char*)lds_raw) + 8);
    const int lo = args.ph_lo, hi = args.ph_hi;
#define IN(k) (lo <= (k) && (k) < hi)
#define SEAM(k) do { if ((k) + 1 < hi) xcd_barrier(bar); } while (0)
#if PH_ON(0)
    if (IN(0)) { for (int rep = 0; rep < 1 + REP_ON(0); ++rep) { phase_prologue(C); __syncthreads(); } SEAM(0); }
#endif
#if PH_ON(1)
    if (IN(1)) { for (int rep = 0; rep < 1 + REP_ON(1); ++rep) { phase_hrows(C); __syncthreads(); } SEAM(1); }
#endif
#if PH_ON(2)
    if (IN(2)) { for (int rep = 0; rep < 1 + REP_ON(2); ++rep) { phase_gemm_in(C); __syncthreads(); } SEAM(2); }
#endif
#if PH_ON(3)
    if (IN(3)) { for (int rep = 0; rep < 1 + REP_ON(3); ++rep) { phase_na(C); __syncthreads(); phase_hg_agg(C); __syncthreads(); } SEAM(3); }
#endif
#if PH_ON(4)
    if (IN(4)) { for (int rep = 0; rep < 1 + REP_ON(4); ++rep) { phase_hg_scan(C); __syncthreads(); } SEAM(4); }
#endif
#if PH_ON(5)
    if (IN(5)) { for (int rep = 0; rep < 1 + REP_ON(5); ++rep) { phase_hg_out(C); __syncthreads(); } SEAM(5); }
#endif
#if PH_ON(6)
    if (IN(6)) { for (int rep = 0; rep < 1 + REP_ON(6); ++rep) { phase_gemm_out(C); __syncthreads(); } SEAM(6); }
#endif
#if PH_ON(7)
    if (IN(7)) { for (int rep = 0; rep < 1 + REP_ON(7); ++rep) { phase_rowpass(C); __syncthreads(); } SEAM(7); }
#endif
#if PH_ON(8)
    if (IN(8)) { for (int rep = 0; rep < 1 + REP_ON(8); ++rep) { phase_topk(C); __syncthreads(); } SEAM(8); }
#endif
#if PH_ON(9)
    if (IN(9)) { for (int rep = 0; rep < 1 + REP_ON(9); ++rep) { phase_gemm1(C); __syncthreads(); } SEAM(9); }
#endif
#if PH_ON(10)
    if (IN(10)) { for (int rep = 0; rep < 1 + REP_ON(10); ++rep) { phase_gemm2(C); __syncthreads(); } SEAM(10); }
#endif
#if PH_ON(11)
    if (IN(11)) { for (int rep = 0; rep < 1 + REP_ON(11); ++rep) { phase_final(C); __syncthreads(); } SEAM(11); }
#endif
#undef IN
#undef SEAM
}

extern "C" void kernel_launch(void* const* d_in, const int* in_sizes, int n_in, void* d_out, int out_size, void* d_ws, size_t ws_size, hipStream_t stream) {
    static int grid = 0;
    if (grid == 0) {
        if (n_in != 19 || out_size != MROWS * DM || ws_size < WS_END) { fprintf(stderr, "kernel_launch: unexpected problem (n_in %d out %d ws %zu)\n", n_in, out_size, ws_size); grid = -1; return; }
        int dev = 0, cus = 0, per_cu = 0;
        if (hipGetDevice(&dev) != hipSuccess || hipDeviceGetAttribute(&cus, hipDeviceAttributeMultiprocessorCount, dev) != hipSuccess) { grid = -1; return; }
        if (hipFuncSetAttribute((const void*)fwd_kernel, hipFuncAttributeMaxDynamicSharedMemorySize, LDS_BYTES) != hipSuccess) { fprintf(stderr, "kernel_launch: hipFuncSetAttribute failed\n"); grid = -1; return; }
        if (hipOccupancyMaxActiveBlocksPerMultiprocessor(&per_cu, (const void*)fwd_kernel, NTHR, LDS_BYTES) != hipSuccess || per_cu < 1) { fprintf(stderr, "kernel_launch: occupancy query says %d\n", per_cu); }
        (void)hipGetLastError();
        grid = cus;
    }
    if (grid < 0) return;
    (void)hipMemsetAsync((char*)d_ws + WS_CTL, 0, CTL_ZERO_BYTES, stream);
    Args a{};
    for (int i = 0; i < 19; ++i) a.in[i] = (const float*)d_in[i];
    a.out = (float*)d_out; a.ws = (unsigned char*)d_ws;
#if MK_N_LAUNCHES == 1
    a.ph_lo = 0; a.ph_hi = NPHASE;
    hipLaunchKernelGGL(fwd_kernel, dim3(grid), dim3(NTHR), LDS_BYTES, stream, a);
#else
    for (int ph = 0; ph < NPHASE; ++ph) { a.ph_lo = ph; a.ph_hi = ph + 1; hipLaunchKernelGGL(fwd_kernel, dim3(grid), dim3(NTHR), LDS_BYTES, stream, a); }
#endif
}
```

```cpp
#include <hip/hip_runtime.h>
#include <cstdio>
#include <cstdint>
#include <cmath>
namespace pg8 {
#define PG8_LAS __attribute__((address_space(3)))
typedef unsigned short bf16_t;
typedef short bf16x8 __attribute__((ext_vector_type(8)));
typedef float f32x4 __attribute__((ext_vector_type(4)));
typedef unsigned u32x4 __attribute__((ext_vector_type(4)));
constexpr int BM = 256, BK = 64, HALF = 128, HTB = HALF * BK * 2  , STAGE_BYTES = 8 * HTB, NXCD = 8, WGM = 8;

__host__ __device__ __forceinline__ int lds_byte(int r, int c) { const int st = (r >> 4) * 2 + (c >> 5), rr = r & 15, cc = c & 31, ob = rr * 64 + cc * 2; return st * 1024 + (ob ^ (((ob >> 9) & 1) << 5)); }
__host__ __device__ __forceinline__ void stage_rc(int b, int& R, int& C) { const int st = b / 1024, sb = b % 1024, swz = sb ^ (((sb >> 9) & 1) << 5); R = (st >> 1) * 16 + swz / 64; C = (st & 1) * 32 + (swz % 64) / 2; }
__host__ __device__ __forceinline__ int perm32(int rho) { const int n = rho >> 4, i = rho & 15; return 8 * (i >> 2) + 4 * n + (i & 3); }

struct Unit { int pm, pn; };
struct Gemm { const bf16_t* A; const bf16_t* Bt; int M, N, K; int gshift; size_t gstride; int glds; };

struct StaticOrder {
    int nM, nN, nwg, G, c;
    __host__ __device__ void init(int M, int N, int G_, int c_) { nM = M / BM; nN = N / BM; nwg = nM * nN; G = G_; c = c_; }
    __host__ __device__ bool next(int i, Unit& u) const {
        const long L = (long)i * G + c; if (L >= nwg) return false;
        int wgid = (int)L; { const int q = nwg / NXCD, r = nwg % NXCD, xcd = wgid % NXCD, off = wgid / NXCD; wgid = (xcd < r ? xcd * (q + 1) : r * (q + 1) + (xcd - r) * q) + off; }
        const int nig = WGM * nN, gid = wgid / nig, fm = gid * WGM, gsz = (nM - fm) < WGM ? (nM - fm) : WGM;
        u.pm = fm + ((wgid % nig) % gsz); u.pn = (wgid % nig) / gsz; return true;
    }
    __device__ __forceinline__ void a_ready(const Unit&) const {}
    __device__ __forceinline__ void done(const Unit&) const {}
};


typedef int i32x4 __attribute__((ext_vector_type(4)));
typedef int i32x8 __attribute__((ext_vector_type(8)));
__device__ __forceinline__ i32x8 cat8(bf16x8 a, bf16x8 b) { return __builtin_shufflevector(__builtin_bit_cast(i32x4, a), __builtin_bit_cast(i32x4, b), 0, 1, 2, 3, 4, 5, 6, 7); }
template <class Epi, class Sched, bool ALIGN_EPI = false, bool SP2 = false, bool GATHER = false, bool FP8 = false>
__device__ __forceinline__ void gemm_phase(PG8_LAS unsigned char* lds, const Gemm g, const Sched& S, const Epi& E) {
    const int tid = threadIdx.x, wid = __builtin_amdgcn_readfirstlane(tid >> 6), lane = tid & 63, wr = wid >> 2, wc = wid & 3, fr = lane & 15, fq = lane >> 4;
    const int K = g.K, nt = K / BK;
    unsigned voffA[2], voffB[2];
#pragma unroll
    for (int i = 0; i < 2; ++i) { int R, C; stage_rc(tid * 16 + i * 8192, R, C); const int Rb = Epi::PERM ? ((R & ~31) + perm32(R & 31)) : R;
        voffA[i] = (unsigned)(R * K + C) * 2u; voffB[i] = (unsigned)(Rb * K + C) * 2u; }
    unsigned vc0[2] = {0u, 0u}, vc1[2] = {0u, 0u}, vn0[2] = {0u, 0u}, vn1[2] = {0u, 0u}; int gR[2] = {0, 0}; unsigned gC2[2] = {0u, 0u};
    if constexpr (GATHER) {
#pragma unroll
        for (int i = 0; i < 2; ++i) { int R, C; stage_rc(tid * 16 + i * 8192, R, C); gR[i] = R; gC2[i] = (unsigned)C * 2u; } }
#define PG8_GATHER_OFFS(ui_, o0, o1) do { const PG8_LAS int* ip_ = (const PG8_LAS int*)(lds + g.glds) + (ui_) * 256; \
        _Pragma("unroll") for (int i_ = 0; i_ < 2; ++i_) { o0[i_] = (unsigned)ip_[gR[i_]] * (unsigned)(K * 2) + gC2[i_]; o1[i_] = (unsigned)ip_[128 + gR[i_]] * (unsigned)(K * 2) + gC2[i_]; } } while (0)
#define PG8_STAGE_A0(bufoff, gbase, nx) do { if constexpr (GATHER) { if (nx) PG8_STAGE(bufoff, gbase, vn0); else PG8_STAGE(bufoff, gbase, vc0); } else PG8_STAGE(bufoff, gbase, voffA); } while (0)
#define PG8_STAGE_A1(bufoff, gbase, nx) do { if constexpr (GATHER) { if (nx) PG8_STAGE(bufoff, gbase, vn1); else PG8_STAGE(bufoff, gbase, vc1); } else PG8_STAGE(bufoff, (gbase) + hstep, voffA); } while (0)
    const size_t kstep = (size_t)(BK * 2);
    const size_t hstep = (size_t)HALF * K * 2;
    const size_t tstep = 2 * hstep;
    const unsigned ldsw = (unsigned)wid * 1024u;
    const int aoff = lds_byte(wr * 64 + fr, fq * 8), boff = lds_byte(wc * 32 + fr, fq * 8);
#define PG8_SA(b, h) (((b) * 2 + (h)) * HTB)
#define PG8_SB(b, h) ((4 + (b) * 2 + (h)) * HTB)
#define PG8_STAGE(bufoff, gbase, voff) do { _Pragma("unroll") for (int _i = 0; _i < 2; ++_i) \
        __builtin_amdgcn_global_load_lds((const unsigned*)((const char*)(gbase) + (voff)[_i]), (PG8_LAS unsigned*)(lds + (bufoff) + ldsw + _i * 8192), 16, 0, 0); } while (0)
#define PG8_LDA(dst, b, h) do { _Pragma("unroll") for (int m = 0; m < 4; ++m) { dst[m].lo = *(const PG8_LAS i32x4*)(lds + PG8_SA(b, h) + aoff + m * 2048); dst[m].hi = *(const PG8_LAS i32x4*)(lds + PG8_SA(b, h) + aoff + m * 2048 + 1024); } } while (0)
#define PG8_LDB(dst, b, h) do { _Pragma("unroll") for (int n = 0; n < 2; ++n) { dst[n].lo = *(const PG8_LAS i32x4*)(lds + PG8_SB(b, h) + boff + n * 2048); dst[n].hi = *(const PG8_LAS i32x4*)(lds + PG8_SB(b, h) + boff + n * 2048 + 1024); } } while (0)
#define PG8_MMA(ai, bj, At, Bt) do { __builtin_amdgcn_s_setprio(1); _Pragma("unroll") for (int m = 0; m < 4; ++m) _Pragma("unroll") for (int n = 0; n < 2; ++n) { \
        if constexpr (FP8) asm volatile("v_mfma_scale_f32_16x16x128_f8f6f4 %0, %1, %2, %0, %3, %3 op_sel_hi:[0,0,0]" : "+v"(acc[ai][bj][m][n]) : "v"(Bt[n]), "v"(At[m]), "v"(sc1));   \
        else { acc[ai][bj][m][n] = __builtin_amdgcn_mfma_f32_16x16x32_bf16(__builtin_bit_cast(bf16x8, (i32x4)Bt[n].lo), __builtin_bit_cast(bf16x8, (i32x4)At[m].lo), acc[ai][bj][m][n], 0, 0, 0); \
               acc[ai][bj][m][n] = __builtin_amdgcn_mfma_f32_16x16x32_bf16(__builtin_bit_cast(bf16x8, (i32x4)Bt[n].hi), __builtin_bit_cast(bf16x8, (i32x4)At[m].hi), acc[ai][bj][m][n], 0, 0, 0); } } \
        __builtin_amdgcn_s_setprio(0); } while (0)
#define PG8_WAIT_V(n) asm volatile("s_waitcnt vmcnt(" #n ")" ::: "memory")
#define PG8_WAIT_L(n) asm volatile("s_waitcnt lgkmcnt(" #n ")" ::: "memory")
#define PG8_BAR __builtin_amdgcn_s_barrier()
#define PG8_SCHED __builtin_amdgcn_sched_barrier(0)
    Unit cur, nxt; int ui = 0;
    if (!S.next(0, cur)) return;
    f32x4 acc[2][2][4][2];
#pragma unroll
    for (int a = 0; a < 2; ++a)
#pragma unroll
        for (int b = 0; b < 2; ++b)
#pragma unroll
            for (int m = 0; m < 4; ++m)
#pragma unroll
                for (int n = 0; n < 2; ++n) acc[a][b][m][n] = (f32x4){0.f, 0.f, 0.f, 0.f};
    int sc1 = 0x7f7f7f7f; asm volatile("" : "+v"(sc1));
    i32x8 At[4], B0[2], B1[2];
    const char* cA = (const char*)g.A + (GATHER ? (size_t)0 : (size_t)cur.pm * tstep); if constexpr (GATHER) PG8_GATHER_OFFS(0, vc0, vc1);
    const char* cB = (const char*)g.Bt + (size_t)cur.pn * tstep + (size_t)(cur.pm >> g.gshift) * g.gstride;
    S.a_ready(cur);
    if constexpr (SP2) {
        PG8_STAGE(PG8_SB(0, 0), cB, voffB); PG8_STAGE(PG8_SB(0, 1), cB + hstep, voffB); PG8_STAGE_A0(PG8_SA(0, 0), cA, false); PG8_STAGE_A1(PG8_SA(0, 1), cA, false);
        if (wr == 1) PG8_BAR;
        PG8_WAIT_V(2); PG8_BAR;
        PG8_STAGE(PG8_SB(1, 0), cB + kstep, voffB); PG8_STAGE_A0(PG8_SA(1, 0), cA + kstep, false); PG8_STAGE(PG8_SB(1, 1), cB + hstep + kstep, voffB);
        PG8_WAIT_V(6); PG8_BAR;
    } else {
        PG8_STAGE(PG8_SB(0, 0), cB, voffB); PG8_STAGE(PG8_SA(0, 0), cA, voffA); PG8_STAGE(PG8_SB(0, 1), cB + hstep, voffB); PG8_STAGE(PG8_SA(0, 1), cA + hstep, voffA);
        if (wr == 1) PG8_BAR;
        PG8_WAIT_V(4); PG8_BAR;
        PG8_STAGE(PG8_SB(1, 0), cB + kstep, voffB); PG8_STAGE(PG8_SA(1, 0), cA + kstep, voffA); PG8_STAGE(PG8_SB(1, 1), cB + hstep + kstep, voffB);
        PG8_WAIT_V(6); PG8_BAR;
    }
    for (;;) {
        const bool has_next = S.next(ui + 1, nxt);
        const char* nA = (has_next && !GATHER) ? (const char*)g.A + (size_t)nxt.pm * tstep : cA;
        if constexpr (GATHER) { if (has_next) PG8_GATHER_OFFS(ui + 1, vn0, vn1); else { vn0[0] = vc0[0]; vn0[1] = vc0[1]; vn1[0] = vc1[0]; vn1[1] = vc1[1]; } } const char* nB = has_next ? (const char*)g.Bt + (size_t)nxt.pn * tstep + (size_t)(nxt.pm >> g.gshift) * g.gstride : cB;
        for (int t = 0; t < nt; t += 2) {
            const bool last = (t == nt - 2);
            const char* a1 = cA + (size_t)(t + 1) * kstep;
            const char* a2 = last ? nA : cA + (size_t)(t + 2) * kstep; const char* b2 = last ? nB : cB + (size_t)(t + 2) * kstep;
            const char* a3 = a2 + kstep; const char* b3 = b2 + kstep;
            if (last && has_next) S.a_ready(nxt);
            if constexpr (SP2) {
            PG8_LDB(B0, 0, 0); PG8_LDB(B1, 0, 1); PG8_SCHED; PG8_LDA(At, 0, 0); PG8_STAGE_A1(PG8_SA(1, 1), a1, false);
            PG8_WAIT_V(8); PG8_WAIT_L(0); PG8_BAR; PG8_MMA(0, 0, At, B0); PG8_MMA(0, 1, At, B1); PG8_BAR; PG8_SCHED;
            PG8_LDA(At, 0, 1); PG8_STAGE(PG8_SB(0, 0), b2, voffB); PG8_STAGE(PG8_SB(0, 1), b2 + hstep, voffB); PG8_STAGE_A0(PG8_SA(0, 0), a2, last);
            PG8_WAIT_V(8); PG8_WAIT_L(0); PG8_BAR; PG8_MMA(1, 0, At, B0); PG8_MMA(1, 1, At, B1); PG8_BAR; PG8_SCHED;
            PG8_LDB(B0, 1, 0); PG8_LDB(B1, 1, 1); PG8_SCHED; PG8_LDA(At, 1, 0); PG8_STAGE_A1(PG8_SA(0, 1), a2, last);
            PG8_WAIT_V(8); PG8_WAIT_L(0); PG8_BAR; PG8_MMA(0, 0, At, B0); PG8_MMA(0, 1, At, B1); PG8_BAR; PG8_SCHED;
            PG8_LDA(At, 1, 1); PG8_STAGE(PG8_SB(1, 0), b3, voffB); PG8_STAGE(PG8_SB(1, 1), b3 + hstep, voffB); PG8_STAGE_A0(PG8_SA(1, 0), a3, last);
            PG8_WAIT_V(8); PG8_WAIT_L(0); PG8_BAR; PG8_MMA(1, 0, At, B0); PG8_MMA(1, 1, At, B1); PG8_BAR; PG8_SCHED;
            } else {
            PG8_LDB(B0, 0, 0); PG8_SCHED; PG8_LDA(At, 0, 0); PG8_STAGE(PG8_SA(1, 1), a1 + hstep, voffA);
            PG8_WAIT_L(8); PG8_BAR; PG8_WAIT_L(0); PG8_MMA(0, 0, At, B0); PG8_BAR; PG8_SCHED;
            PG8_LDB(B1, 0, 1); PG8_STAGE(PG8_SB(0, 0), b2, voffB);
            PG8_BAR; PG8_WAIT_L(0); PG8_MMA(0, 1, At, B1); PG8_BAR;
            PG8_LDA(At, 0, 1); PG8_STAGE(PG8_SA(0, 0), a2, voffA);
            PG8_BAR; PG8_WAIT_L(0); PG8_MMA(1, 0, At, B0); PG8_BAR; PG8_SCHED;
            PG8_STAGE(PG8_SB(0, 1), b2 + hstep, voffB);
            PG8_WAIT_V(6); PG8_BAR; PG8_MMA(1, 1, At, B1); PG8_BAR;
            PG8_LDB(B0, 1, 0); PG8_SCHED; PG8_LDA(At, 1, 0); PG8_STAGE(PG8_SA(0, 1), a2 + hstep, voffA);
            PG8_WAIT_L(8); PG8_BAR; PG8_WAIT_L(0); PG8_MMA(0, 0, At, B0); PG8_BAR; PG8_SCHED;
            PG8_LDB(B1, 1, 1); PG8_STAGE(PG8_SB(1, 0), b3, voffB);
            PG8_BAR; PG8_WAIT_L(0); PG8_MMA(0, 1, At, B1); PG8_BAR;
            PG8_LDA(At, 1, 1); PG8_STAGE(PG8_SA(1, 0), a3, voffA);
            PG8_BAR; PG8_WAIT_L(0); PG8_MMA(1, 0, At, B0); PG8_BAR; PG8_SCHED;
            PG8_STAGE(PG8_SB(1, 1), b3 + hstep, voffB);
            PG8_WAIT_V(6); PG8_BAR; PG8_MMA(1, 1, At, B1); PG8_BAR;
            }
        }
        if constexpr (ALIGN_EPI) { if (wr == 0) PG8_BAR; }
        if constexpr (FP8) asm volatile("s_nop 15\n\ts_nop 15" ::: "memory");
        if constexpr (!Epi::AFTER_DRAIN) { E(acc, cur, wr, wc, fr, fq); S.done(cur); }
        if (!has_next) break;
#pragma unroll
        for (int a = 0; a < 2; ++a)
#pragma unroll
            for (int b = 0; b < 2; ++b)
#pragma unroll
                for (int m = 0; m < 4; ++m)
#pragma unroll
                    for (int n = 0; n < 2; ++n) acc[a][b][m][n] = (f32x4){0.f, 0.f, 0.f, 0.f};
        cur = nxt; cA = nA; cB = nB; ++ui;
        if constexpr (GATHER) { vc0[0] = vn0[0]; vc0[1] = vn0[1]; vc1[0] = vn1[0]; vc1[1] = vn1[1]; }
        if constexpr (ALIGN_EPI) { if (wr == 1) PG8_BAR; }
    }
    PG8_WAIT_V(0);
    if constexpr (!ALIGN_EPI) { if (wr == 0) PG8_BAR; }
    PG8_BAR;
    if constexpr (Epi::AFTER_DRAIN) { E.fused(acc, cur, wr, wc, fr, fq, lds, wid, lane); S.done(cur); }
#undef PG8_SA
#undef PG8_SB
#undef PG8_STAGE
#undef PG8_STAGE_A0
#undef PG8_STAGE_A1
#undef PG8_GATHER_OFFS
#undef PG8_LDA
#undef PG8_LDB
#undef PG8_MMA
#undef PG8_WAIT_V
#undef PG8_WAIT_L
#undef PG8_BAR
#undef PG8_SCHED
}
}

#define LAS __attribute__((address_space(3)))
typedef unsigned short bf16;
typedef unsigned u32x4 __attribute__((ext_vector_type(4)));
typedef unsigned u32x2 __attribute__((ext_vector_type(2)));
typedef float f32x4 __attribute__((ext_vector_type(4)));
typedef float f32x2 __attribute__((ext_vector_type(2)));

constexpr int NWAVES = 8, NTHR = 512;
constexpr int DM = 1024, NB = 2, SEQ = 8192, CTXL = 256;
constexpr int MROWS = NB * SEQ;
constexpr int MCTX = NB * CTXL;
constexpr int MTOT = MROWS + MCTX;
constexpr int NINC = 4096;
constexpr int NE = 16, CAP = 1024, FE = 2752, FEP = 2816, N1P = 5632;
constexpr int MEXP = NE * NB * CAP;
constexpr float RMS_EPS = 1e-6f;
constexpr int NPHASE = 12;
#ifndef PHMASK
#define PHMASK 0xFFF
#endif
#define PH_ON(k) ((PHMASK >> (k)) & 1)
#ifndef REPMASK
#define REPMASK 0x0
#endif
#define REP_ON(k) ((REPMASK >> (k)) & 1)
#ifndef MK_N_LAUNCHES
#define MK_N_LAUNCHES 1
#endif

constexpr size_t MiB = 1u << 20, KiB = 1u << 10;
constexpr size_t WS_CTL = 0, CTL_ZERO_BYTES = 1 * MiB;
constexpr size_t WS_MODP = 1 * MiB;
constexpr size_t WS_MODF = 1 * MiB + 640 * KiB;
constexpr size_t WS_LB = 1 * MiB + 768 * KiB;
constexpr size_t WS_COS = 1 * MiB + 800 * KiB;
constexpr size_t WS_SIN = 1 * MiB + 808 * KiB;
constexpr size_t WS_WRT = 1 * MiB + 832 * KiB;
constexpr size_t WS_AFF = 2 * MiB;
constexpr size_t WS_IDX = 3 * MiB;
constexpr size_t WS_GATEV = 3 * MiB + 256 * KiB;
constexpr size_t WS_SLOT = 4 * MiB;
constexpr size_t WS_H2 = 8 * MiB;
constexpr size_t WS_WINT = 72 * MiB;
constexpr size_t WS_WOUTT = 80 * MiB;
constexpr size_t WS_W1T = 82 * MiB;
constexpr size_t WS_W2T = 258 * MiB;
constexpr size_t WS_H = 346 * MiB;
constexpr size_t WS_QP = 379 * MiB;
constexpr size_t WS_QR = 395 * MiB;
constexpr size_t WS_KR = 411 * MiB;
constexpr size_t WS_V = 428 * MiB;
constexpr size_t WS_QH = 445 * MiB;
constexpr size_t WS_LFF = 462 * MiB;
constexpr size_t WS_LFB = 495 * MiB;
constexpr size_t WS_IH = 528 * MiB;
constexpr size_t WS_GH = 545 * MiB;
constexpr size_t WS_MIXIN = 561 * MiB;
constexpr size_t WS_HID = 346 * MiB;
constexpr size_t WS_MIX = 593 * MiB;
constexpr size_t WS_YS = 593 * MiB;
constexpr size_t WS_END = 657 * MiB;
static_assert(WS_HID + (size_t)MEXP * FEP * 2 <= WS_MIXIN + 32 * MiB, "hid overlay");
static_assert(WS_W1T + (size_t)NE * N1P * DM * 2 <= WS_W2T && WS_W2T + (size_t)NE * DM * FEP * 2 <= WS_H, "weights");

constexpr int CW_BAR = 4096;
constexpr int LDSCTL_BYTES = 512, LDS_BYTES = 155648;

#define LDS_WAIT() asm volatile("s_waitcnt lgkmcnt(0)" ::: "memory")
#define VM_WAIT() asm volatile("s_waitcnt vmcnt(0)" ::: "memory")
__device__ __forceinline__ unsigned f2bf(float f) { unsigned u = __builtin_bit_cast(unsigned, f); return (u + 0x7fffu + ((u >> 16) & 1u)) >> 16; }
__device__ __forceinline__ unsigned pk2(float lo, float hi) { return f2bf(lo) | (f2bf(hi) << 16); }
__device__ __forceinline__ float bf2f(unsigned h) { return __builtin_bit_cast(float, h << 16); }
__device__ __forceinline__ float bflo(unsigned w) { return __builtin_bit_cast(float, w << 16); }
__device__ __forceinline__ float bfhi(unsigned w) { return __builtin_bit_cast(float, w & 0xffff0000u); }
__device__ __forceinline__ float wave_sum(float v) {
#pragma unroll
    for (int o = 1; o < 64; o <<= 1) v += __shfl_xor(v, o);
    return v;
}
__device__ __forceinline__ float wave_max(float v) {
#pragma unroll
    for (int o = 1; o < 64; o <<= 1) v = fmaxf(v, __shfl_xor(v, o));
    return v;
}
__device__ __forceinline__ unsigned pk4_fp8(float a, float b, float c, float d) { int w = 0; w = __builtin_amdgcn_cvt_pk_fp8_f32(a, b, w, false); w = __builtin_amdgcn_cvt_pk_fp8_f32(c, d, w, true); return (unsigned)w; }
constexpr float W2_SCALE = 32.f, HID_SCALE = 8.f;
constexpr float W1_SCALE = 32.f, H2_SCALE = 4.f;
__device__ __forceinline__ float sigmoidf_(float x) { return __builtin_amdgcn_rcpf(1.0f + __expf(-x)); }

#define XB_TMO      128
#define XB_XCNT(j)  (256  + 64 * (j))
#define XB_XSUB(j)  (1280 + 64 * (j))
#define XB_XGEN(j)  (2304 + 64 * (j))
#define XB_TOP      3328
#define XB_TOPGEN   3392
#define XCD_BAR_WORDS 3456
#define XB_SPIN_CAP (1u << 20)
__device__ __forceinline__ unsigned xb_ld(unsigned* p)              { return __hip_atomic_load(p, __ATOMIC_RELAXED, __HIP_MEMORY_SCOPE_AGENT); }
__device__ __forceinline__ unsigned xb_add(unsigned* p, unsigned v) { return __hip_atomic_fetch_add(p, v, __ATOMIC_RELAXED, __HIP_MEMORY_SCOPE_AGENT); }
__device__ __forceinline__ unsigned xb_xcc_id() { return (unsigned)__builtin_amdgcn_s_getreg((3 << 11) | 20) & 0xFu; }
#define XB_SPIN(cond, bar) do { unsigned _sp = 0; while (cond) { __builtin_amdgcn_s_sleep(1); \
    if ((++_sp & 255u) == 0u) { if (xb_ld(&(bar)[XB_TMO])) break; if (_sp > XB_SPIN_CAP) { atomicAdd(&(bar)[XB_TMO], 1u); break; } } } } while (0)
struct XcdBarrier { unsigned* bar; unsigned x; volatile LAS unsigned* st; };
__device__ __forceinline__ XcdBarrier xcd_barrier_post(unsigned* bar, volatile LAS unsigned* st) {
    XcdBarrier b; b.bar = bar; b.x = xb_xcc_id(); b.st = st;
    if (threadIdx.x == 0) (void)xb_add(&bar[XB_XCNT(b.x)], 1u);
    return b;
}
__device__ __forceinline__ void xcd_barrier_complete(unsigned* bar, unsigned x, unsigned& nloc, unsigned& nx) {
    const unsigned G = gridDim.x * gridDim.y * gridDim.z;
    unsigned sum, cnt, mine, sp = 0u;
    for (;;) {
        sum = 0u; cnt = 0u; mine = 0u;
#pragma unroll
        for (unsigned j = 0; j < 16; ++j) { const unsigned c = xb_ld(&bar[XB_XCNT(j)]); sum += c; cnt += (c > 0u) ? 1u : 0u; mine = (j == x) ? c : mine; }
        if (sum == G) break;
        __builtin_amdgcn_s_sleep(1);
        if ((++sp & 255u) == 0u) { if (xb_ld(&bar[XB_TMO])) break; if (sp > XB_SPIN_CAP) { atomicAdd(&bar[XB_TMO], 1u); break; } }
    }
    nloc = mine > 0u ? mine : 1u; nx = cnt > 0u ? cnt : 1u;
}
__device__ __forceinline__ void xcd_barrier(const XcdBarrier& b) {
    asm volatile("s_waitcnt vmcnt(0)" ::: "memory");
    __syncthreads();
    if (threadIdx.x == 0) {
        unsigned* bar = b.bar;
        __builtin_amdgcn_s_waitcnt(0);
        unsigned nloc = b.st[0], nx = b.st[1];
        if (nloc == 0u) { xcd_barrier_complete(bar, b.x, nloc, nx); b.st[0] = nloc; b.st[1] = nx; }
        const unsigned old = xb_add(&bar[XB_XSUB(b.x)], 1u);
        const unsigned gen = old / nloc;
        if (old + 1u == (gen + 1u) * nloc) {
            __builtin_amdgcn_fence(__ATOMIC_RELEASE, "agent");
            asm volatile("s_waitcnt vmcnt(0)" ::: "memory");
            const unsigned og = xb_add(&bar[XB_TOP], 1u);
            const unsigned tg = og / nx;
            if (og + 1u == (tg + 1u) * nx) xb_add(&bar[XB_TOPGEN], 1u);
            else XB_SPIN(xb_ld(&bar[XB_TOPGEN]) == tg, bar);
            __builtin_amdgcn_fence(__ATOMIC_ACQUIRE, "agent");
            xb_add(&bar[XB_XGEN(b.x)], 1u);
            asm volatile("s_waitcnt vmcnt(0)" ::: "memory");
        } else {
            XB_SPIN(xb_ld(&bar[XB_XGEN(b.x)]) == gen, bar);
            __builtin_amdgcn_fence(__ATOMIC_ACQUIRE, "agent");
            asm volatile("s_waitcnt vmcnt(0)" ::: "memory");
        }
    }
    __syncthreads();
}

struct Args { const float* in[19]; float* out; unsigned char* ws; int ph_lo, ph_hi; };
enum { I_X = 0, I_C, I_CTX, I_CCTX, I_WMOD, I_BMOD, I_GPRE1, I_GPOST1, I_GPRE2, I_GPOST2, I_WIN, I_WOUT, I_RPB, I_LBL, I_HGN, I_WROUTER, I_WGATE, I_WUP, I_WDOWN };

struct Ctx {
    LAS unsigned char* lds; int tid, lane, wave, G;
    Args a; unsigned char* ws;
};
template <class T> __device__ __forceinline__ T* wsp(const Ctx& C, size_t off) { return (T*)(C.ws + off); }

constexpr int CV_T_IN = 8 * 32, CV_T_OUT = 8 * 8, CV_T_G = 8 * 22, CV_T_D = 22 * 8, CV_T_E = 2 * CV_T_G + CV_T_D, CV_NT = CV_T_IN + CV_T_OUT + NE * CV_T_E;
constexpr int CV_D2 = 1568;
constexpr int CV_P0_END = CV_T_IN + CV_T_OUT, CV_D1_END = CV_NT - CV_D2;
__device__ __forceinline__ void convert_tiles(const Ctx& C, int first, int last, int start, int stride) {
    const Args& a = C.a;
    int tid_ = C.tid; asm volatile("" : "+v"(tid_));
    constexpr int T_IN = CV_T_IN, T_OUT = CV_T_OUT, T_G = CV_T_G, T_E = CV_T_E;
    {
        LAS float* scr = (LAS float*)C.lds;
#define SCR(k_, n_) (*(const LAS float*)((const LAS unsigned char*)scr + (k_) * 512 + (((((n_) >> 2) ^ (k_) ^ ((k_) >> 4)) & 31) << 4) + ((n_) & 3) * 4))
        struct Item { const float* src; bf16* dst; int N, ldk, k0, n0, kval, nval, which; float f8scale; };
        auto decode = [&](int it, Item& I) {
            int r = it;
            if (r < T_IN) { I = Item{a.in[I_WIN], wsp<bf16>(C, WS_WINT), NINC, DM, 128 * (r >> 5), 128 * (r & 31), DM, NINC, -1, 0.f}; return; }
            r -= T_IN;
            if (r < T_OUT) { I = Item{a.in[I_WOUT], wsp<bf16>(C, WS_WOUTT), DM, DM, 128 * (r >> 3), 128 * (r & 7), DM, DM, -1, 0.f}; return; }
            r -= T_OUT;
            const int e = r / T_E; r %= T_E;
            if (r < 2 * T_G) { const int which = r / T_G; r %= T_G;
                I = Item{(which ? a.in[I_WUP] : a.in[I_WGATE]) + (size_t)e * DM * FE, (bf16*)(C.ws + WS_W1T + (size_t)e * N1P * DM), FE, DM, 128 * (r / 22), 128 * (r % 22), DM, FE, which, W1_SCALE}; return; }
            r -= 2 * T_G;
            I = Item{a.in[I_WDOWN] + (size_t)e * FE * DM, (bf16*)(C.ws + WS_W2T + (size_t)e * DM * FEP), DM, FEP, 128 * (r >> 3), 128 * (r & 7), FE, DM, -1, W2_SCALE};
        };
        auto loadt = [&](const Item& I, f32x4 (&v)[8]) {
#pragma unroll
            for (int i = 0; i < 8; ++i) { const int idx = tid_ + 512 * i, row = idx >> 5, c4 = idx & 31; const int k = I.k0 + row, n = I.n0 + 4 * c4;
                v[i] = (k < I.kval && n < I.nval) ? __builtin_nontemporal_load((const f32x4*)(I.src + (size_t)k * I.N + n)) : (f32x4){0.f, 0.f, 0.f, 0.f}; }
        };
        Item I0, I1; f32x4 v0[8], v1[8];
        int it = first + start;
        if (it < last) { decode(it, I0); loadt(I0, v0); }
        if (it + stride < last) { decode(it + stride, I1); loadt(I1, v1); }
        auto step = [&](Item& I, f32x4 (&v)[8], int itn) {
            __syncthreads();
#pragma unroll
            for (int i = 0; i < 8; ++i) { const int idx = tid_ + 512 * i, row = idx >> 5, c4 = idx & 31; *(LAS f32x4*)((LAS unsigned char*)scr + row * 512 + (((c4 ^ row ^ (row >> 4)) & 31) << 4)) = v[i]; }
            const Item cur = I;
            if (itn < last) { decode(itn, I); loadt(I, v); }
            __syncthreads();
            if (cur.f8scale != 0.f) {
#pragma unroll
                for (int i = 0; i < 2; ++i) { const int idx = tid_ + 512 * i, nl = idx >> 3, c = idx & 7; const float sc = cur.f8scale; float t[16];
#pragma unroll
                    for (int kk = 0; kk < 16; ++kk) { t[kk] = SCR(16 * c + kk, nl) * sc; if ((kk & 7) == 7) asm volatile("" ::: "memory"); }
                    u32x4 o;
                    o.x = pk4_fp8(t[0], t[1], t[2], t[3]); o.y = pk4_fp8(t[4], t[5], t[6], t[7]); o.z = pk4_fp8(t[8], t[9], t[10], t[11]); o.w = pk4_fp8(t[12], t[13], t[14], t[15]);
                    const int f = cur.n0 + nl; const int rowd = cur.which < 0 ? f : 32 * (f >> 4) + 16 * cur.which + (f & 15);
                    __builtin_nontemporal_store(o, (u32x4*)((unsigned char*)cur.dst + (size_t)rowd * cur.ldk + cur.k0 + 16 * c)); }
            } else {
#pragma unroll
                for (int i = 0; i < 4; ++i) { const int idx = tid_ + 512 * i, nl = idx >> 4, c = idx & 15;
                    u32x4 o; o.x = pk2(SCR(8 * c, nl), SCR(8 * c + 1, nl)); o.y = pk2(SCR(8 * c + 2, nl), SCR(8 * c + 3, nl)); o.z = pk2(SCR(8 * c + 4, nl), SCR(8 * c + 5, nl)); o.w = pk2(SCR(8 * c + 6, nl), SCR(8 * c + 7, nl));
                    const int f = cur.n0 + nl; const int rowd = cur.which < 0 ? f : 32 * (f >> 4) + 16 * cur.which + (f & 15);
                    *(u32x4*)(cur.dst + (size_t)rowd * cur.ldk + cur.k0 + 8 * c) = o; }
            }
        };
        for (; it < last; it += 2 * stride) { step(I0, v0, it + 2 * stride); if (it + stride < last) step(I1, v1, it + 3 * stride); }
#undef SCR
    }
}

__device__ __forceinline__ void phase_prologue(const Ctx& C) {
    const Args& a = C.a;
    if (blockIdx.x < 192) {
        const int cc = blockIdx.x % 24, ks = blockIdx.x / 24;
        LAS float* sv = (LAS float*)C.lds;
        LAS float* red = sv + 384;
        if (C.tid < 384) { const int i = C.tid >> 7, k = C.tid & 127; const float cv = (i < 2) ? a.in[I_C][i * DM + ks * 128 + k] : a.in[I_CCTX][ks * 128 + k]; sv[C.tid] = cv / (1.0f + expf(-cv)); }
        __syncthreads();
        const int cl = C.tid & 255, col = cc * 256 + cl, kh = C.tid >> 8;
        float a0 = 0.f, a1 = 0.f, a2 = 0.f;
        const float* wp = a.in[I_WMOD] + (size_t)(ks * 128 + kh * 64) * 6144 + col;
#pragma unroll 8
        for (int kk = 0; kk < 64; ++kk) { const float w = wp[(size_t)kk * 6144]; const int k = kh * 64 + kk; a0 += sv[k] * w; a1 += sv[128 + k] * w; a2 += sv[256 + k] * w; }
        if (kh == 1) { red[cl] = a0; red[256 + cl] = a1; red[512 + cl] = a2; }
        __syncthreads();
        if (kh == 0) { float* mp = wsp<float>(C, WS_MODP) + (size_t)ks * 18432 + col; mp[0] = a0 + red[cl]; mp[6144] = a1 + red[256 + cl]; mp[12288] = a2 + red[512 + cl]; }
        __syncthreads();
    }
    if (blockIdx.x == 255 % C.G) {
        const float* lg = a.in[I_LBL]; float* lb = wsp<float>(C, WS_LB);
        if (C.tid < 512) { const float l0 = lg[C.tid], l1 = lg[512 + C.tid]; lb[C.tid] = 1.0f / (1.0f + expf(l1 - l0)); }
    }
    if (blockIdx.x == 253 % C.G) {
        float* wrt = wsp<float>(C, WS_WRT);
        for (int idx = C.tid; idx < 16384; idx += NTHR) wrt[(idx & 15) * 1024 + (idx >> 4)] = a.in[I_WROUTER][idx];
    }
    if (blockIdx.x == 254 % C.G) {
        float* ct = wsp<float>(C, WS_COS); float* st = wsp<float>(C, WS_SIN);
        for (int idx = C.tid; idx < 2048; idx += NTHR) { const int pos = idx >> 4, i = idx & 15; const float inv = powf(10000.0f, -(float)i / 16.0f); const float ang = (float)pos * inv; ct[idx] = cosf(ang); st[idx] = sinf(ang); }
    }
    convert_tiles(C, 0, C.G > 32 ? CV_P0_END : CV_NT, (int)blockIdx.x, C.G);
}

__device__ __forceinline__ void phase_hrows(const Ctx& C) {
    const Args& a = C.a;
    const float* modp = wsp<float>(C, WS_MODP); const float* bmod = a.in[I_BMOD];
    { float* modf = wsp<float>(C, WS_MODF);
      for (int idx = blockIdx.x * NTHR + C.tid; idx < 18432; idx += C.G * NTHR) { float s = bmod[idx % 6144];
#pragma unroll
          for (int ks = 0; ks < 8; ++ks) s += modp[ks * 18432 + idx];
          modf[idx] = s; } }
    LAS float* sm = (LAS float*)C.lds;
    for (int j4 = C.tid; j4 < 1536; j4 += NTHR) { const int i = j4 >> 9, ci = (j4 & 511) * 4; f32x4 s = *(const f32x4*)(bmod + ci);
#pragma unroll
        for (int ks = 0; ks < 8; ++ks) s = s + *(const f32x4*)(modp + ks * 18432 + i * 6144 + ci);
        if (ci >= 1024) s = *(const f32x4*)(a.in[I_GPRE1] + ci - 1024) * (1.0f + s);
        *(LAS f32x4*)(sm + i * 2048 + ci) = s; }
    __syncthreads();
    const int gw = blockIdx.x * NWAVES + C.wave, NGW = C.G * NWAVES;
    bf16* H = wsp<bf16>(C, WS_H);
    auto load3 = [&](int row0, f32x4 (&v)[3][4]) {
#pragma unroll
        for (int r = 0; r < 3; ++r) { const int row = row0 + r; const float* src = row < MROWS ? a.in[I_X] + (size_t)row * DM : a.in[I_CTX] + (size_t)(row - MROWS) * DM;
#pragma unroll
            for (int j = 0; j < 4; ++j) v[r][j] = *(const f32x4*)(src + 4 * (C.lane + 64 * j)); }
    };
    auto calc3 = [&](int row0, const f32x4 (&v)[3][4], u32x2 (&o)[3][4]) {
        float ss[3];
#pragma unroll
        for (int r = 0; r < 3; ++r) { float s_ = 0.f;
#pragma unroll
            for (int j = 0; j < 4; ++j) s_ += (v[r][j].x * v[r][j].x + v[r][j].y * v[r][j].y) + (v[r][j].z * v[r][j].z + v[r][j].w * v[r][j].w);
            ss[r] = s_; }
#pragma unroll
        for (int o_ = 1; o_ < 64; o_ <<= 1) {
#pragma unroll
            for (int r = 0; r < 3; ++r) ss[r] += __shfl_xor(ss[r], o_); }
#pragma unroll
        for (int r = 0; r < 3; ++r) { const int row = row0 + r; const int vi = row < MROWS ? (row >> 13) : 2; const float rstd = 1.0f / sqrtf(ss[r] * (1.0f / DM) + RMS_EPS);
#pragma unroll
            for (int j = 0; j < 4; ++j) { const int ch = 4 * (C.lane + 64 * j);
                const f32x4 sh = *(const LAS f32x4*)(sm + vi * 2048 + ch), gs = *(const LAS f32x4*)(sm + vi * 2048 + 1024 + ch);
                const f32x4 h = v[r][j] * rstd * gs + sh;
                o[r][j].x = pk2(h.x, h.y); o[r][j].y = pk2(h.z, h.w); } }
    };
    auto store3 = [&](int row0, const u32x2 (&o)[3][4]) {
#pragma unroll
        for (int r = 0; r < 3; ++r)
#pragma unroll
            for (int j = 0; j < 4; ++j) *(u32x2*)(H + (size_t)(row0 + r) * DM + 4 * (C.lane + 64 * j)) = o[r][j];
    };
    int row0 = 3 * gw;
    if (row0 < MTOT) {
        f32x4 v[3][4], vn[3][4]; u32x2 o[3][4];
        load3(row0, v);
        { const int rn = row0 + 3 * NGW < MTOT ? row0 + 3 * NGW : row0; load3(rn, vn); }
        calc3(row0, v, o);
        int prow = row0;
        for (row0 += 3 * NGW; row0 < MTOT; row0 += 3 * NGW) {
#pragma unroll
            for (int r = 0; r < 3; ++r)
#pragma unroll
                for (int j = 0; j < 4; ++j) v[r][j] = vn[r][j];
            store3(prow, o);
            { const int rn = row0 + 3 * NGW < MTOT ? row0 + 3 * NGW : row0; load3(rn, vn); }
            calc3(row0, v, o);
            prow = row0;
        }
        store3(prow, o);
    }
}

__device__ __forceinline__ void st_bf4(bf16* p, f32x4 v) { u32x2 o; o.x = pk2(v.x, v.y); o.y = pk2(v.z, v.w); *(u32x2*)p = o; }

struct EpiIn {
    static constexpr bool PERM = false, AFTER_DRAIN = false;
    bf16 *QP, *QR, *KR, *V, *QH, *IH, *GH; float *LFF, *LFB; const LAS float *lb, *cosT, *sinT;
    __device__ __forceinline__ void operator()(const f32x4 (&acc)[2][2][4][2], const pg8::Unit& u, int wr, int wc, int fr, int fq) const {
        const int stream = u.pn >> 1; const bool isctx = u.pm >= 64;
        if (isctx && (stream == 0 || stream == 7)) return;
#pragma unroll
        for (int ai = 0; ai < 2; ++ai)
#pragma unroll
            for (int m = 0; m < 4; ++m) {
                const int row = u.pm * 256 + ai * 128 + wr * 64 + m * 16 + fr;
#pragma unroll
                for (int bj = 0; bj < 2; ++bj) {
                    const int cs = (u.pn & 1) * 256 + bj * 128 + wc * 32 + 4 * fq;
                    const f32x4 x1 = acc[ai][bj][m][0], x2 = acc[ai][bj][m][1];
                    const size_t o = (size_t)row * 512 + cs;
                    if (stream <= 1) {
                        const int t = row & 8191, pos = (wc & 1) ? (t & 63) : (t >> 6);
                        const f32x4 c4 = *(const LAS f32x4*)(cosT + pos * 16 + 4 * fq), s4 = *(const LAS f32x4*)(sinT + pos * 16 + 4 * fq);
                        const f32x4 r1 = x1 * c4 - x2 * s4, r2 = x1 * s4 + x2 * c4;
                        if (stream == 0) { st_bf4(QP + o, x1 * 0.125f); st_bf4(QP + o + 16, x2 * 0.125f); st_bf4(QR + o, r1 * 0.125f); st_bf4(QR + o + 16, r2 * 0.125f); }
                        else if (isctx) { st_bf4(KR + o, x1); st_bf4(KR + o + 16, x2); }
                        else { st_bf4(KR + o, r1); st_bf4(KR + o + 16, r2); }
                    } else if (stream == 2) { st_bf4(V + o, x1); st_bf4(V + o + 16, x2); }
                    else if (stream == 3) { st_bf4(QH + o, x1); st_bf4(QH + o + 16, x2); }
                    else if (stream == 4 || stream == 5) {
                        float* LF = stream == 4 ? LFF : LFB;
                        const f32x4 l1 = *(const LAS f32x4*)(lb + cs), l2 = *(const LAS f32x4*)(lb + cs + 16);
                        f32x4 y1, y2;
#pragma unroll
                        for (int j = 0; j < 4; ++j) { y1[j] = __logf(l1[j] + (1.0f - l1[j]) * sigmoidf_(x1[j])); y2[j] = __logf(l2[j] + (1.0f - l2[j]) * sigmoidf_(x2[j])); }
                        *(f32x4*)(LF + o) = y1; *(f32x4*)(LF + o + 16) = y2;
                    } else if (stream == 6) { st_bf4(IH + o, x1); st_bf4(IH + o + 16, x2); }
                    else { st_bf4(GH + o, x1); st_bf4(GH + o + 16, x2); }
                }
            }
    }
};
struct EpiF32 {
    static constexpr bool PERM = false, AFTER_DRAIN = false;
    float* O; int ldc;
    __device__ __forceinline__ void operator()(const f32x4 (&acc)[2][2][4][2], const pg8::Unit& u, int wr, int wc, int fr, int fq) const {
#pragma unroll
        for (int ai = 0; ai < 2; ++ai)
#pragma unroll
            for (int m = 0; m < 4; ++m) { float* rp = O + (size_t)(u.pm * 256 + ai * 128 + wr * 64 + m * 16 + fr) * ldc + u.pn * 256 + wc * 32 + 4 * fq;
#pragma unroll
                for (int bj = 0; bj < 2; ++bj)
#pragma unroll
                    for (int n = 0; n < 2; ++n) *(f32x4*)(rp + bj * 128 + n * 16) = acc[ai][bj][m][n]; }
    }
};
struct EpiHid {
    static constexpr bool PERM = false, AFTER_DRAIN = false;
    unsigned char* HID;
    __device__ __forceinline__ void operator()(const f32x4 (&acc)[2][2][4][2], const pg8::Unit& u, int wr, int wc, int fr, int fq) const {
#pragma unroll
        for (int ai = 0; ai < 2; ++ai)
#pragma unroll
            for (int m = 0; m < 4; ++m) { unsigned char* rp = HID + (size_t)(u.pm * 256 + ai * 128 + wr * 64 + m * 16 + fr) * FEP + u.pn * 128 + wc * 16 + 4 * fq;
#pragma unroll
                for (int bj = 0; bj < 2; ++bj) { const f32x4 g = acc[ai][bj][m][0] * (1.0f / (W1_SCALE * H2_SCALE)), up = acc[ai][bj][m][1] * (HID_SCALE / (W1_SCALE * H2_SCALE)); f32x4 hv;
#pragma unroll
                    for (int j = 0; j < 4; ++j) hv[j] = __builtin_amdgcn_fmed3f(g[j] * sigmoidf_(g[j]) * up[j], -448.f, 448.f);
                    *(unsigned*)(rp + bj * 64) = pk4_fp8(hv[0], hv[1], hv[2], hv[3]); } }
    }
};
struct EpiYs {
    static constexpr bool PERM = false, AFTER_DRAIN = false;
    bf16* YS; const float* gate;
    __device__ __forceinline__ void operator()(const f32x4 (&acc)[2][2][4][2], const pg8::Unit& u, int wr, int wc, int fr, int fq) const {
#pragma unroll
        for (int ai = 0; ai < 2; ++ai)
#pragma unroll
            for (int m = 0; m < 4; ++m) { const int row = u.pm * 256 + ai * 128 + wr * 64 + m * 16 + fr; const float gv = gate[row] * (1.0f / (W2_SCALE * HID_SCALE));
                bf16* rp = YS + (size_t)row * DM + u.pn * 256 + wc * 32 + 4 * fq;
#pragma unroll
                for (int bj = 0; bj < 2; ++bj)
#pragma unroll
                    for (int n = 0; n < 2; ++n) st_bf4(rp + bj * 128 + n * 16, acc[ai][bj][m][n] * gv); }
    }
};

typedef short bf16x8 __attribute__((ext_vector_type(8)));
typedef short s16x4 __attribute__((ext_vector_type(4)));
constexpr int NA_KW = 0, NA_VW = NA_KW + 5 * 64 * 128, NA_KC = NA_VW + 5 * 64 * 128, NA_VC = NA_KC + 256 * 128, NA_SB = NA_VC + 256 * 128, NA_END = NA_SB + 15 * 64 * 4;
static_assert(NA_END + LDSCTL_BYTES <= LDS_BYTES, "NA LDS map");
__device__ __forceinline__ int voff(int key, int c  ) { return (key >> 3) * 1024 + (c >> 1) * 256 + (key & 7) * 32 + (c & 1) * 16; }
__device__ __forceinline__ int kswz(int row, int chunk) { return row * 128 + ((chunk ^ (row & 7)) << 4); }
__device__ __forceinline__ s16x4 lds_tr16(const LAS unsigned char* p) { return __builtin_bit_cast(s16x4, __builtin_amdgcn_ds_read_tr16_b64_v4i16((LAS s16x4*)p)); }
__device__ __forceinline__ int clampi(int v, int lo, int hi) { return min(max(v, lo), hi); }
__device__ __forceinline__ bf16x8 pack8(f32x4 a, f32x4 b) { u32x4 w; w.x = pk2(a.x, a.y); w.y = pk2(a.z, a.w); w.z = pk2(b.x, b.y); w.w = pk2(b.z, b.w); return __builtin_bit_cast(bf16x8, w); }

__device__ __forceinline__ void phase_na(const Ctx& C) {
    const Args& a_ = C.a;
    const bf16 *QP = wsp<bf16>(C, WS_QP), *QR = wsp<bf16>(C, WS_QR), *KR = wsp<bf16>(C, WS_KR), *V = wsp<bf16>(C, WS_V);
    bf16* MIXIN = wsp<bf16>(C, WS_MIXIN); const float* rpb = a_.in[I_RPB];
    LAS unsigned char* L = C.lds; LAS float* sB = (LAS float*)(L + NA_SB);
    const int UPB = (1024 + C.G - 1) / C.G, u_lo = blockIdx.x * UPB, u_hi = min(1024, u_lo + UPB);
    const int q = C.lane & 15, g = C.lane >> 4;
    int cur_bh = -1;
    for (int u = u_lo; u < u_hi; ++u) {
        const int bh = u >> 6, b = bh >> 3, h = bh & 7, r = 2 * (u & 63);
        const int rlo = clampi(r - 4, 0, 120);
        const int rr = r + (C.wave >> 2), j = C.wave & 3;
        const int r0q = clampi(rr - 4, 0, 120), c0 = clampi(16 * j - 8, 0, 32), cq = 16 * j + q, wc0 = clampi(cq - 8, 0, 48);
        const size_t mq = (size_t)b * SEQ + rr * 64 + cq;
        const bf16x8 qr0 = *(const bf16x8*)(QR + mq * 512 + h * 64 + 8 * g), qr1 = *(const bf16x8*)(QR + mq * 512 + h * 64 + 32 + 8 * g);
        const bf16x8 qp0 = *(const bf16x8*)(QP + mq * 512 + h * 64 + 8 * g), qp1 = *(const bf16x8*)(QP + mq * 512 + h * 64 + 32 + 8 * g);
        float mrun = -INFINITY, lrun = 0.f;
        f32x4 o[4];
#pragma unroll
        for (int dt = 0; dt < 4; ++dt) o[dt] = (f32x4){0.f, 0.f, 0.f, 0.f};
        const int slot0 = r0q - rlo;
        const int kw = slot0 * 64 + c0 + 4 * g + (q >> 2);
        const LAS unsigned char* vwb = L + NA_VW + (kw >> 3) * 1024 + (kw & 7) * 32 + (q & 3) * 8;
        const LAS unsigned char* kwb0 = L + NA_KW + kswz(slot0 * 64 + c0 + q, g), *kwb1 = L + NA_KW + kswz(slot0 * 64 + c0 + q, 4 + g);
        const int kx = 4 * g + (q >> 2);
        const LAS unsigned char* vcb = L + NA_VC + (kx >> 3) * 1024 + (kx & 7) * 32 + (q & 3) * 8;
        const LAS unsigned char* kc0 = L + NA_KC + kswz(q, g), *kc1 = L + NA_KC + kswz(q, 4 + g);
        const LAS float* bl = sB + (r0q - rr + 7) * 64 + (c0 + 4 * g - cq + 15 + 16);
        const int kcl = c0 + 4 * g - wc0;
        __syncthreads();
        if (bh != cur_bh) {
            cur_bh = bh;
            { u32x4 tk[4], tv[4];
#pragma unroll
              for (int i = 0; i < 4; ++i) { const int idx = C.tid + NTHR * i, l = idx >> 3, c = idx & 7; const size_t row = (size_t)MROWS + b * CTXL + l;
                  tk[i] = *(const u32x4*)(KR + row * 512 + h * 64 + 8 * c); tv[i] = *(const u32x4*)(V + row * 512 + h * 64 + 8 * c); }
#pragma unroll
              for (int i = 0; i < 4; ++i) { const int idx = C.tid + NTHR * i, l = idx >> 3, c = idx & 7;
                  *(LAS u32x4*)(L + NA_KC + kswz(l, c)) = tk[i]; *(LAS u32x4*)(L + NA_VC + voff(l, c)) = tv[i]; } }
            for (int idx = C.tid; idx < 15 * 64; idx += NTHR) { const int dr = idx >> 6, dc = (idx & 63) - 16; sB[idx] = (dc >= 0 && dc < 31) ? rpb[(h * 15 + dr) * 31 + dc] : 0.f; }
        }
#pragma unroll 1
        for (int grp = 0; grp < 2; ++grp) {
            if (grp == 1) __syncthreads();
            { const int row0 = rlo + 4 * grp;
              u32x4 tk[5], tv[5];
#pragma unroll
              for (int i = 0; i < 5; ++i) { const int idx = C.tid + NTHR * i, kidx = idx >> 3, c = idx & 7; const size_t tok = (size_t)b * SEQ + min(row0 * 64 + kidx, SEQ - 1);
                  tk[i] = *(const u32x4*)(KR + tok * 512 + h * 64 + 8 * c); tv[i] = *(const u32x4*)(V + tok * 512 + h * 64 + 8 * c); }
#pragma unroll
              for (int i = 0; i < 5; ++i) { const int idx = C.tid + NTHR * i, kidx = idx >> 3, c = idx & 7;
                  *(LAS u32x4*)(L + NA_KW + kswz(kidx, c)) = tk[i]; *(LAS u32x4*)(L + NA_VW + voff(kidx, c)) = tv[i]; } }
            __syncthreads();
            if (grp == 0) {
                f32x4 sc[16];
#pragma unroll
                for (int tt = 0; tt < 16; ++tt) {
                    const bf16x8 k0 = *(const LAS bf16x8*)(kc0 + 2048 * tt), k1 = *(const LAS bf16x8*)(kc1 + 2048 * tt);
                    f32x4 z = {0.f, 0.f, 0.f, 0.f}; z = __builtin_amdgcn_mfma_f32_16x16x32_bf16(k0, qp0, z, 0, 0, 0); sc[tt] = __builtin_amdgcn_mfma_f32_16x16x32_bf16(k1, qp1, z, 0, 0, 0); }
                float mx = -INFINITY;
#pragma unroll
                for (int tt = 0; tt < 16; ++tt)
#pragma unroll
                    for (int i = 0; i < 4; ++i) mx = fmaxf(mx, sc[tt][i]);
                mx = fmaxf(mx, __shfl_xor(mx, 16)); mx = fmaxf(mx, __shfl_xor(mx, 32));
                float ls = 0.f;
#pragma unroll
                for (int tt = 0; tt < 16; ++tt)
#pragma unroll
                    for (int i = 0; i < 4; ++i) { const float p = __expf(sc[tt][i] - mx); sc[tt][i] = p; ls += p; }
                ls += __shfl_xor(ls, 16); ls += __shfl_xor(ls, 32);
                mrun = mx; lrun = ls;
#pragma unroll
                for (int uu = 0; uu < 8; ++uu) { const bf16x8 pf = pack8(sc[2 * uu], sc[2 * uu + 1]);
#pragma unroll
                    for (int dt = 0; dt < 4; ++dt) { const s16x4 lo = lds_tr16(vcb + uu * 4096 + dt * 256), hi = lds_tr16(vcb + uu * 4096 + 2048 + dt * 256);
                        const bf16x8 af = {lo[0], lo[1], lo[2], lo[3], hi[0], hi[1], hi[2], hi[3]}; o[dt] = __builtin_amdgcn_mfma_f32_16x16x32_bf16(af, pf, o[dt], 0, 0, 0); } }
            }
            f32x4 sw[8];
#pragma unroll
            for (int tt = 0; tt < 8; ++tt) { const int al = tt >> 1, cg = tt & 1;
                const bf16x8 k0 = *(const LAS bf16x8*)(kwb0 + (al * 64 + 16 * cg) * 128), k1 = *(const LAS bf16x8*)(kwb1 + (al * 64 + 16 * cg) * 128);
                f32x4 z = {0.f, 0.f, 0.f, 0.f}; z = __builtin_amdgcn_mfma_f32_16x16x32_bf16(k0, qr0, z, 0, 0, 0); sw[tt] = __builtin_amdgcn_mfma_f32_16x16x32_bf16(k1, qr1, z, 0, 0, 0); }
            float mx = mrun;
            const LAS float* blg = bl + grp * 256;
#pragma unroll
            for (int tt = 0; tt < 8; ++tt) { const int al = tt >> 1, cg = tt & 1;
#pragma unroll
                for (int i = 0; i < 4; ++i) { const unsigned rel = (unsigned)(kcl + 16 * cg + i); const float s = rel < 16u ? sw[tt][i] + blg[al * 64 + 16 * cg + i] : -INFINITY; sw[tt][i] = s; mx = fmaxf(mx, s); } }
            mx = fmaxf(mx, __shfl_xor(mx, 16)); mx = fmaxf(mx, __shfl_xor(mx, 32));
            const float scale = __expf(mrun - mx); mrun = mx;
            float ls = 0.f;
#pragma unroll
            for (int tt = 0; tt < 8; ++tt)
#pragma unroll
                for (int i = 0; i < 4; ++i) { const float p = __expf(sw[tt][i] - mx); sw[tt][i] = p; ls += p; }
            ls += __shfl_xor(ls, 16); ls += __shfl_xor(ls, 32);
            lrun = lrun * scale + ls;
#pragma unroll
            for (int dt = 0; dt < 4; ++dt) o[dt] = o[dt] * scale;
#pragma unroll
            for (int al = 0; al < 4; ++al) { const bf16x8 pf = pack8(sw[2 * al], sw[2 * al + 1]);
#pragma unroll
                for (int dt = 0; dt < 4; ++dt) { const s16x4 lo = lds_tr16(vwb + al * 8192 + dt * 256), hi = lds_tr16(vwb + al * 8192 + 2048 + dt * 256);
                    const bf16x8 af = {lo[0], lo[1], lo[2], lo[3], hi[0], hi[1], hi[2], hi[3]}; o[dt] = __builtin_amdgcn_mfma_f32_16x16x32_bf16(af, pf, o[dt], 0, 0, 0); } }
        }
        const float inv = 1.0f / lrun;
#pragma unroll
        for (int dt = 0; dt < 4; ++dt) st_bf4(MIXIN + mq * DM + h * 64 + 16 * dt + 4 * g, o[dt] * inv);
    }
}

__device__ __forceinline__ int hg_row(int b, int dir, int c, int j) {
    const int tt = (c < 4 ? 64 * c : 64 * (c - 4)) + j;
    return c < 4 ? MROWS + b * CTXL + (dir ? 255 - tt : tt) : b * SEQ + (dir ? 8191 - tt : tt);
}

constexpr size_t WS_DSEG = 5 * MiB;
constexpr size_t WS_KVSEG = 8 * MiB;
constexpr size_t WS_SINS = 40 * MiB;
constexpr int HG_QD = 0, HG_KD = 16384, HG_KET = 32768, HG_VT = 49152, HG_AT = 65536, HG_ST = 73728, HG_DEC = 75776, HG_END = 76288;
__device__ __forceinline__ int off256(int row, int c) { return row * 256 + ((c ^ (row & 15)) << 4); }
__device__ __forceinline__ int off128(int row, int c) { return row * 128 + ((c ^ ((row >> 1) & 7)) << 4); }

struct HgRaw { float lf[16]; unsigned qv[16], vv[16]; };
template <bool FULL>
__device__ __forceinline__ void hg_load(const Ctx& C, int b, int h, int dir, int c, const float* LF, const bf16* QH, const bf16* IH, HgRaw& r) {
    const int ch = C.tid & 127, tq = C.tid >> 7;
#pragma unroll
    for (int i = 0; i < 16; ++i) { const size_t o = (size_t)hg_row(b, dir, c, 16 * tq + i) * 512 + h * 128 + ch; r.lf[i] = LF[o]; r.vv[i] = IH[o]; r.qv[i] = FULL ? (unsigned)QH[o] : 0u; }
}
template <bool FULL>
__device__ __forceinline__ float hg_prep(const Ctx& C, const HgRaw& r) {
    LAS unsigned char* L = C.lds; LAS float* sT = (LAS float*)(L + HG_ST); LAS float* sDec = (LAS float*)(L + HG_DEC);
    const int ch = C.tid & 127, tq = C.tid >> 7;
    float bl[16]; float run = 0.f;
#pragma unroll
    for (int i = 0; i < 16; ++i) { run += r.lf[i]; bl[i] = run; }
    sT[tq * 128 + ch] = run;
    __syncthreads();
    float off = 0.f, tot = 0.f;
#pragma unroll
    for (int t = 0; t < 4; ++t) { const float x = sT[t * 128 + ch]; off += (t < tq) ? x : 0.f; tot += x; }
    unsigned ke[8], vt[8];
#pragma unroll
    for (int i = 0; i < 16; i += 2) {
        const float b0 = off + bl[i], b1 = off + bl[i + 1];
        const float k0 = 1.0f - __expf(r.lf[i]), k1 = 1.0f - __expf(r.lf[i + 1]);
        ke[i >> 1] = pk2(k0 * __expf(tot - b0), k1 * __expf(tot - b1));
        vt[i >> 1] = r.vv[i] | (r.vv[i + 1] << 16);
        if (FULL) {
            const int t0 = 16 * tq + i;
            *(LAS unsigned short*)(L + HG_QD + off256(t0, ch >> 3) + (ch & 7) * 2) = (unsigned short)f2bf(bf2f(r.qv[i]) * __expf(b0));
            *(LAS unsigned short*)(L + HG_QD + off256(t0 + 1, ch >> 3) + (ch & 7) * 2) = (unsigned short)f2bf(bf2f(r.qv[i + 1]) * __expf(b1));
            *(LAS unsigned short*)(L + HG_KD + off256(t0, ch >> 3) + (ch & 7) * 2) = (unsigned short)f2bf(k0 * __expf(-b0));
            *(LAS unsigned short*)(L + HG_KD + off256(t0 + 1, ch >> 3) + (ch & 7) * 2) = (unsigned short)f2bf(k1 * __expf(-b1));
        }
    }
    *(LAS u32x4*)(L + HG_KET + off128(ch, 2 * tq)) = (u32x4){ke[0], ke[1], ke[2], ke[3]};
    *(LAS u32x4*)(L + HG_KET + off128(ch, 2 * tq + 1)) = (u32x4){ke[4], ke[5], ke[6], ke[7]};
    *(LAS u32x4*)(L + HG_VT + off128(ch, 2 * tq)) = (u32x4){vt[0], vt[1], vt[2], vt[3]};
    *(LAS u32x4*)(L + HG_VT + off128(ch, 2 * tq + 1)) = (u32x4){vt[4], vt[5], vt[6], vt[7]};
    if (tq == 0) sDec[ch] = __expf(tot);
    return tot;
}
__device__ __forceinline__ void hg_update(const Ctx& C, f32x4 (&S)[8]) {
    LAS unsigned char* L = C.lds; const LAS float* sDec = (const LAS float*)(L + HG_DEC);
    const int q = C.lane & 15, g = C.lane >> 4, v0 = 16 * C.wave;
    const bf16x8 vb0 = *(const LAS bf16x8*)(L + HG_VT + off128(v0 + q, g)), vb1 = *(const LAS bf16x8*)(L + HG_VT + off128(v0 + q, 4 + g));
#pragma unroll
    for (int kt = 0; kt < 8; ++kt) { const f32x4 d4 = *(const LAS f32x4*)(sDec + 16 * kt + 4 * g); f32x4 acc = S[kt] * d4;
        const bf16x8 a0 = *(const LAS bf16x8*)(L + HG_KET + off128(16 * kt + q, g)), a1 = *(const LAS bf16x8*)(L + HG_KET + off128(16 * kt + q, 4 + g));
        acc = __builtin_amdgcn_mfma_f32_16x16x32_bf16(a0, vb0, acc, 0, 0, 0); S[kt] = __builtin_amdgcn_mfma_f32_16x16x32_bf16(a1, vb1, acc, 0, 0, 0); }
}

__device__ __forceinline__ void phase_hg_agg(const Ctx& C) {
    const float* LFF = wsp<float>(C, WS_LFF); const float* LFB = wsp<float>(C, WS_LFB); const bf16 *QH = wsp<bf16>(C, WS_QH), *IH = wsp<bf16>(C, WS_IH);
    float* DSEG = wsp<float>(C, WS_DSEG); float* KVSEG = wsp<float>(C, WS_KVSEG);
    const int UPB = (512 + C.G - 1) / C.G, u_lo = blockIdx.x * UPB, u_hi = min(512, u_lo + UPB);
    const int q = C.lane & 15, g = C.lane >> 4;
    const int nsteps = (u_hi - u_lo) * 4;
    HgRaw raw;
    if (nsteps > 0) { const int bhd = u_lo >> 5, seg = u_lo & 31; hg_load<false>(C, bhd >> 3, (bhd >> 1) & 3, bhd & 1, 4 * seg, (bhd & 1) ? LFB : LFF, QH, IH, raw); }
    f32x4 S[8]; float total = 0.f;
#pragma unroll 1
    for (int t = 0; t < nsteps; ++t) {
        const int u = u_lo + (t >> 2), cc = t & 3;
        if (cc == 0) { total = 0.f;
#pragma unroll
            for (int kt = 0; kt < 8; ++kt) S[kt] = (f32x4){0.f, 0.f, 0.f, 0.f}; }
        total += hg_prep<false>(C, raw);
        if (t + 1 < nsteps) { const int un = u_lo + ((t + 1) >> 2), bhd = un >> 5, seg = un & 31; hg_load<false>(C, bhd >> 3, (bhd >> 1) & 3, bhd & 1, 4 * seg + ((t + 1) & 3), (bhd & 1) ? LFB : LFF, QH, IH, raw); }
        __syncthreads();
        hg_update(C, S);
        if (cc == 3) {
            if (C.tid < 128) DSEG[(size_t)u * 128 + C.tid] = __expf(total);
            float* kv = KVSEG + (size_t)u * 16384 + 16 * C.wave + q;
#pragma unroll
            for (int kt = 0; kt < 8; ++kt)
#pragma unroll
                for (int i = 0; i < 4; ++i) kv[(16 * kt + 4 * g + i) * 128] = S[kt][i];
        }
    }
}
__device__ __forceinline__ void phase_hg_scan(const Ctx& C) {
    const float* DSEG = wsp<float>(C, WS_DSEG); const float* KVSEG = wsp<float>(C, WS_KVSEG); float* SIN = wsp<float>(C, WS_SINS);
    for (int e2 = blockIdx.x * NTHR + C.tid; e2 < 16 * 8192; e2 += C.G * NTHR) {
        const int bhd = e2 >> 13, el = (e2 & 8191) * 2, k = el >> 7;
        const float* kv = KVSEG + (size_t)bhd * 32 * 16384 + el; const float* ds = DSEG + (size_t)bhd * 32 * 128 + k; float* so = SIN + (size_t)bhd * 32 * 16384 + el;
        f32x2 cur = *(const f32x2*)kv; *(f32x2*)so = cur;
        f32x2 kvn[8]; float dn[8];
#pragma unroll 1
        for (int s0 = 1; s0 < 32; s0 += 8) {
#pragma unroll
            for (int i = 0; i < 8; ++i) { const int s = min(s0 + i, 31); kvn[i] = *(const f32x2*)(kv + (size_t)s * 16384); dn[i] = ds[s * 128]; }
#pragma unroll
            for (int i = 0; i < 8; ++i) if (s0 + i < 32) { cur = dn[i] * cur + kvn[i]; *(f32x2*)(so + (size_t)(s0 + i) * 16384) = cur; }
        }
    }
}
constexpr int HG_OFS = HG_END;
constexpr int HG_OS = HG_QD;
static_assert(HG_OFS + 256 * 128 * 2 + LDSCTL_BYTES <= LDS_BYTES && 64 * 128 * 4 <= HG_KET, "hg_out LDS map");
__device__ __forceinline__ void phase_hg_out(const Ctx& C) {
    const Args& a = C.a;
    const float* LFF = wsp<float>(C, WS_LFF); const float* LFB = wsp<float>(C, WS_LFB); const bf16 *QH = wsp<bf16>(C, WS_QH), *IH = wsp<bf16>(C, WS_IH), *GH = wsp<bf16>(C, WS_GH);
    const float* SIN = wsp<float>(C, WS_SINS); const float* hgn = a.in[I_HGN]; bf16* MIXIN = wsp<bf16>(C, WS_MIXIN);
    LAS unsigned char* L = C.lds;
    const int UPB = (256 + C.G - 1) / C.G, u_lo = blockIdx.x * UPB, u_hi = min(256, u_lo + UPB);
    const int q = C.lane & 15, g = C.lane >> 4, v0 = 16 * C.wave;
    for (int u = u_lo; u < u_hi; ++u) {
        const int bh = u >> 5, ls = u & 31, b = bh >> 2, h = bh & 3;
        HgRaw raw;
        hg_load<true>(C, b, h, 0, 4 + 4 * ls, LFF, QH, IH, raw);
        f32x4 S[8];
#pragma unroll 1
        for (int step = 0; step < 8; ++step) {
            const int dir = step >> 2, cc = step & 3;
            {
                const int bhd = bh * 2 + dir, segl = dir ? 31 - ls : ls;
                if (cc == 0) { const float* si = SIN + ((size_t)bhd * 32 + segl) * 16384 + v0 + q;
#pragma unroll
                  for (int kt = 0; kt < 8; ++kt)
#pragma unroll
                      for (int i = 0; i < 4; ++i) S[kt][i] = si[(16 * kt + 4 * g + i) * 128]; }
                (void)hg_prep<true>(C, raw);
                if (step < 7) { const int dn = (step + 1) >> 2, sn = dn ? 31 - ls : ls; hg_load<true>(C, b, h, dn, 4 + 4 * sn + ((step + 1) & 3), dn ? LFB : LFF, QH, IH, raw); }
                __syncthreads();
#pragma unroll
                for (int t2 = 0; t2 < 2; ++t2) { const int id = 2 * C.wave + t2, st = id >> 2, jt = id & 3;
                    f32x4 acc = {0.f, 0.f, 0.f, 0.f};
                    if (st <= jt) {
#pragma unroll
                        for (int ks = 0; ks < 4; ++ks) { const bf16x8 ka = *(const LAS bf16x8*)(L + HG_KD + off256(16 * st + q, 4 * ks + g)), qb = *(const LAS bf16x8*)(L + HG_QD + off256(16 * jt + q, 4 * ks + g));
                            acc = __builtin_amdgcn_mfma_f32_16x16x32_bf16(ka, qb, acc, 0, 0, 0); }
#pragma unroll
                        for (int i = 0; i < 4; ++i) if (16 * st + 4 * g + i > 16 * jt + q) acc[i] = 0.f;
                    }
                    u32x2 w; w.x = pk2(acc[0], acc[1]); w.y = pk2(acc[2], acc[3]);
                    *(LAS u32x2*)(L + HG_AT + off128(16 * jt + q, 2 * st + (g >> 1)) + (g & 1) * 8) = w; }
                __syncthreads();
                f32x4 o[4];
#pragma unroll
                for (int jt = 0; jt < 4; ++jt) o[jt] = (f32x4){0.f, 0.f, 0.f, 0.f};
                { const bf16x8 vb0 = *(const LAS bf16x8*)(L + HG_VT + off128(v0 + q, g)), vb1 = *(const LAS bf16x8*)(L + HG_VT + off128(v0 + q, 4 + g));
#pragma unroll
                  for (int jt = 0; jt < 4; ++jt) { const bf16x8 a0 = *(const LAS bf16x8*)(L + HG_AT + off128(16 * jt + q, g)), a1 = *(const LAS bf16x8*)(L + HG_AT + off128(16 * jt + q, 4 + g));
                      o[jt] = __builtin_amdgcn_mfma_f32_16x16x32_bf16(a0, vb0, o[jt], 0, 0, 0); o[jt] = __builtin_amdgcn_mfma_f32_16x16x32_bf16(a1, vb1, o[jt], 0, 0, 0); } }
#pragma unroll
                for (int sp = 0; sp < 4; ++sp) { const bf16x8 sb = pack8(S[2 * sp], S[2 * sp + 1]);
#pragma unroll
                    for (int jt = 0; jt < 4; ++jt) { const int row = 16 * jt + q;
                        const s16x4 lo = *(const LAS s16x4*)(L + HG_QD + off256(row, 4 * sp + (g >> 1)) + (g & 1) * 8), hi = *(const LAS s16x4*)(L + HG_QD + off256(row, 4 * sp + 2 + (g >> 1)) + (g & 1) * 8);
                        const bf16x8 af = {lo[0], lo[1], lo[2], lo[3], hi[0], hi[1], hi[2], hi[3]};
                        o[jt] = __builtin_amdgcn_mfma_f32_16x16x32_bf16(af, sb, o[jt], 0, 0, 0); } }
                if (dir == 0) {
#pragma unroll
                    for (int jt = 0; jt < 4; ++jt)
#pragma unroll
                        for (int i = 0; i < 4; ++i) *(LAS unsigned short*)(L + HG_OFS + (64 * cc + 16 * jt + 4 * g + i) * 256 + (v0 + q) * 2) = (unsigned short)f2bf(o[jt][i]);
                    if (cc < 3) hg_update(C, S);
                } else {
#pragma unroll
                    for (int jt = 0; jt < 4; ++jt)
#pragma unroll
                        for (int i = 0; i < 4; ++i) o[jt][i] += bf2f(*(const LAS unsigned short*)(L + HG_OFS + (255 - 64 * cc - (16 * jt + 4 * g + i)) * 256 + (v0 + q) * 2));
                    if (cc < 3) hg_update(C, S);
                    __syncthreads();
#pragma unroll
                    for (int jt = 0; jt < 4; ++jt)
#pragma unroll
                        for (int i = 0; i < 4; ++i) *(LAS float*)(L + HG_OS + ((16 * jt + 4 * g + i) * 128 + v0 + q) * 4) = o[jt][i];
                    unsigned gwp[8];
#pragma unroll
                    for (int jj = 0; jj < 8; ++jj) { const size_t row = (size_t)b * SEQ + 256 * ls + 255 - 64 * cc - (8 * C.wave + jj); gwp[jj] = *(const unsigned*)(GH + row * 512 + h * 128 + 2 * C.lane); }
                    __syncthreads();
#pragma unroll
                    for (int jj = 0; jj < 8; ++jj) { const int j = 8 * C.wave + jj; const size_t row = (size_t)b * SEQ + 256 * ls + 255 - 64 * cc - j;
                        const f32x2 ov = *(const LAS f32x2*)(L + HG_OS + (j * 128 + 2 * C.lane) * 4);
                        const float rstd = 1.0f / sqrtf(wave_sum(ov.x * ov.x + ov.y * ov.y) * (1.0f / 128.0f) + RMS_EPS);
                        const unsigned gw2 = gwp[jj]; const f32x2 nn = *(const f32x2*)(hgn + 2 * C.lane);
                        *(unsigned*)(MIXIN + row * DM + 512 + h * 128 + 2 * C.lane) = pk2(ov.x * rstd * nn.x * sigmoidf_(bflo(gw2)), ov.y * rstd * nn.y * sigmoidf_(bfhi(gw2))); }
                }
            }
        }
    }
}

__device__ __forceinline__ void phase_rowpass(const Ctx& C) {
    const Args& a = C.a;
    LAS float* sW = (LAS float*)C.lds;
    LAS float* sC = sW + 16 * 1024;
    const float* modf = wsp<float>(C, WS_MODF);
    { const float* WRT = wsp<float>(C, WS_WRT);
#pragma unroll 4
      for (int i = 0; i < 8; ++i) { const int idx = C.tid + 512 * i; *(LAS f32x4*)(sW + 4 * idx) = *(const f32x4*)(WRT + 4 * idx); }
      for (int j4 = C.tid; j4 < 1536; j4 += NTHR) { const int bb = j4 / 768, rem = j4 % 768, wh = rem >> 8, ch = (rem & 255) * 4; const float* mf = modf + bb * 6144;
          f32x4 v;
          if (wh == 0) v = *(const f32x4*)(a.in[I_GPOST1] + ch) * *(const f32x4*)(mf + 2048 + ch);
          else if (wh == 1) v = *(const f32x4*)(a.in[I_GPRE2] + ch) * (1.0f + *(const f32x4*)(mf + 4096 + ch));
          else v = *(const f32x4*)(mf + 3072 + ch);
          *(LAS f32x4*)(sC + (bb * 3 + wh) * 1024 + ch) = v; } }
    __syncthreads();
    const float* MIX = wsp<float>(C, WS_MIX); float* AFF = wsp<float>(C, WS_AFF); unsigned char* H2 = C.ws + WS_H2;
    const int gw = blockIdx.x * NWAVES + C.wave, NGW = C.G * NWAVES;
    const int b5 = (C.lane >> 5) & 1, b4 = (C.lane >> 4) & 1, b3 = (C.lane >> 3) & 1, b2 = (C.lane >> 2) & 1, myexp = 8 * b5 + 4 * b4 + 2 * b3 + b2;
    if (2 * gw >= MROWS) return;
    f32x4 mx[2][4], xv[2][4], mxn[2][4], xvn[2][4], po[2][4]; unsigned ph[2][4]; float paff[2] = {0.f, 0.f};
    auto loadn = [&](int row0) {
#pragma unroll
        for (int r = 0; r < 2; ++r)
#pragma unroll
            for (int j = 0; j < 4; ++j) { const size_t o = (size_t)(row0 + r) * DM + 4 * (C.lane + 64 * j); mxn[r][j] = *(const f32x4*)(MIX + o); xvn[r][j] = *(const f32x4*)(a.in[I_X] + o); }
    };
    auto storep = [&](int row0) {
        const int b = row0 >> 13;
#pragma unroll
        for (int r = 0; r < 2; ++r) {
#pragma unroll
            for (int j = 0; j < 4; ++j) { const int ch = 4 * (C.lane + 64 * j); *(f32x4*)(a.out + (size_t)(row0 + r) * DM + ch) = po[r][j]; *(unsigned*)(H2 + (size_t)(row0 + r) * DM + ch) = ph[r][j]; }
            if ((C.lane & 3) == 0) AFF[((size_t)b * 16 + myexp) * SEQ + ((row0 + r) & 8191)] = paff[r]; }
    };
#pragma unroll
    for (int r = 0; r < 2; ++r)
#pragma unroll
        for (int j = 0; j < 4; ++j) { po[r][j] = (f32x4){0.f, 0.f, 0.f, 0.f}; ph[r][j] = 0u; }
    loadn(2 * gw);
    int prow = 2 * gw;
    for (int row0 = 2 * gw; row0 < MROWS; row0 += 2 * NGW) {
        const int b = row0 >> 13; const LAS float* cc = sC + b * 3072;
        float ss[2];
#pragma unroll
        for (int r = 0; r < 2; ++r) { ss[r] = 0.f;
#pragma unroll
            for (int j = 0; j < 4; ++j) { mx[r][j] = mxn[r][j]; xv[r][j] = xvn[r][j]; } }
        storep(prow); prow = row0;
        loadn(row0 + 2 * NGW < MROWS ? row0 + 2 * NGW : row0);
#pragma unroll
        for (int r = 0; r < 2; ++r)
#pragma unroll
            for (int j = 0; j < 4; ++j) ss[r] += (mx[r][j].x * mx[r][j].x + mx[r][j].y * mx[r][j].y) + (mx[r][j].z * mx[r][j].z + mx[r][j].w * mx[r][j].w);
#pragma unroll
        for (int o = 1; o < 64; o <<= 1) { ss[0] += __shfl_xor(ss[0], o); ss[1] += __shfl_xor(ss[1], o); }
        float ss2[2] = {0.f, 0.f};
#pragma unroll
        for (int j = 0; j < 4; ++j) { const int ch = 4 * (C.lane + 64 * j); const f32x4 c1 = *(const LAS f32x4*)(cc + ch);
#pragma unroll
            for (int r = 0; r < 2; ++r) { const float rstd1 = 1.0f / sqrtf(ss[r] * (1.0f / DM) + RMS_EPS);
                xv[r][j] = xv[r][j] + c1 * (mx[r][j] * rstd1); po[r][j] = xv[r][j];
                ss2[r] += (xv[r][j].x * xv[r][j].x + xv[r][j].y * xv[r][j].y) + (xv[r][j].z * xv[r][j].z + xv[r][j].w * xv[r][j].w); } }
#pragma unroll
        for (int o = 1; o < 64; o <<= 1) { ss2[0] += __shfl_xor(ss2[0], o); ss2[1] += __shfl_xor(ss2[1], o); }
#pragma unroll
        for (int j = 0; j < 4; ++j) { const int ch = 4 * (C.lane + 64 * j); const f32x4 c2 = *(const LAS f32x4*)(cc + 1024 + ch), sh = *(const LAS f32x4*)(cc + 2048 + ch);
#pragma unroll
            for (int r = 0; r < 2; ++r) { const float rstd2 = 1.0f / sqrtf(ss2[r] * (1.0f / DM) + RMS_EPS);
                xv[r][j] = xv[r][j] * (rstd2 * c2) + sh; ph[r][j] = pk4_fp8(xv[r][j].x * H2_SCALE, xv[r][j].y * H2_SCALE, xv[r][j].z * H2_SCALE, xv[r][j].w * H2_SCALE); } }
#pragma unroll
        for (int r = 0; r < 2; ++r) {
            float lg[16];
#pragma unroll
            for (int e = 0; e < 16; ++e) { float p = 0.f;
#pragma unroll
                for (int j = 0; j < 4; ++j) { const f32x4 w = *(const LAS f32x4*)(sW + e * 1024 + 4 * (C.lane + 64 * j)); const f32x4 h = xv[r][j]; p += (h.x * w.x + h.y * w.y) + (h.z * w.z + h.w * w.w); }
                lg[e] = p; if ((e & 3) == 3) asm volatile("" ::: "memory"); }
            float l8[8], l4[4], l2[2], l1;
#pragma unroll
            for (int e = 0; e < 8; ++e) { const float keep = b5 ? lg[e + 8] : lg[e], send = b5 ? lg[e] : lg[e + 8]; l8[e] = keep + __shfl_xor(send, 32); }
#pragma unroll
            for (int e = 0; e < 4; ++e) { const float keep = b4 ? l8[e + 4] : l8[e], send = b4 ? l8[e] : l8[e + 4]; l4[e] = keep + __shfl_xor(send, 16); }
#pragma unroll
            for (int e = 0; e < 2; ++e) { const float keep = b3 ? l4[e + 2] : l4[e], send = b3 ? l4[e] : l4[e + 2]; l2[e] = keep + __shfl_xor(send, 8); }
            { const float keep = b2 ? l2[1] : l2[0], send = b2 ? l2[0] : l2[1]; l1 = keep + __shfl_xor(send, 4); }
            l1 += __shfl_xor(l1, 2); l1 += __shfl_xor(l1, 1);
            float mxl = l1;
#pragma unroll
            for (int o = 4; o < 64; o <<= 1) mxl = fmaxf(mxl, __shfl_xor(mxl, o));
            const float p = expf(l1 - mxl); float den = p;
#pragma unroll
            for (int o = 4; o < 64; o <<= 1) den += __shfl_xor(den, o);
            paff[r] = p / den;
        }
    }
    storep(prow);
}

__device__ __forceinline__ void phase_topk(const Ctx& C) {
    if (blockIdx.x >= 32) { convert_tiles(C, CV_D1_END, CV_NT, (int)blockIdx.x - 32, C.G - 32); return; }
    const int list = blockIdx.x, b = list >> 4, e = list & 15;
    LAS unsigned* keys = (LAS unsigned*)C.lds;
    LAS unsigned* hist = keys + 8192;
    volatile LAS unsigned* misc = hist + 256;
    LAS unsigned* wtot = hist + 256 + 8;
    const float* AFF = wsp<float>(C, WS_AFF) + (size_t)list * SEQ;
#pragma unroll
    for (int i = 0; i < 4; ++i) *(LAS u32x4*)(keys + 4 * (C.tid + 512 * i)) = *(const u32x4*)(AFF + 4 * (C.tid + 512 * i));
    if (C.tid == 0) { misc[0] = 0u; misc[1] = (unsigned)CAP; }
    __syncthreads();
    unsigned prefix = 0u, mask = 0u;
    for (int pass = 3; pass >= 0; --pass) {
        if (C.tid < 256) hist[C.tid] = 0u;
        __syncthreads();
#pragma unroll
        for (int i = 0; i < 16; ++i) { const unsigned key = keys[C.tid + 512 * i]; if ((key & mask) == prefix) atomicAdd((unsigned*)&hist[(key >> (8 * pass)) & 255u], 1u); }
        __syncthreads();
        if (C.wave == 0) {
            const u32x4 h4 = *(const LAS u32x4*)(hist + 4 * C.lane); const unsigned s = h4.x + h4.y + h4.z + h4.w; unsigned inc = s;
#pragma unroll
            for (int o = 1; o < 64; o <<= 1) { const unsigned t = __shfl_down(inc, o); if (C.lane + o < 64) inc += t; }
            const unsigned need = misc[1]; unsigned cum = inc - s;
            int chosen = -1; unsigned nn = 0u;
            if (cum < need && need <= cum + h4.w) { chosen = 4 * C.lane + 3; nn = need - cum; } cum += h4.w;
            if (cum < need && need <= cum + h4.z) { chosen = 4 * C.lane + 2; nn = need - cum; } cum += h4.z;
            if (cum < need && need <= cum + h4.y) { chosen = 4 * C.lane + 1; nn = need - cum; } cum += h4.y;
            if (cum < need && need <= cum + h4.x) { chosen = 4 * C.lane + 0; nn = need - cum; }
            if (chosen >= 0) { misc[0] = prefix | ((unsigned)chosen << (8 * pass)); misc[1] = nn; }
        }
        __syncthreads();
        prefix = misc[0]; mask |= 0xFFu << (8 * pass);
    }
    const unsigned T = prefix, need_eq = misc[1];
    const int base = C.tid * 16; unsigned cgt = 0u, ceq = 0u; unsigned kk[16];
#pragma unroll
    for (int i = 0; i < 4; ++i) { const u32x4 k4 = *(const LAS u32x4*)(keys + base + 4 * i); kk[4 * i] = k4.x; kk[4 * i + 1] = k4.y; kk[4 * i + 2] = k4.z; kk[4 * i + 3] = k4.w; }
#pragma unroll
    for (int i = 0; i < 16; ++i) { cgt += kk[i] > T ? 1u : 0u; ceq += kk[i] == T ? 1u : 0u; }
    unsigned ig = cgt, ie = ceq;
#pragma unroll
    for (int o = 1; o < 64; o <<= 1) { const unsigned tg = __shfl_up(ig, o), te = __shfl_up(ie, o); if (C.lane >= o) { ig += tg; ie += te; } }
    if (C.lane == 63) { wtot[C.wave] = ig; wtot[8 + C.wave] = ie; }
    __syncthreads();
    unsigned gpre = ig - cgt, epre = ie - ceq;
    for (int w = 0; w < C.wave; ++w) { gpre += wtot[w]; epre += wtot[8 + w]; }
    int* IDX = wsp<int>(C, WS_IDX) + list * CAP; float* GATEV = wsp<float>(C, WS_GATEV) + (e * 2 + b) * CAP; int* SLOT = wsp<int>(C, WS_SLOT);
#pragma unroll
    for (int i = 0; i < 16; ++i) { const int t = base + i; const unsigned key = kk[i]; int pos = -1;
        if (key > T) { pos = (int)(gpre + min(epre, need_eq)); ++gpre; }
        else if (key == T) { if (epre < need_eq) pos = (int)(gpre + epre); ++epre; }
        if (pos >= 0) { IDX[pos] = t; GATEV[pos] = __builtin_bit_cast(float, key); }
        SLOT[((size_t)b * SEQ + t) * 16 + e] = pos; }
}

__device__ __forceinline__ void phase_final(const Ctx& C) {
    const Args& a = C.a;
    const int gw = blockIdx.x * NWAVES + C.wave, NGW = C.G * NWAVES;
    const int* SLOT = wsp<int>(C, WS_SLOT); const bf16* YS = wsp<bf16>(C, WS_YS); const float* modf = wsp<float>(C, WS_MODF);
    for (int row = gw; row < MROWS; row += NGW) {
        const int b = row >> 13; const float* mf = modf + b * 6144;
        const int sv = SLOT[(size_t)row * 16 + (C.lane & 15)];
        f32x4 x1[4];
#pragma unroll
        for (int j = 0; j < 4; ++j) x1[j] = *(const f32x4*)(a.out + (size_t)row * DM + 4 * (C.lane + 64 * j));
        unsigned long long mask = __ballot(sv >= 0) & 0xFFFFull;
        f32x4 acc[4];
#pragma unroll
        for (int j = 0; j < 4; ++j) acc[j] = (f32x4){0.f, 0.f, 0.f, 0.f};
        while (mask) {
            const int e0 = __builtin_ctzll(mask); mask &= mask - 1; const bool two = mask != 0ull; const int e1 = two ? __builtin_ctzll(mask) : e0; mask &= mask - 1;
            const bf16* y0 = YS + ((size_t)(e0 * 2 + b) * CAP + __builtin_amdgcn_readlane(sv, e0)) * DM; const bf16* y1 = YS + ((size_t)(e1 * 2 + b) * CAP + __builtin_amdgcn_readlane(sv, e1)) * DM;
            u32x2 w0[4], w1[4];
#pragma unroll
            for (int j = 0; j < 4; ++j) { w0[j] = *(const u32x2*)(y0 + 4 * (C.lane + 64 * j)); w1[j] = *(const u32x2*)(y1 + 4 * (C.lane + 64 * j)); }
            const float f1 = two ? 1.f : 0.f;
#pragma unroll
            for (int j = 0; j < 4; ++j) { acc[j].x += bflo(w0[j].x) + f1 * bflo(w1[j].x); acc[j].y += bfhi(w0[j].x) + f1 * bfhi(w1[j].x); acc[j].z += bflo(w0[j].y) + f1 * bflo(w1[j].y); acc[j].w += bfhi(w0[j].y) + f1 * bfhi(w1[j].y); } }
        float ss = 0.f;
#pragma unroll
        for (int j = 0; j < 4; ++j) ss += (acc[j].x * acc[j].x + acc[j].y * acc[j].y) + (acc[j].z * acc[j].z + acc[j].w * acc[j].w);
        const float rstd = 1.0f / sqrtf(wave_sum(ss) * (1.0f / DM) + RMS_EPS);
#pragma unroll
        for (int j = 0; j < 4; ++j) { const int ch = 4 * (C.lane + 64 * j);
            const f32x4 gp = *(const f32x4*)(a.in[I_GPOST2] + ch), gt = *(const f32x4*)(mf + 5120 + ch);
            *(f32x4*)(a.out + (size_t)row * DM + ch) = x1[j] + gt * (acc[j] * rstd * gp); }
    }
}

constexpr int GTAB_OFF = 131072;
__device__ __forceinline__ void phase_gemm_in(const Ctx& C) {
    const int Mg = MTOT;
    pg8::Gemm g{wsp<bf16>(C, WS_H), wsp<bf16>(C, WS_WINT), Mg, NINC, DM, 0, 0, 0}; pg8::StaticOrder S; S.init(Mg, NINC, C.G, (int)blockIdx.x);
    LAS float* tb = (LAS float*)(C.lds + GTAB_OFF);
    for (int i = C.tid; i < 2048; i += NTHR) { tb[i] = wsp<float>(C, WS_COS)[i]; tb[2048 + i] = wsp<float>(C, WS_SIN)[i]; }
    if (C.tid < 512) tb[4096 + C.tid] = wsp<float>(C, WS_LB)[C.tid];
    __syncthreads();
    EpiIn E{wsp<bf16>(C, WS_QP), wsp<bf16>(C, WS_QR), wsp<bf16>(C, WS_KR), wsp<bf16>(C, WS_V), wsp<bf16>(C, WS_QH), wsp<bf16>(C, WS_IH), wsp<bf16>(C, WS_GH),
            wsp<float>(C, WS_LFF), wsp<float>(C, WS_LFB), tb + 4096, tb, tb + 2048};
    const int nt_ = (Mg / 256) * (NINC / 256), rounds = (nt_ + C.G - 1) / C.G, lrt = nt_ - (rounds - 1) * C.G; const bool allc = lrt >= C.G;
    const bool conv = C.G > 32 && (allc || (int)blockIdx.x >= lrt); const int widx = allc ? (int)blockIdx.x : (int)blockIdx.x - lrt, nconv = allc ? C.G : C.G - lrt;
    if (conv && (widx & 1) == 0) { convert_tiles(C, CV_P0_END, CV_D1_END, widx, nconv); __syncthreads(); }
    pg8::gemm_phase<EpiIn, pg8::StaticOrder, true, true>(C.lds, g, S, E);
    if (conv && (widx & 1) == 1) convert_tiles(C, CV_P0_END, CV_D1_END, widx, nconv);
}
__device__ __forceinline__ void phase_gemm_out(const Ctx& C) {
    pg8::Gemm g{wsp<bf16>(C, WS_MIXIN), wsp<bf16>(C, WS_WOUTT), MROWS, DM, DM, 0, 0, 0}; pg8::StaticOrder S; S.init(MROWS, DM, C.G, (int)blockIdx.x);
    EpiF32 E{wsp<float>(C, WS_MIX), DM};
    pg8::gemm_phase<EpiF32, pg8::StaticOrder, true, true>(C.lds, g, S, E);
}
static_assert(LDSCTL_BYTES + GTAB_OFF + 23 * 1024 <= LDS_BYTES, "gather table");
__device__ __forceinline__ void phase_gemm1(const Ctx& C) {
    pg8::StaticOrder S; S.init(MEXP, N1P, C.G, (int)blockIdx.x);
    {
        const int* IDX = wsp<int>(C, WS_IDX); LAS int* tab = (LAS int*)(C.lds + GTAB_OFF); pg8::Unit u;
        for (int i = 0; i < 23 && S.next(i, u); ++i)
            if (C.tid < 256) { const int e = u.pm >> 3, b = (u.pm >> 2) & 1; tab[i * 256 + C.tid] = b * SEQ + IDX[(b * 16 + e) * CAP + (u.pm & 3) * 256 + C.tid]; }
        __syncthreads();
    }
    pg8::Gemm g{wsp<bf16>(C, WS_H2), wsp<bf16>(C, WS_W1T), MEXP, N1P, DM / 2, 3, (size_t)N1P * DM, GTAB_OFF};
    EpiHid E{C.ws + WS_HID};
    pg8::gemm_phase<EpiHid, pg8::StaticOrder, true, true, true, true>(C.lds, g, S, E);
}
__device__ __forceinline__ void phase_gemm2(const Ctx& C) {
    pg8::Gemm g{wsp<bf16>(C, WS_HID), wsp<bf16>(C, WS_W2T), MEXP, DM, FEP / 2, 3, (size_t)DM * FEP, 0}; pg8::StaticOrder S; S.init(MEXP, DM, C.G, (int)blockIdx.x);
    EpiYs E{wsp<bf16>(C, WS_YS), wsp<float>(C, WS_GATEV)};
    pg8::gemm_phase<EpiYs, pg8::StaticOrder, true, true, false, true>(C.lds, g, S, E);
}

__global__ void __launch_bounds__(NTHR, 2) fwd_kernel(Args args) {
    extern __shared__ __attribute__((aligned(16))) unsigned char lds_raw[];
    Ctx C; C.lds = (LAS unsigned char*)lds_raw + LDSCTL_BYTES; C.tid = threadIdx.x; C.lane = C.tid & 63; C.wave = __builtin_amdgcn_readfirstlane(C.tid >> 6); C.G = gridDim.x; C.a = args; C.ws = args.ws;
    if (C.tid < LDSCTL_BYTES / 4) ((LAS unsigned*)lds_raw)[C.tid] = 0u;
    __syncthreads();
    const bool multi = (args.ph_hi - args.ph_lo) > 1;
    XcdBarrier bar; bar.bar = (unsigned*)(C.ws + WS_CTL) + CW_BAR; bar.x = 0; bar.st = nullptr;
    if (multi) bar = xcd_barrier_post((unsigned*)(C.ws + WS_CTL) + CW_BAR, (volatile LAS unsigned*)((LAS unsigned char*)lds_raw) + 8);
    const int lo = args.ph_lo, hi = args.ph_hi;
#define IN(k) (lo <= (k) && (k) < hi)
#define SEAM(k) do { if ((k) + 1 < hi) xcd_barrier(bar); } while (0)
#if PH_ON(0)
    if (IN(0)) { for (int rep = 0; rep < 1 + REP_ON(0); ++rep) { phase_prologue(C); __syncthreads(); } SEAM(0); }
#endif
#if PH_ON(1)
    if (IN(1)) { for (int rep = 0; rep < 1 + REP_ON(1); ++rep) { phase_hrows(C); __syncthreads(); } SEAM(1); }
#endif
#if PH_ON(2)
    if (IN(2)) { for (int rep = 0; rep < 1 + REP_ON(2); ++rep) { phase_gemm_in(C); __syncthreads(); } SEAM(2); }
#endif
#if PH_ON(3)
    if (IN(3)) { for (int rep = 0; rep < 1 + REP_ON(3); ++rep) { phase_na(C); __syncthreads(); phase_hg_agg(C); __syncthreads(); } SEAM(3); }
#endif
#if PH_ON(4)
    if (IN(4)) { for (int rep = 0; rep < 1 + REP_ON(4); ++rep) { phase_hg_scan(C); __syncthreads(); } SEAM(4); }
#endif
#if PH_ON(5)
    if (IN(5)) { for (int rep = 0; rep < 1 + REP_ON(5); ++rep) { phase_hg_out(C); __syncthreads(); } SEAM(5); }
#endif
#if PH_ON(6)
    if (IN(6)) { for (int rep = 0; rep < 1 + REP_ON(6); ++rep) { phase_gemm_out(C); __syncthreads(); } SEAM(6); }
#endif
#if PH_ON(7)
    if (IN(7)) { for (int rep = 0; rep < 1 + REP_ON(7); ++rep) { phase_rowpass(C); __syncthreads(); } SEAM(7); }
#endif
#if PH_ON(8)
    if (IN(8)) { for (int rep = 0; rep < 1 + REP_ON(8); ++rep) { phase_topk(C); __syncthreads(); } SEAM(8); }
#endif
#if PH_ON(9)
    if (IN(9)) { for (int rep = 0; rep < 1 + REP_ON(9); ++rep) { phase_gemm1(C); __syncthreads(); } SEAM(9); }
#endif
#if PH_ON(10)
    if (IN(10)) { for (int rep = 0; rep < 1 + REP_ON(10); ++rep) { phase_gemm2(C); __syncthreads(); } SEAM(10); }
#endif
#if PH_ON(11)
    if (IN(11)) { for (int rep = 0; rep < 1 + REP_ON(11); ++rep) { phase_final(C); __syncthreads(); } SEAM(11); }
#endif
#undef IN
#undef SEAM
}

extern "C" void kernel_launch(void* const* d_in, const int* in_sizes, int n_in, void* d_out, int out_size, void* d_ws, size_t ws_size, hipStream_t stream) {
    static int grid = 0;
    if (grid == 0) {
        if (n_in != 19 || out_size != MROWS * DM || ws_size < WS_END) { fprintf(stderr, "kernel_launch: unexpected problem (n_in %d out %d ws %zu)\n", n_in, out_size, ws_size); grid = -1; return; }
        int dev = 0, cus = 0, per_cu = 0;
        if (hipGetDevice(&dev) != hipSuccess || hipDeviceGetAttribute(&cus, hipDeviceAttributeMultiprocessorCount, dev) != hipSuccess) { grid = -1; return; }
        if (hipFuncSetAttribute((const void*)fwd_kernel, hipFuncAttributeMaxDynamicSharedMemorySize, LDS_BYTES) != hipSuccess) { fprintf(stderr, "kernel_launch: hipFuncSetAttribute failed\n"); grid = -1; return; }
        if (hipOccupancyMaxActiveBlocksPerMultiprocessor(&per_cu, (const void*)fwd_kernel, NTHR, LDS_BYTES) != hipSuccess || per_cu < 1) { fprintf(stderr, "kernel_launch: occupancy query says %d\n", per_cu); }
        (void)hipGetLastError();
        grid = cus;
    }
    if (grid < 0) return;
    (void)hipMemsetAsync((char*)d_ws + WS_CTL, 0, CTL_ZERO_BYTES, stream);
    Args a{};
    for (int i = 0; i < 19; ++i) a.in[i] = (const float*)d_in[i];
    a.out = (float*)d_out; a.ws = (unsigned char*)d_ws;
#if MK_N_LAUNCHES == 1
    a.ph_lo = 0; a.ph_hi = NPHASE;
    hipLaunchKernelGGL(fwd_kernel, dim3(grid), dim3(NTHR), LDS_BYTES, stream, a);
#else
    for (int ph = 0; ph < NPHASE; ++ph) { a.ph_lo = ph; a.ph_hi = ph + 1; hipLaunchKernelGGL(fwd_kernel, dim3(grid), dim3(NTHR), LDS_BYTES, stream, a); }
#endif
}
```

```cpp
#include <hip/hip_runtime.h>
#include <cstdio>
#include <cstdint>
#include <cmath>
namespace pg8 {
#define PG8_LAS __attribute__((address_space(3)))
typedef unsigned short bf16_t;
typedef short bf16x8 __attribute__((ext_vector_type(8)));
typedef float f32x4 __attribute__((ext_vector_type(4)));
typedef unsigned u32x4 __attribute__((ext_vector_type(4)));
constexpr int BM = 256, BK = 64, HALF = 128, HTB = HALF * BK * 2  , STAGE_BYTES = 8 * HTB, NXCD = 8, WGM = 8;

__host__ __device__ __forceinline__ int lds_byte(int r, int c) { const int st = (r >> 4) * 2 + (c >> 5), rr = r & 15, cc = c & 31, ob = rr * 64 + cc * 2; return st * 1024 + (ob ^ (((ob >> 9) & 1) << 5)); }
__host__ __device__ __forceinline__ void stage_rc(int b, int& R, int& C) { const int st = b / 1024, sb = b % 1024, swz = sb ^ (((sb >> 9) & 1) << 5); R = (st >> 1) * 16 + swz / 64; C = (st & 1) * 32 + (swz % 64) / 2; }
__host__ __device__ __forceinline__ int perm32(int rho) { const int n = rho >> 4, i = rho & 15; return 8 * (i >> 2) + 4 * n + (i & 3); }

struct Unit { int pm, pn; };
struct Gemm { const bf16_t* A; const bf16_t* Bt; int M, N, K; int gshift; size_t gstride; int glds; };

struct StaticOrder {
    int nM, nN, nwg, G, c;
    __host__ __device__ void init(int M, int N, int G_, int c_) { nM = M / BM; nN = N / BM; nwg = nM * nN; G = G_; c = c_; }
    __host__ __device__ bool next(int i, Unit& u) const {
        const long L = (long)i * G + c; if (L >= nwg) return false;
        int wgid = (int)L; { const int q = nwg / NXCD, r = nwg % NXCD, xcd = wgid % NXCD, off = wgid / NXCD; wgid = (xcd < r ? xcd * (q + 1) : r * (q + 1) + (xcd - r) * q) + off; }
        const int nig = WGM * nN, gid = wgid / nig, fm = gid * WGM, gsz = (nM - fm) < WGM ? (nM - fm) : WGM;
        u.pm = fm + ((wgid % nig) % gsz); u.pn = (wgid % nig) / gsz; return true;
    }
    __device__ __forceinline__ void a_ready(const Unit&) const {}
    __device__ __forceinline__ void done(const Unit&) const {}
};


typedef int i32x4 __attribute__((ext_vector_type(4)));
typedef int i32x8 __attribute__((ext_vector_type(8)));
__device__ __forceinline__ i32x8 cat8(bf16x8 a, bf16x8 b) { return __builtin_shufflevector(__builtin_bit_cast(i32x4, a), __builtin_bit_cast(i32x4, b), 0, 1, 2, 3, 4, 5, 6, 7); }
template <class Epi, class Sched, bool ALIGN_EPI = false, bool SP2 = false, bool GATHER = false, bool FP8 = false>
__device__ __forceinline__ void gemm_phase(PG8_LAS unsigned char* lds, const Gemm g, const Sched& S, const Epi& E) {
    const int tid = threadIdx.x, wid = __builtin_amdgcn_readfirstlane(tid >> 6), lane = tid & 63, wr = wid >> 2, wc = wid & 3, fr = lane & 15, fq = lane >> 4;
    const int K = g.K, nt = K / BK;
    unsigned voffA[2], voffB[2];
#pragma unroll
    for (int i = 0; i < 2; ++i) { int R, C; stage_rc(tid * 16 + i * 8192, R, C); const int Rb = Epi::PERM ? ((R & ~31) + perm32(R & 31)) : R;
        voffA[i] = (unsigned)(R * K + C) * 2u; voffB[i] = (unsigned)(Rb * K + C) * 2u; }
    unsigned vc0[2] = {0u, 0u}, vc1[2] = {0u, 0u}, vn0[2] = {0u, 0u}, vn1[2] = {0u, 0u}; int gR[2] = {0, 0}; unsigned gC2[2] = {0u, 0u};
    if constexpr (GATHER) {
#pragma unroll
        for (int i = 0; i < 2; ++i) { int R, C; stage_rc(tid * 16 + i * 8192, R, C); gR[i] = R; gC2[i] = (unsigned)C * 2u; } }
#define PG8_GATHER_OFFS(ui_, o0, o1) do { const PG8_LAS int* ip_ = (const PG8_LAS int*)(lds + g.glds) + (ui_) * 256; \
        _Pragma("unroll") for (int i_ = 0; i_ < 2; ++i_) { o0[i_] = (unsigned)ip_[gR[i_]] * (unsigned)(K * 2) + gC2[i_]; o1[i_] = (unsigned)ip_[128 + gR[i_]] * (unsigned)(K * 2) + gC2[i_]; } } while (0)
#define PG8_STAGE_A0(bufoff, gbase, nx) do { if constexpr (GATHER) { if (nx) PG8_STAGE(bufoff, gbase, vn0); else PG8_STAGE(bufoff, gbase, vc0); } else PG8_STAGE(bufoff, gbase, voffA); } while (0)
#define PG8_STAGE_A1(bufoff, gbase, nx) do { if constexpr (GATHER) { if (nx) PG8_STAGE(bufoff, gbase, vn1); else PG8_STAGE(bufoff, gbase, vc1); } else PG8_STAGE(bufoff, (gbase) + hstep, voffA); } while (0)
    const size_t kstep = (size_t)(BK * 2);
    const size_t hstep = (size_t)HALF * K * 2;
    const size_t tstep = 2 * hstep;
    const unsigned ldsw = (unsigned)wid * 1024u;
    const int aoff = lds_byte(wr * 64 + fr, fq * 8), boff = lds_byte(wc * 32 + fr, fq * 8);
#define PG8_SA(b, h) (((b) * 2 + (h)) * HTB)
#define PG8_SB(b, h) ((4 + (b) * 2 + (h)) * HTB)
#define PG8_STAGE(bufoff, gbase, voff) do { _Pragma("unroll") for (int _i = 0; _i < 2; ++_i) \
        __builtin_amdgcn_global_load_lds((const unsigned*)((const char*)(gbase) + (voff)[_i]), (PG8_LAS unsigned*)(lds + (bufoff) + ldsw + _i * 8192), 16, 0, 0); } while (0)
#define PG8_LDA(dst, b, h) do { _Pragma("unroll") for (int m = 0; m < 4; ++m) { dst[m].lo = *(const PG8_LAS i32x4*)(lds + PG8_SA(b, h) + aoff + m * 2048); dst[m].hi = *(const PG8_LAS i32x4*)(lds + PG8_SA(b, h) + aoff + m * 2048 + 1024); } } while (0)
#define PG8_LDB(dst, b, h) do { _Pragma("unroll") for (int n = 0; n < 2; ++n) { dst[n].lo = *(const PG8_LAS i32x4*)(lds + PG8_SB(b, h) + boff + n * 2048); dst[n].hi = *(const PG8_LAS i32x4*)(lds + PG8_SB(b, h) + boff + n * 2048 + 1024); } } while (0)
#define PG8_MMA(ai, bj, At, Bt) do { __builtin_amdgcn_s_setprio(1); _Pragma("unroll") for (int m = 0; m < 4; ++m) _Pragma("unroll") for (int n = 0; n < 2; ++n) { \
        if constexpr (FP8) asm volatile("v_mfma_scale_f32_16x16x128_f8f6f4 %0, %1, %2, %0, %3, %3 op_sel_hi:[0,0,0]" : "+v"(acc[ai][bj][m][n]) : "v"(Bt[n]), "v"(At[m]), "v"(sc1));   \
        else { acc[ai][bj][m][n] = __builtin_amdgcn_mfma_f32_16x16x32_bf16(__builtin_bit_cast(bf16x8, (i32x4)Bt[n].lo), __builtin_bit_cast(bf16x8, (i32x4)At[m].lo), acc[ai][bj][m][n], 0, 0, 0); \
               acc[ai][bj][m][n] = __builtin_amdgcn_mfma_f32_16x16x32_bf16(__builtin_bit_cast(bf16x8, (i32x4)Bt[n].hi), __builtin_bit_cast(bf16x8, (i32x4)At[m].hi), acc[ai][bj][m][n], 0, 0, 0); } } \
        __builtin_amdgcn_s_setprio(0); } while (0)
#define PG8_WAIT_V(n) asm volatile("s_waitcnt vmcnt(" #n ")" ::: "memory")
#define PG8_WAIT_L(n) asm volatile("s_waitcnt lgkmcnt(" #n ")" ::: "memory")
#define PG8_BAR __builtin_amdgcn_s_barrier()
#define PG8_SCHED __builtin_amdgcn_sched_barrier(0)
    Unit cur, nxt; int ui = 0;
    if (!S.next(0, cur)) return;
    f32x4 acc[2][2][4][2];
#pragma unroll
    for (int a = 0; a < 2; ++a)
#pragma unroll
        for (int b = 0; b < 2; ++b)
#pragma unroll
            for (int m = 0; m < 4; ++m)
#pragma unroll
                for (int n = 0; n < 2; ++n) acc[a][b][m][n] = (f32x4){0.f, 0.f, 0.f, 0.f};
    int sc1 = 0x7f7f7f7f; asm volatile("" : "+v"(sc1));
    i32x8 At[4], B0[2], B1[2];
    const char* cA = (const char*)g.A + (GATHER ? (size_t)0 : (size_t)cur.pm * tstep); if constexpr (GATHER) PG8_GATHER_OFFS(0, vc0, vc1);
    const char* cB = (const char*)g.Bt + (size_t)cur.pn * tstep + (size_t)(cur.pm >> g.gshift) * g.gstride;
    S.a_ready(cur);
    if constexpr (SP2) {
        PG8_STAGE(PG8_SB(0, 0), cB, voffB); PG8_STAGE(PG8_SB(0, 1), cB + hstep, voffB); PG8_STAGE_A0(PG8_SA(0, 0), cA, false); PG8_STAGE_A1(PG8_SA(0, 1), cA, false);
        if (wr == 1) PG8_BAR;
        PG8_WAIT_V(2); PG8_BAR;
        PG8_STAGE(PG8_SB(1, 0), cB + kstep, voffB); PG8_STAGE_A0(PG8_SA(1, 0), cA + kstep, false); PG8_STAGE(PG8_SB(1, 1), cB + hstep + kstep, voffB);
        PG8_WAIT_V(6); PG8_BAR;
    } else {
        PG8_STAGE(PG8_SB(0, 0), cB, voffB); PG8_STAGE(PG8_SA(0, 0), cA, voffA); PG8_STAGE(PG8_SB(0, 1), cB + hstep, voffB); PG8_STAGE(PG8_SA(0, 1), cA + hstep, voffA);
        if (wr == 1) PG8_BAR;
        PG8_WAIT_V(4); PG8_BAR;
        PG8_STAGE(PG8_SB(1, 0), cB + kstep, voffB); PG8_STAGE(PG8_SA(1, 0), cA + kstep, voffA); PG8_STAGE(PG8_SB(1, 1), cB + hstep + kstep, voffB);
        PG8_WAIT_V(6); PG8_BAR;
    }
    for (;;) {
        const bool has_next = S.next(ui + 1, nxt);
        const char* nA = (has_next && !GATHER) ? (const char*)g.A + (size_t)nxt.pm * tstep : cA;
        if constexpr (GATHER) { if (has_next) PG8_GATHER_OFFS(ui + 1, vn0, vn1); else { vn0[0] = vc0[0]; vn0[1] = vc0[1]; vn1[0] = vc1[0]; vn1[1] = vc1[1]; } } const char* nB = has_next ? (const char*)g.Bt + (size_t)nxt.pn * tstep + (size_t)(nxt.pm >> g.gshift) * g.gstride : cB;
        for (int t = 0; t < nt; t += 2) {
            const bool last = (t == nt - 2);
            const char* a1 = cA + (size_t)(t + 1) * kstep;
            const char* a2 = last ? nA : cA + (size_t)(t + 2) * kstep; const char* b2 = last ? nB : cB + (size_t)(t + 2) * kstep;
            const char* a3 = a2 + kstep; const char* b3 = b2 + kstep;
            if (last && has_next) S.a_ready(nxt);
            if constexpr (SP2) {
            PG8_LDB(B0, 0, 0); PG8_LDB(B1, 0, 1); PG8_SCHED; PG8_LDA(At, 0, 0); PG8_STAGE_A1(PG8_SA(1, 1), a1, false);
            PG8_WAIT_V(8); PG8_WAIT_L(0); PG8_BAR; PG8_MMA(0, 0, At, B0); PG8_MMA(0, 1, At, B1); PG8_BAR; PG8_SCHED;
            PG8_LDA(At, 0, 1); PG8_STAGE(PG8_SB(0, 0), b2, voffB); PG8_STAGE(PG8_SB(0, 1), b2 + hstep, voffB); PG8_STAGE_A0(PG8_SA(0, 0), a2, last);
            PG8_WAIT_V(8); PG8_WAIT_L(0); PG8_BAR; PG8_MMA(1, 0, At, B0); PG8_MMA(1, 1, At, B1); PG8_BAR; PG8_SCHED;
            PG8_LDB(B0, 1, 0); PG8_LDB(B1, 1, 1); PG8_SCHED; PG8_LDA(At, 1, 0); PG8_STAGE_A1(PG8_SA(0, 1), a2, last);
            PG8_WAIT_V(8); PG8_WAIT_L(0); PG8_BAR; PG8_MMA(0, 0, At, B0); PG8_MMA(0, 1, At, B1); PG8_BAR; PG8_SCHED;
            PG8_LDA(At, 1, 1); PG8_STAGE(PG8_SB(1, 0), b3, voffB); PG8_STAGE(PG8_SB(1, 1), b3 + hstep, voffB); PG8_STAGE_A0(PG8_SA(1, 0), a3, last);
            PG8_WAIT_V(8); PG8_WAIT_L(0); PG8_BAR; PG8_MMA(1, 0, At, B0); PG8_MMA(1, 1, At, B1); PG8_BAR; PG8_SCHED;
            } else {
            PG8_LDB(B0, 0, 0); PG8_SCHED; PG8_LDA(At, 0, 0); PG8_STAGE(PG8_SA(1, 1), a1 + hstep, voffA);
            PG8_WAIT_L(8); PG8_BAR; PG8_WAIT_L(0); PG8_MMA(0, 0, At, B0); PG8_BAR; PG8_SCHED;
            PG8_LDB(B1, 0, 1); PG8_STAGE(PG8_SB(0, 0), b2, voffB);
            PG8_BAR; PG8_WAIT_L(0); PG8_MMA(0, 1, At, B1); PG8_BAR;
            PG8_LDA(At, 0, 1); PG8_STAGE(PG8_SA(0, 0), a2, voffA);
            PG8_BAR; PG8_WAIT_L(0); PG8_MMA(1, 0, At, B0); PG8_BAR; PG8_SCHED;
            PG8_STAGE(PG8_SB(0, 1), b2 + hstep, voffB);
            PG8_WAIT_V(6); PG8_BAR; PG8_MMA(1, 1, At, B1); PG8_BAR;
            PG8_LDB(B0, 1, 0); PG8_SCHED; PG8_LDA(At, 1, 0); PG8_STAGE(PG8_SA(0, 1), a2 + hstep, voffA);
            PG8_WAIT_L(8); PG8_BAR; PG8_WAIT_L(0); PG8_MMA(0, 0, At, B0); PG8_BAR; PG8_SCHED;
            PG8_LDB(B1, 1, 1); PG8_STAGE(PG8_SB(1, 0), b3, voffB);
            PG8_BAR; PG8_WAIT_L(0); PG8_MMA(0, 1, At, B1); PG8_BAR;
            PG8_LDA(At, 1, 1); PG8_STAGE(PG8_SA(1, 0), a3, voffA);
            PG8_BAR; PG8_WAIT_L(0); PG8_MMA(1, 0, At, B0); PG8_BAR; PG8_SCHED;
            PG8_STAGE(PG8_SB(1, 1), b3 + hstep, voffB);
            PG8_WAIT_V(6); PG8_BAR; PG8_MMA(1, 1, At, B1); PG8_BAR;
            }
        }
        if constexpr (ALIGN_EPI) { if (wr == 0) PG8_BAR; }
        if constexpr (FP8) asm volatile("s_nop 15\n\ts_nop 15" ::: "memory");
        if constexpr (!Epi::AFTER_DRAIN) { E(acc, cur, wr, wc, fr, fq); S.done(cur); }
        if (!has_next) break;
#pragma unroll
        for (int a = 0; a < 2; ++a)
#pragma unroll
            for (int b = 0; b < 2; ++b)
#pragma unroll
                for (int m = 0; m < 4; ++m)
#pragma unroll
                    for (int n = 0; n < 2; ++n) acc[a][b][m][n] = (f32x4){0.f, 0.f, 0.f, 0.f};
        cur = nxt; cA = nA; cB = nB; ++ui;
        if constexpr (GATHER) { vc0[0] = vn0[0]; vc0[1] = vn0[1]; vc1[0] = vn1[0]; vc1[1] = vn1[1]; }
        if constexpr (ALIGN_EPI) { if (wr == 1) PG8_BAR; }
    }
    PG8_WAIT_V(0);
    if constexpr (!ALIGN_EPI) { if (wr == 0) PG8_BAR; }
    PG8_BAR;
    if constexpr (Epi::AFTER_DRAIN) { E.fused(acc, cur, wr, wc, fr, fq, lds, wid, lane); S.done(cur); }
#undef PG8_SA
#undef PG8_SB
#undef PG8_STAGE
#undef PG8_STAGE_A0
#undef PG8_STAGE_A1
#undef PG8_GATHER_OFFS
#undef PG8_LDA
#undef PG8_LDB
#undef PG8_MMA
#undef PG8_WAIT_V
#undef PG8_WAIT_L
#undef PG8_BAR
#undef PG8_SCHED
}
}

#define LAS __attribute__((address_space(3)))
typedef unsigned short bf16;
typedef unsigned u32x4 __attribute__((ext_vector_type(4)));
typedef unsigned u32x2 __attribute__((ext_vector_type(2)));
typedef float f32x4 __attribute__((ext_vector_type(4)));
typedef float f32x2 __attribute__((ext_vector_type(2)));

constexpr int NWAVES = 8, NTHR = 512;
constexpr int DM = 1024, NB = 2, SEQ = 8192, CTXL = 256;
constexpr int MROWS = NB * SEQ;
constexpr int MCTX = NB * CTXL;
constexpr int MTOT = MROWS + MCTX;
constexpr int NINC = 4096;
constexpr int NE = 16, CAP = 1024, FE = 2752, FEP = 2816, N1P = 5632;
constexpr int MEXP = NE * NB * CAP;
constexpr float RMS_EPS = 1e-6f;
constexpr int NPHASE = 12;
#ifndef PHMASK
#define PHMASK 0xFFF
#endif
#define PH_ON(k) ((PHMASK >> (k)) & 1)
#ifndef REPMASK
#define REPMASK 0x0
#endif
#define REP_ON(k) ((REPMASK >> (k)) & 1)
#ifndef MK_N_LAUNCHES
#define MK_N_LAUNCHES 1
#endif

constexpr size_t MiB = 1u << 20, KiB = 1u << 10;
constexpr size_t WS_CTL = 0, CTL_ZERO_BYTES = 1 * MiB;
constexpr size_t WS_MODP = 1 * MiB;
constexpr size_t WS_MODF = 1 * MiB + 640 * KiB;
constexpr size_t WS_LB = 1 * MiB + 768 * KiB;
constexpr size_t WS_COS = 1 * MiB + 800 * KiB;
constexpr size_t WS_SIN = 1 * MiB + 808 * KiB;
constexpr size_t WS_WRT = 1 * MiB + 832 * KiB;
constexpr size_t WS_AFF = 2 * MiB;
constexpr size_t WS_IDX = 3 * MiB;
constexpr size_t WS_GATEV = 3 * MiB + 256 * KiB;
constexpr size_t WS_SLOT = 4 * MiB;
constexpr size_t WS_H2 = 8 * MiB;
constexpr size_t WS_WINT = 72 * MiB;
constexpr size_t WS_WOUTT = 80 * MiB;
constexpr size_t WS_W1T = 82 * MiB;
constexpr size_t WS_W2T = 258 * MiB;
constexpr size_t WS_H = 346 * MiB;
constexpr size_t WS_QP = 379 * MiB;
constexpr size_t WS_QR = 395 * MiB;
constexpr size_t WS_KR = 411 * MiB;
constexpr size_t WS_V = 428 * MiB;
constexpr size_t WS_QH = 445 * MiB;
constexpr size_t WS_LFF = 462 * MiB;
constexpr size_t WS_LFB = 495 * MiB;
constexpr size_t WS_IH = 528 * MiB;
constexpr size_t WS_GH = 545 * MiB;
constexpr size_t WS_MIXIN = 561 * MiB;
constexpr size_t WS_HID = 346 * MiB;
constexpr size_t WS_MIX = 593 * MiB;
constexpr size_t WS_YS = 593 * MiB;
constexpr size_t WS_END = 657 * MiB;
static_assert(WS_HID + (size_t)MEXP * FEP * 2 <= WS_MIXIN + 32 * MiB, "hid overlay");
static_assert(WS_W1T + (size_t)NE * N1P * DM * 2 <= WS_W2T && WS_W2T + (size_t)NE * DM * FEP * 2 <= WS_H, "weights");

constexpr int CW_BAR = 4096;
constexpr int LDSCTL_BYTES = 512, LDS_BYTES = 155648;

#define LDS_WAIT() asm volatile("s_waitcnt lgkmcnt(0)" ::: "memory")
#define VM_WAIT() asm volatile("s_waitcnt vmcnt(0)" ::: "memory")
__device__ __forceinline__ unsigned f2bf(float f) { unsigned u = __builtin_bit_cast(unsigned, f); return (u + 0x7fffu + ((u >> 16) & 1u)) >> 16; }
__device__ __forceinline__ unsigned pk2(float lo, float hi) { return f2bf(lo) | (f2bf(hi) << 16); }
__device__ __forceinline__ float bf2f(unsigned h) { return __builtin_bit_cast(float, h << 16); }
__device__ __forceinline__ float bflo(unsigned w) { return __builtin_bit_cast(float, w << 16); }
__device__ __forceinline__ float bfhi(unsigned w) { return __builtin_bit_cast(float, w & 0xffff0000u); }
__device__ __forceinline__ float wave_sum(float v) {
#pragma unroll
    for (int o = 1; o < 64; o <<= 1) v += __shfl_xor(v, o);
    return v;
}
__device__ __forceinline__ float wave_max(float v) {
#pragma unroll
    for (int o = 1; o < 64; o <<= 1) v = fmaxf(v, __shfl_xor(v, o));
    return v;
}
__device__ __forceinline__ unsigned pk4_fp8(float a, float b, float c, float d) { int w = 0; w = __builtin_amdgcn_cvt_pk_fp8_f32(a, b, w, false); w = __builtin_amdgcn_cvt_pk_fp8_f32(c, d, w, true); return (unsigned)w; }
constexpr float W2_SCALE = 32.f, HID_SCALE = 8.f;
constexpr float W1_SCALE = 32.f, H2_SCALE = 4.f;
__device__ __forceinline__ float sigmoidf_(float x) { return __builtin_amdgcn_rcpf(1.0f + __expf(-x)); }

#define XB_TMO      128
#define XB_XCNT(j)  (256  + 64 * (j))
#define XB_XSUB(j)  (1280 + 64 * (j))
#define XB_XGEN(j)  (2304 + 64 * (j))
#define XB_TOP      3328
#define XB_TOPGEN   3392
#define XCD_BAR_WORDS 3456
#define XB_SPIN_CAP (1u << 20)
__device__ __forceinline__ unsigned xb_ld(unsigned* p)              { return __hip_atomic_load(p, __ATOMIC_RELAXED, __HIP_MEMORY_SCOPE_AGENT); }
__device__ __forceinline__ unsigned xb_add(unsigned* p, unsigned v) { return __hip_atomic_fetch_add(p, v, __ATOMIC_RELAXED, __HIP_MEMORY_SCOPE_AGENT); }
__device__ __forceinline__ unsigned xb_xcc_id() { return (unsigned)__builtin_amdgcn_s_getreg((3 << 11) | 20) & 0xFu; }
#define XB_SPIN(cond, bar) do { unsigned _sp = 0; while (cond) { __builtin_amdgcn_s_sleep(1); \
    if ((++_sp & 255u) == 0u) { if (xb_ld(&(bar)[XB_TMO])) break; if (_sp > XB_SPIN_CAP) { atomicAdd(&(bar)[XB_TMO], 1u); break; } } } } while (0)
struct XcdBarrier { unsigned* bar; unsigned x; volatile LAS unsigned* st; };
__device__ __forceinline__ XcdBarrier xcd_barrier_post(unsigned* bar, volatile LAS unsigned* st) {
    XcdBarrier b; b.bar = bar; b.x = xb_xcc_id(); b.st = st;
    if (threadIdx.x == 0) (void)xb_add(&bar[XB_XCNT(b.x)], 1u);
    return b;
}
__device__ __forceinline__ void xcd_barrier_complete(unsigned* bar, unsigned x, unsigned& nloc, unsigned& nx) {
    const unsigned G = gridDim.x * gridDim.y * gridDim.z;
    unsigned sum, cnt, mine, sp = 0u;
    for (;;) {
        sum = 0u; cnt = 0u; mine = 0u;
#pragma unroll
        for (unsigned j = 0; j < 16; ++j) { const unsigned c = xb_ld(&bar[XB_XCNT(j)]); sum += c; cnt += (c > 0u) ? 1u : 0u; mine = (j == x) ? c : mine; }
        if (sum == G) break;
        __builtin_amdgcn_s_sleep(1);
        if ((++sp & 255u) == 0u) { if (xb_ld(&bar[XB_TMO])) break; if (sp > XB_SPIN_CAP) { atomicAdd(&bar[XB_TMO], 1u); break; } }
    }
    nloc = mine > 0u ? mine : 1u; nx = cnt > 0u ? cnt : 1u;
}
__device__ __forceinline__ void xcd_barrier(const XcdBarrier& b) {
    asm volatile("s_waitcnt vmcnt(0)" ::: "memory");
    __syncthreads();
    if (threadIdx.x == 0) {
        unsigned* bar = b.bar;
        __builtin_amdgcn_s_waitcnt(0);
        unsigned nloc = b.st[0], nx = b.st[1];
        if (nloc == 0u) { xcd_barrier_complete(bar, b.x, nloc, nx); b.st[0] = nloc; b.st[1] = nx; }
        const unsigned old = xb_add(&bar[XB_XSUB(b.x)], 1u);
        const unsigned gen = old / nloc;
        if (old + 1u == (gen + 1u) * nloc) {
            __builtin_amdgcn_fence(__ATOMIC_RELEASE, "agent");
            asm volatile("s_waitcnt vmcnt(0)" ::: "memory");
            const unsigned og = xb_add(&bar[XB_TOP], 1u);
            const unsigned tg = og / nx;
            if (og + 1u == (tg + 1u) * nx) xb_add(&bar[XB_TOPGEN], 1u);
            else XB_SPIN(xb_ld(&bar[XB_TOPGEN]) == tg, bar);
            __builtin_amdgcn_fence(__ATOMIC_ACQUIRE, "agent");
            xb_add(&bar[XB_XGEN(b.x)], 1u);
            asm volatile("s_waitcnt vmcnt(0)" ::: "memory");
        } else {
            XB_SPIN(xb_ld(&bar[XB_XGEN(b.x)]) == gen, bar);
            __builtin_amdgcn_fence(__ATOMIC_ACQUIRE, "agent");
            asm volatile("s_waitcnt vmcnt(0)" ::: "memory");
        }
    }
    __syncthreads();
}

struct Args { const float* in[19]; float* out; unsigned char* ws; int ph_lo, ph_hi; };
enum { I_X = 0, I_C, I_CTX, I_CCTX, I_WMOD, I_BMOD, I_GPRE1, I_GPOST1, I_GPRE2, I_GPOST2, I_WIN, I_WOUT, I_RPB, I_LBL, I_HGN, I_WROUTER, I_WGATE, I_WUP, I_WDOWN };

struct Ctx {
    LAS unsigned char* lds; int tid, lane, wave, G;
    Args a; unsigned char* ws;
};
template <class T> __device__ __forceinline__ T* wsp(const Ctx& C, size_t off) { return (T*)(C.ws + off); }

constexpr int CV_T_IN = 8 * 32, CV_T_OUT = 8 * 8, CV_T_G = 8 * 22, CV_T_D = 22 * 8, CV_T_E = 2 * CV_T_G + CV_T_D, CV_NT = CV_T_IN + CV_T_OUT + NE * CV_T_E;
constexpr int CV_D2 = 1568;
constexpr int CV_P0_END = CV_T_IN + CV_T_OUT, CV_D1_END = CV_NT - CV_D2;
__device__ __forceinline__ void convert_tiles(const Ctx& C, int first, int last, int start, int stride) {
    const Args& a = C.a;
    int tid_ = C.tid; asm volatile("" : "+v"(tid_));
    constexpr int T_IN = CV_T_IN, T_OUT = CV_T_OUT, T_G = CV_T_G, T_E = CV_T_E;
    {
        LAS float* scr = (LAS float*)C.lds;
#define SCR(k_, n_) (*(const LAS float*)((const LAS unsigned char*)scr + (k_) * 512 + (((((n_) >> 2) ^ (k_) ^ ((k_) >> 4)) & 31) << 4) + ((n_) & 3) * 4))
        struct Item { const float* src; bf16* dst; int N, ldk, k0, n0, kval, nval, which; float f8scale; };
        auto decode = [&](int it, Item& I) {
            int r = it;
            if (r < T_IN) { I = Item{a.in[I_WIN], wsp<bf16>(C, WS_WINT), NINC, DM, 128 * (r >> 5), 128 * (r & 31), DM, NINC, -1, 0.f}; return; }
            r -= T_IN;
            if (r < T_OUT) { I = Item{a.in[I_WOUT], wsp<bf16>(C, WS_WOUTT), DM, DM, 128 * (r >> 3), 128 * (r & 7), DM, DM, -1, 0.f}; return; }
            r -= T_OUT;
            const int e = r / T_E; r %= T_E;
            if (r < 2 * T_G) { const int which = r / T_G; r %= T_G;
                I = Item{(which ? a.in[I_WUP] : a.in[I_WGATE]) + (size_t)e * DM * FE, (bf16*)(C.ws + WS_W1T + (size_t)e * N1P * DM), FE, DM, 128 * (r / 22), 128 * (r % 22), DM, FE, which, W1_SCALE}; return; }
            r -= 2 * T_G;
            I = Item{a.in[I_WDOWN] + (size_t)e * FE * DM, (bf16*)(C.ws + WS_W2T + (size_t)e * DM * FEP), DM, FEP, 128 * (r >> 3), 128 * (r & 7), FE, DM, -1, W2_SCALE};
        };
        auto loadt = [&](const Item& I, f32x4 (&v)[8]) {
#pragma unroll
            for (int i = 0; i < 8; ++i) { const int idx = tid_ + 512 * i, row = idx >> 5, c4 = idx & 31; const int k = I.k0 + row, n = I.n0 + 4 * c4;
                v[i] = (k < I.kval && n < I.nval) ? __builtin_nontemporal_load((const f32x4*)(I.src + (size_t)k * I.N + n)) : (f32x4){0.f, 0.f, 0.f, 0.f}; }
        };
        Item I0, I1; f32x4 v0[8], v1[8];
        int it = first + start;
        if (it < last) { decode(it, I0); loadt(I0, v0); }
        if (it + stride < last) { decode(it + stride, I1); loadt(I1, v1); }
        auto step = [&](Item& I, f32x4 (&v)[8], int itn) {
            __syncthreads();
#pragma unroll
            for (int i = 0; i < 8; ++i) { const int idx = tid_ + 512 * i, row = idx >> 5, c4 = idx & 31; *(LAS f32x4*)((LAS unsigned char*)scr + row * 512 + (((c4 ^ row ^ (row >> 4)) & 31) << 4)) = v[i]; }
            const Item cur = I;
            if (itn < last) { decode(itn, I); loadt(I, v); }
            __syncthreads();
            if (cur.f8scale != 0.f) {
#pragma unroll
                for (int i = 0; i < 2; ++i) { const int idx = tid_ + 512 * i, nl = idx >> 3, c = idx & 7; const float sc = cur.f8scale; float t[16];
#pragma unroll
                    for (int kk = 0; kk < 16; ++kk) { t[kk] = SCR(16 * c + kk, nl) * sc; if ((kk & 7) == 7) asm volatile("" ::: "memory"); }
                    u32x4 o;
                    o.x = pk4_fp8(t[0], t[1], t[2], t[3]); o.y = pk4_fp8(t[4], t[5], t[6], t[7]); o.z = pk4_fp8(t[8], t[9], t[10], t[11]); o.w = pk4_fp8(t[12], t[13], t[14], t[15]);
                    const int f = cur.n0 + nl; const int rowd = cur.which < 0 ? f : 32 * (f >> 4) + 16 * cur.which + (f & 15);
                    __builtin_nontemporal_store(o, (u32x4*)((unsigned char*)cur.dst + (size_t)rowd * cur.ldk + cur.k0 + 16 * c)); }
            } else {
#pragma unroll
                for (int i = 0; i < 4; ++i) { const int idx = tid_ + 512 * i, nl = idx >> 4, c = idx & 15;
                    u32x4 o; o.x = pk2(SCR(8 * c, nl), SCR(8 * c + 1, nl)); o.y = pk2(SCR(8 * c + 2, nl), SCR(8 * c + 3, nl)); o.z = pk2(SCR(8 * c + 4, nl), SCR(8 * c + 5, nl)); o.w = pk2(SCR(8 * c + 6, nl), SCR(8 * c + 7, nl));
                    const int f = cur.n0 + nl; const int rowd = cur.which < 0 ? f : 32 * (f >> 4) + 16 * cur.which + (f & 15);
                    *(u32x4*)(cur.dst + (size_t)rowd * cur.ldk + cur.k0 + 8 * c) = o; }
            }
        };
        for (; it < last; it += 2 * stride) { step(I0, v0, it + 2 * stride); if (it + stride < last) step(I1, v1, it + 3 * stride); }
#undef SCR
    }
}

__device__ __forceinline__ void phase_prologue(const Ctx& C) {
    const Args& a = C.a;
    if (blockIdx.x < 192) {
        const int cc = blockIdx.x % 24, ks = blockIdx.x / 24;
        LAS float* sv = (LAS float*)C.lds;
        LAS float* red = sv + 384;
        if (C.tid < 384) { const int i = C.tid >> 7, k = C.tid & 127; const float cv = (i < 2) ? a.in[I_C][i * DM + ks * 128 + k] : a.in[I_CCTX][ks * 128 + k]; sv[C.tid] = cv / (1.0f + expf(-cv)); }
        __syncthreads();
        const int cl = C.tid & 255, col = cc * 256 + cl, kh = C.tid >> 8;
        float a0 = 0.f, a1 = 0.f, a2 = 0.f;
        const float* wp = a.in[I_WMOD] + (size_t)(ks * 128 + kh * 64) * 6144 + col;
#pragma unroll 8
        for (int kk = 0; kk < 64; ++kk) { const float w = wp[(size_t)kk * 6144]; const int k = kh * 64 + kk; a0 += sv[k] * w; a1 += sv[128 + k] * w; a2 += sv[256 + k] * w; }
        if (kh == 1) { red[cl] = a0; red[256 + cl] = a1; red[512 + cl] = a2; }
        __syncthreads();
        if (kh == 0) { float* mp = wsp<float>(C, WS_MODP) + (size_t)ks * 18432 + col; mp[0] = a0 + red[cl]; mp[6144] = a1 + red[256 + cl]; mp[12288] = a2 + red[512 + cl]; }
        __syncthreads();
    }
    if (blockIdx.x == 255 % C.G) {
        const float* lg = a.in[I_LBL]; float* lb = wsp<float>(C, WS_LB);
        if (C.tid < 512) { const float l0 = lg[C.tid], l1 = lg[512 + C.tid]; lb[C.tid] = 1.0f / (1.0f + expf(l1 - l0)); }
    }
    if (blockIdx.x == 253 % C.G) {
        float* wrt = wsp<float>(C, WS_WRT);
        for (int idx = C.tid; idx < 16384; idx += NTHR) wrt[(idx & 15) * 1024 + (idx >> 4)] = a.in[I_WROUTER][idx];
    }
    if (blockIdx.x == 254 % C.G) {
        float* ct = wsp<float>(C, WS_COS); float* st = wsp<float>(C, WS_SIN);
        for (int idx = C.tid; idx < 2048; idx += NTHR) { const int pos = idx >> 4, i = idx & 15; const float inv = powf(10000.0f, -(float)i / 16.0f); const float ang = (float)pos * inv; ct[idx] = cosf(ang); st[idx] = sinf(ang); }
    }
    convert_tiles(C, 0, C.G > 32 ? CV_P0_END : CV_NT, (int)blockIdx.x, C.G);
}

__device__ __forceinline__ void phase_hrows(const Ctx& C) {
    const Args& a = C.a;
    const float* modp = wsp<float>(C, WS_MODP); const float* bmod = a.in[I_BMOD];
    { float* modf = wsp<float>(C, WS_MODF);
      for (int idx = blockIdx.x * NTHR + C.tid; idx < 18432; idx += C.G * NTHR) { float s = bmod[idx % 6144];
#pragma unroll
          for (int ks = 0; ks < 8; ++ks) s += modp[ks * 18432 + idx];
          modf[idx] = s; } }
    LAS float* sm = (LAS float*)C.lds;
    for (int j4 = C.tid; j4 < 1536; j4 += NTHR) { const int i = j4 >> 9, ci = (j4 & 511) * 4; f32x4 s = *(const f32x4*)(bmod + ci);
#pragma unroll
        for (int ks = 0; ks < 8; ++ks) s = s + *(const f32x4*)(modp + ks * 18432 + i * 6144 + ci);
        if (ci >= 1024) s = *(const f32x4*)(a.in[I_GPRE1] + ci - 1024) * (1.0f + s);
        *(LAS f32x4*)(sm + i * 2048 + ci) = s; }
    __syncthreads();
    const int gw = blockIdx.x * NWAVES + C.wave, NGW = C.G * NWAVES;
    bf16* H = wsp<bf16>(C, WS_H);
    auto load3 = [&](int row0, f32x4 (&v)[3][4]) {
#pragma unroll
        for (int r = 0; r < 3; ++r) { const int row = row0 + r; const float* src = row < MROWS ? a.in[I_X] + (size_t)row * DM : a.in[I_CTX] + (size_t)(row - MROWS) * DM;
#pragma unroll
            for (int j = 0; j < 4; ++j) v[r][j] = *(const f32x4*)(src + 4 * (C.lane + 64 * j)); }
    };
    auto calc3 = [&](int row0, const f32x4 (&v)[3][4], u32x2 (&o)[3][4]) {
        float ss[3];
#pragma unroll
        for (int r = 0; r < 3; ++r) { float s_ = 0.f;
#pragma unroll
            for (int j = 0; j < 4; ++j) s_ += (v[r][j].x * v[r][j].x + v[r][j].y * v[r][j].y) + (v[r][j].z * v[r][j].z + v[r][j].w * v[r][j].w);
            ss[r] = s_; }
#pragma unroll
        for (int o_ = 1; o_ < 64; o_ <<= 1) {
#pragma unroll
            for (int r = 0; r < 3; ++r) ss[r] += __shfl_xor(ss[r], o_); }
#pragma unroll
        for (int r = 0; r < 3; ++r) { const int row = row0 + r; const int vi = row < MROWS ? (row >> 13) : 2; const float rstd = 1.0f / sqrtf(ss[r] * (1.0f / DM) + RMS_EPS);
#pragma unroll
            for (int j = 0; j < 4; ++j) { const int ch = 4 * (C.lane + 64 * j);
                const f32x4 sh = *(const LAS f32x4*)(sm + vi * 2048 + ch), gs = *(const LAS f32x4*)(sm + vi * 2048 + 1024 + ch);
                const f32x4 h = v[r][j] * rstd * gs + sh;
                o[r][j].x = pk2(h.x, h.y); o[r][j].y = pk2(h.z, h.w); } }
    };
    auto store3 = [&](int row0, const u32x2 (&o)[3][4]) {
#pragma unroll
        for (int r = 0; r < 3; ++r)
#pragma unroll
            for (int j = 0; j < 4; ++j) *(u32x2*)(H + (size_t)(row0 + r) * DM + 4 * (C.lane + 64 * j)) = o[r][j];
    };
    int row0 = 3 * gw;
    if (row0 < MTOT) {
        f32x4 v[3][4], vn[3][4]; u32x2 o[3][4];
        load3(row0, v);
        { const int rn = row0 + 3 * NGW < MTOT ? row0 + 3 * NGW : row0; load3(rn, vn); }
        calc3(row0, v, o);
        int prow = row0;
        for (row0 += 3 * NGW; row0 < MTOT; row0 += 3 * NGW) {
#pragma unroll
            for (int r = 0; r < 3; ++r)
#pragma unroll
                for (int j = 0; j < 4; ++j) v[r][j] = vn[r][j];
            store3(prow, o);
            { const int rn = row0 + 3 * NGW < MTOT ? row0 + 3 * NGW : row0; load3(rn, vn); }
            calc3(row0, v, o);
            prow = row0;
        }
        store3(prow, o);
    }
}

__device__ __forceinline__ void st_bf4(bf16* p, f32x4 v) { u32x2 o; o.x = pk2(v.x, v.y); o.y = pk2(v.z, v.w); *(u32x2*)p = o; }

struct EpiIn {
    static constexpr bool PERM = false, AFTER_DRAIN = false;
    bf16 *QP, *QR, *KR, *V, *QH, *IH, *GH; float *LFF, *LFB; const LAS float *lb, *cosT, *sinT;
    __device__ __forceinline__ void operator()(const f32x4 (&acc)[2][2][4][2], const pg8::Unit& u, int wr, int wc, int fr, int fq) const {
        const int stream = u.pn >> 1; const bool isctx = u.pm >= 64;
        if (isctx && (stream == 0 || stream == 7)) return;
#pragma unroll
        for (int ai = 0; ai < 2; ++ai)
#pragma unroll
            for (int m = 0; m < 4; ++m) {
                const int row = u.pm * 256 + ai * 128 + wr * 64 + m * 16 + fr;
#pragma unroll
                for (int bj = 0; bj < 2; ++bj) {
                    const int cs = (u.pn & 1) * 256 + bj * 128 + wc * 32 + 4 * fq;
                    const f32x4 x1 = acc[ai][bj][m][0], x2 = acc[ai][bj][m][1];
                    const size_t o = (size_t)row * 512 + cs;
                    if (stream <= 1) {
                        const int t = row & 8191, pos = (wc & 1) ? (t & 63) : (t >> 6);
                        const f32x4 c4 = *(const LAS f32x4*)(cosT + pos * 16 + 4 * fq), s4 = *(const LAS f32x4*)(sinT + pos * 16 + 4 * fq);
                        const f32x4 r1 = x1 * c4 - x2 * s4, r2 = x1 * s4 + x2 * c4;
                        if (stream == 0) { st_bf4(QP + o, x1 * 0.125f); st_bf4(QP + o + 16, x2 * 0.125f); st_bf4(QR + o, r1 * 0.125f); st_bf4(QR + o + 16, r2 * 0.125f); }
                        else if (isctx) { st_bf4(KR + o, x1); st_bf4(KR + o + 16, x2); }
                        else { st_bf4(KR + o, r1); st_bf4(KR + o + 16, r2); }
                    } else if (stream == 2) { st_bf4(V + o, x1); st_bf4(V + o + 16, x2); }
                    else if (stream == 3) { st_bf4(QH + o, x1); st_bf4(QH + o + 16, x2); }
                    else if (stream == 4 || stream == 5) {
                        float* LF = stream == 4 ? LFF : LFB;
                        const f32x4 l1 = *(const LAS f32x4*)(lb + cs), l2 = *(const LAS f32x4*)(lb + cs + 16);
                        f32x4 y1, y2;
#pragma unroll
                        for (int j = 0; j < 4; ++j) { y1[j] = __logf(l1[j] + (1.0f - l1[j]) * sigmoidf_(x1[j])); y2[j] = __logf(l2[j] + (1.0f - l2[j]) * sigmoidf_(x2[j])); }
                        *(f32x4*)(LF + o) = y1; *(f32x4*)(LF + o + 16) = y2;
                    } else if (stream == 6) { st_bf4(IH + o, x1); st_bf4(IH + o + 16, x2); }
                    else { st_bf4(GH + o, x1); st_bf4(GH + o + 16, x2); }
                }
            }
    }
};
struct EpiF32 {
    static constexpr bool PERM = false, AFTER_DRAIN = false;
    float* O; int ldc;
    __device__ __forceinline__ void operator()(const f32x4 (&acc)[2][2][4][2], const pg8::Unit& u, int wr, int wc, int fr, int fq) const {
#pragma unroll
        for (int ai = 0; ai < 2; ++ai)
#pragma unroll
            for (int m = 0; m < 4; ++m) { float* rp = O + (size_t)(u.pm * 256 + ai * 128 + wr * 64 + m * 16 + fr) * ldc + u.pn * 256 + wc * 32 + 4 * fq;
#pragma unroll
                for (int bj = 0; bj < 2; ++bj)
#pragma unroll
                    for (int n = 0; n < 2; ++n) *(f32x4*)(rp + bj * 128 + n * 16) = acc[ai][bj][m][n]; }
    }
};
struct EpiHid {
    static constexpr bool PERM = false, AFTER_DRAIN = false;
    unsigned char* HID;
    __device__ __forceinline__ void operator()(const f32x4 (&acc)[2][2][4][2], const pg8::Unit& u, int wr, int wc, int fr, int fq) const {
#pragma unroll
        for (int ai = 0; ai < 2; ++ai)
#pragma unroll
            for (int m = 0; m < 4; ++m) { unsigned char* rp = HID + (size_t)(u.pm * 256 + ai * 128 + wr * 64 + m * 16 + fr) * FEP + u.pn * 128 + wc * 16 + 4 * fq;
#pragma unroll
                for (int bj = 0; bj < 2; ++bj) { const f32x4 g = acc[ai][bj][m][0] * (1.0f / (W1_SCALE * H2_SCALE)), up = acc[ai][bj][m][1] * (HID_SCALE / (W1_SCALE * H2_SCALE)); f32x4 hv;
#pragma unroll
                    for (int j = 0; j < 4; ++j) hv[j] = __builtin_amdgcn_fmed3f(g[j] * sigmoidf_(g[j]) * up[j], -448.f, 448.f);
                    *(unsigned*)(rp + bj * 64) = pk4_fp8(hv[0], hv[1], hv[2], hv[3]); } }
    }
};
struct EpiYs {
    static constexpr bool PERM = false, AFTER_DRAIN = false;
    bf16* YS; const float* gate;
    __device__ __forceinline__ void operator()(const f32x4 (&acc)[2][2][4][2], const pg8::Unit& u, int wr, int wc, int fr, int fq) const {
#pragma unroll
        for (int ai = 0; ai < 2; ++ai)
#pragma unroll
            for (int m = 0; m < 4; ++m) { const int row = u.pm * 256 + ai * 128 + wr * 64 + m * 16 + fr; const float gv = gate[row] * (1.0f / (W2_SCALE * HID_SCALE));
                bf16* rp = YS + (size_t)row * DM + u.pn * 256 + wc * 32 + 4 * fq;
#pragma unroll
                for (int bj = 0; bj < 2; ++bj)
#pragma unroll
                    for (int n = 0; n < 2; ++n) st_bf4(rp + bj * 128 + n * 16, acc[ai][bj][m][n] * gv); }
    }
};

typedef short bf16x8 __attribute__((ext_vector_type(8)));
typedef short s16x4 __attribute__((ext_vector_type(4)));
constexpr int NA_KW = 0, NA_VW = NA_KW + 5 * 64 * 128, NA_KC = NA_VW + 5 * 64 * 128, NA_VC = NA_KC + 256 * 128, NA_SB = NA_VC + 256 * 128, NA_END = NA_SB + 15 * 64 * 4;
static_assert(NA_END + LDSCTL_BYTES <= LDS_BYTES, "NA LDS map");
__device__ __forceinline__ int voff(int key, int c  ) { return (key >> 3) * 1024 + (c >> 1) * 256 + (key & 7) * 32 + (c & 1) * 16; }
__device__ __forceinline__ int kswz(int row, int chunk) { return row * 128 + ((chunk ^ (row & 7)) << 4); }
__device__ __forceinline__ s16x4 lds_tr16(const LAS unsigned char* p) { return __builtin_bit_cast(s16x4, __builtin_amdgcn_ds_read_tr16_b64_v4i16((LAS s16x4*)p)); }
__device__ __forceinline__ int clampi(int v, int lo, int hi) { return min(max(v, lo), hi); }
__device__ __forceinline__ bf16x8 pack8(f32x4 a, f32x4 b) { u32x4 w; w.x = pk2(a.x, a.y); w.y = pk2(a.z, a.w); w.z = pk2(b.x, b.y); w.w = pk2(b.z, b.w); return __builtin_bit_cast(bf16x8, w); }

__device__ __forceinline__ void phase_na(const Ctx& C) {
    const Args& a_ = C.a;
    const bf16 *QP = wsp<bf16>(C, WS_QP), *QR = wsp<bf16>(C, WS_QR), *KR = wsp<bf16>(C, WS_KR), *V = wsp<bf16>(C, WS_V);
    bf16* MIXIN = wsp<bf16>(C, WS_MIXIN); const float* rpb = a_.in[I_RPB];
    LAS unsigned char* L = C.lds; LAS float* sB = (LAS float*)(L + NA_SB);
    const int UPB = (1024 + C.G - 1) / C.G, u_lo = blockIdx.x * UPB, u_hi = min(1024, u_lo + UPB);
    const int q = C.lane & 15, g = C.lane >> 4;
    int cur_bh = -1;
    for (int u = u_lo; u < u_hi; ++u) {
        const int bh = u >> 6, b = bh >> 3, h = bh & 7, r = 2 * (u & 63);
        const int rlo = clampi(r - 4, 0, 120);
        const int rr = r + (C.wave >> 2), j = C.wave & 3;
        const int r0q = clampi(rr - 4, 0, 120), c0 = clampi(16 * j - 8, 0, 32), cq = 16 * j + q, wc0 = clampi(cq - 8, 0, 48);
        const size_t mq = (size_t)b * SEQ + rr * 64 + cq;
        const bf16x8 qr0 = *(const bf16x8*)(QR + mq * 512 + h * 64 + 8 * g), qr1 = *(const bf16x8*)(QR + mq * 512 + h * 64 + 32 + 8 * g);
        const bf16x8 qp0 = *(const bf16x8*)(QP + mq * 512 + h * 64 + 8 * g), qp1 = *(const bf16x8*)(QP + mq * 512 + h * 64 + 32 + 8 * g);
        float mrun = -INFINITY, lrun = 0.f;
        f32x4 o[4];
#pragma unroll
        for (int dt = 0; dt < 4; ++dt) o[dt] = (f32x4){0.f, 0.f, 0.f, 0.f};
        const int slot0 = r0q - rlo;
        const int kw = slot0 * 64 + c0 + 4 * g + (q >> 2);
        const LAS unsigned char* vwb = L + NA_VW + (kw >> 3) * 1024 + (kw & 7) * 32 + (q & 3) * 8;
        const LAS unsigned char* kwb0 = L + NA_KW + kswz(slot0 * 64 + c0 + q, g), *kwb1 = L + NA_KW + kswz(slot0 * 64 + c0 + q, 4 + g);
        const int kx = 4 * g + (q >> 2);
        const LAS unsigned char* vcb = L + NA_VC + (kx >> 3) * 1024 + (kx & 7) * 32 + (q & 3) * 8;
        const LAS unsigned char* kc0 = L + NA_KC + kswz(q, g), *kc1 = L + NA_KC + kswz(q, 4 + g);
        const LAS float* bl = sB + (r0q - rr + 7) * 64 + (c0 + 4 * g - cq + 15 + 16);
        const int kcl = c0 + 4 * g - wc0;
        __syncthreads();
        if (bh != cur_bh) {
            cur_bh = bh;
            { u32x4 tk[4], tv[4];
#pragma unroll
              for (int i = 0; i < 4; ++i) { const int idx = C.tid + NTHR * i, l = idx >> 3, c = idx & 7; const size_t row = (size_t)MROWS + b * CTXL + l;
                  tk[i] = *(const u32x4*)(KR + row * 512 + h * 64 + 8 * c); tv[i] = *(const u32x4*)(V + row * 512 + h * 64 + 8 * c); }
#pragma unroll
              for (int i = 0; i < 4; ++i) { const int idx = C.tid + NTHR * i, l = idx >> 3, c = idx & 7;
                  *(LAS u32x4*)(L + NA_KC + kswz(l, c)) = tk[i]; *(LAS u32x4*)(L + NA_VC + voff(l, c)) = tv[i]; } }
            for (int idx = C.tid; idx < 15 * 64; idx += NTHR) { const int dr = idx >> 6, dc = (idx & 63) - 16; sB[idx] = (dc >= 0 && dc < 31) ? rpb[(h * 15 + dr) * 31 + dc] : 0.f; }
        }
#pragma unroll 1
        for (int grp = 0; grp < 2; ++grp) {
            if (grp == 1) __syncthreads();
            { const int row0 = rlo + 4 * grp;
              u32x4 tk[5], tv[5];
#pragma unroll
              for (int i = 0; i < 5; ++i) { const int idx = C.tid + NTHR * i, kidx = idx >> 3, c = idx & 7; const size_t tok = (size_t)b * SEQ + min(row0 * 64 + kidx, SEQ - 1);
                  tk[i] = *(const u32x4*)(KR + tok * 512 + h * 64 + 8 * c); tv[i] = *(const u32x4*)(V + tok * 512 + h * 64 + 8 * c); }
#pragma unroll
              for (int i = 0; i < 5; ++i) { const int idx = C.tid + NTHR * i, kidx = idx >> 3, c = idx & 7;
                  *(LAS u32x4*)(L + NA_KW + kswz(kidx, c)) = tk[i]; *(LAS u32x4*)(L + NA_VW + voff(kidx, c)) = tv[i]; } }
            __syncthreads();
            if (grp == 0) {
                f32x4 sc[16];
#pragma unroll
                for (int tt = 0; tt < 16; ++tt) {
                    const bf16x8 k0 = *(const LAS bf16x8*)(kc0 + 2048 * tt), k1 = *(const LAS bf16x8*)(kc1 + 2048 * tt);
                    f32x4 z = {0.f, 0.f, 0.f, 0.f}; z = __builtin_amdgcn_mfma_f32_16x16x32_bf16(k0, qp0, z, 0, 0, 0); sc[tt] = __builtin_amdgcn_mfma_f32_16x16x32_bf16(k1, qp1, z, 0, 0, 0); }
                float mx = -INFINITY;
#pragma unroll
                for (int tt = 0; tt < 16; ++tt)
#pragma unroll
                    for (int i = 0; i < 4; ++i) mx = fmaxf(mx, sc[tt][i]);
                mx = fmaxf(mx, __shfl_xor(mx, 16)); mx = fmaxf(mx, __shfl_xor(mx, 32));
                float ls = 0.f;
#pragma unroll
                for (int tt = 0; tt < 16; ++tt)
#pragma unroll
                    for (int i = 0; i < 4; ++i) { const float p = __expf(sc[tt][i] - mx); sc[tt][i] = p; ls += p; }
                ls += __shfl_xor(ls, 16); ls += __shfl_xor(ls, 32);
                mrun = mx; lrun = ls;
#pragma unroll
                for (int uu = 0; uu < 8; ++uu) { const bf16x8 pf = pack8(sc[2 * uu], sc[2 * uu + 1]);
#pragma unroll
                    for (int dt = 0; dt < 4; ++dt) { const s16x4 lo = lds_tr16(vcb + uu * 4096 + dt * 256), hi = lds_tr16(vcb + uu * 4096 + 2048 + dt * 256);
                        const bf16x8 af = {lo[0], lo[1], lo[2], lo[3], hi[0], hi[1], hi[2], hi[3]}; o[dt] = __builtin_amdgcn_mfma_f32_16x16x32_bf16(af, pf, o[dt], 0, 0, 0); } }
            }
            f32x4 sw[8];
#pragma unroll
            for (int tt = 0; tt < 8; ++tt) { const int al = tt >> 1, cg = tt & 1;
                const bf16x8 k0 = *(const LAS bf16x8*)(kwb0 + (al * 64 + 16 * cg) * 128), k1 = *(const LAS bf16x8*)(kwb1 + (al * 64 + 16 * cg) * 128);
                f32x4 z = {0.f, 0.f, 0.f, 0.f}; z = __builtin_amdgcn_mfma_f32_16x16x32_bf16(k0, qr0, z, 0, 0, 0); sw[tt] = __builtin_amdgcn_mfma_f32_16x16x32_bf16(k1, qr1, z, 0, 0, 0); }
            float mx = mrun;
            const LAS float* blg = bl + grp * 256;
#pragma unroll
            for (int tt = 0; tt < 8; ++tt) { const int al = tt >> 1, cg = tt & 1;
#pragma unroll
                for (int i = 0; i < 4; ++i) { const unsigned rel = (unsigned)(kcl + 16 * cg + i); const float s = rel < 16u ? sw[tt][i] + blg[al * 64 + 16 * cg + i] : -INFINITY; sw[tt][i] = s; mx = fmaxf(mx, s); } }
            mx = fmaxf(mx, __shfl_xor(mx, 16)); mx = fmaxf(mx, __shfl_xor(mx, 32));
            const float scale = __expf(mrun - mx); mrun = mx;
            float ls = 0.f;
#pragma unroll
            for (int tt = 0; tt < 8; ++tt)
#pragma unroll
                for (int i = 0; i < 4; ++i) { const float p = __expf(sw[tt][i] - mx); sw[tt][i] = p; ls += p; }
            ls += __shfl_xor(ls, 16); ls += __shfl_xor(ls, 32);
            lrun = lrun * scale + ls;
#pragma unroll
            for (int dt = 0; dt < 4; ++dt) o[dt] = o[dt] * scale;
#pragma unroll
            for (int al = 0; al < 4; ++al) { const bf16x8 pf = pack8(sw[2 * al], sw[2 * al + 1]);
#pragma unroll
                for (int dt = 0; dt < 4; ++dt) { const s16x4 lo = lds_tr16(vwb + al * 8192 + dt * 256), hi = lds_tr16(vwb + al * 8192 + 2048 + dt * 256);
                    const bf16x8 af = {lo[0], lo[1], lo[2], lo[3], hi[0], hi[1], hi[2], hi[3]}; o[dt] = __builtin_amdgcn_mfma_f32_16x16x32_bf16(af, pf, o[dt], 0, 0, 0); } }
        }
        const float inv = 1.0f / lrun;
#pragma unroll
        for (int dt = 0; dt < 4; ++dt) st_bf4(MIXIN + mq * DM + h * 64 + 16 * dt + 4 * g, o[dt] * inv);
    }
}

__device__ __forceinline__ int hg_row(int b, int dir, int c, int j) {
    const int tt = (c < 4 ? 64 * c : 64 * (c - 4)) + j;
    return c < 4 ? MROWS + b * CTXL + (dir ? 255 - tt : tt) : b * SEQ + (dir ? 8191 - tt : tt);
}

constexpr size_t WS_DSEG = 5 * MiB;
constexpr size_t WS_KVSEG = 8 * MiB;
constexpr size_t WS_SINS = 40 * MiB;
constexpr int HG_QD = 0, HG_KD = 16384, HG_KET = 32768, HG_VT = 49152, HG_AT = 65536, HG_ST = 73728, HG_DEC = 75776, HG_END = 76288;
__device__ __forceinline__ int off256(int row, int c) { return row * 256 + ((c ^ (row & 15)) << 4); }
__device__ __forceinline__ int off128(int row, int c) { return row * 128 + ((c ^ ((row >> 1) & 7)) << 4); }

struct HgRaw { float lf[16]; unsigned qv[16], vv[16]; };
template <bool FULL>
__device__ __forceinline__ void hg_load(const Ctx& C, int b, int h, int dir, int c, const float* LF, const bf16* QH, const bf16* IH, HgRaw& r) {
    const int ch = C.tid & 127, tq = C.tid >> 7;
#pragma unroll
    for (int i = 0; i < 16; ++i) { const size_t o = (size_t)hg_row(b, dir, c, 16 * tq + i) * 512 + h * 128 + ch; r.lf[i] = LF[o]; r.vv[i] = IH[o]; r.qv[i] = FULL ? (unsigned)QH[o] : 0u; }
}
template <bool FULL>
__device__ __forceinline__ float hg_prep(const Ctx& C, const HgRaw& r) {
    LAS unsigned char* L = C.lds; LAS float* sT = (LAS float*)(L + HG_ST); LAS float* sDec = (LAS float*)(L + HG_DEC);
    const int ch = C.tid & 127, tq = C.tid >> 7;
    float bl[16]; float run = 0.f;
#pragma unroll
    for (int i = 0; i < 16; ++i) { run += r.lf[i]; bl[i] = run; }
    sT[tq * 128 + ch] = run;
    __syncthreads();
    float off = 0.f, tot = 0.f;
#pragma unroll
    for (int t = 0; t < 4; ++t) { const float x = sT[t * 128 + ch]; off += (t < tq) ? x : 0.f; tot += x; }
    unsigned ke[8], vt[8];
#pragma unroll
    for (int i = 0; i < 16; i += 2) {
        const float b0 = off + bl[i], b1 = off + bl[i + 1];
        const float k0 = 1.0f - __expf(r.lf[i]), k1 = 1.0f - __expf(r.lf[i + 1]);
        ke[i >> 1] = pk2(k0 * __expf(tot - b0), k1 * __expf(tot - b1));
        vt[i >> 1] = r.vv[i] | (r.vv[i + 1] << 16);
        if (FULL) {
            const int t0 = 16 * tq + i;
            *(LAS unsigned short*)(L + HG_QD + off256(t0, ch >> 3) + (ch & 7) * 2) = (unsigned short)f2bf(bf2f(r.qv[i]) * __expf(b0));
            *(LAS unsigned short*)(L + HG_QD + off256(t0 + 1, ch >> 3) + (ch & 7) * 2) = (unsigned short)f2bf(bf2f(r.qv[i + 1]) * __expf(b1));
            *(LAS unsigned short*)(L + HG_KD + off256(t0, ch >> 3) + (ch & 7) * 2) = (unsigned short)f2bf(k0 * __expf(-b0));
            *(LAS unsigned short*)(L + HG_KD + off256(t0 + 1, ch >> 3) + (ch & 7) * 2) = (unsigned short)f2bf(k1 * __expf(-b1));
        }
    }
    *(LAS u32x4*)(L + HG_KET + off128(ch, 2 * tq)) = (u32x4){ke[0], ke[1], ke[2], ke[3]};
    *(LAS u32x4*)(L + HG_KET + off128(ch, 2 * tq + 1)) = (u32x4){ke[4], ke[5], ke[6], ke[7]};
    *(LAS u32x4*)(L + HG_VT + off128(ch, 2 * tq)) = (u32x4){vt[0], vt[1], vt[2], vt[3]};
    *(LAS u32x4*)(L + HG_VT + off128(ch, 2 * tq + 1)) = (u32x4){vt[4], vt[5], vt[6], vt[7]};
    if (tq == 0) sDec[ch] = __expf(tot);
    return tot;
}
__device__ __forceinline__ void hg_update(const Ctx& C, f32x4 (&S)[8]) {
    LAS unsigned char* L = C.lds; const LAS float* sDec = (const LAS float*)(L + HG_DEC);
    const int q = C.lane & 15, g = C.lane >> 4, v0 = 16 * C.wave;
    const bf16x8 vb0 = *(const LAS bf16x8*)(L + HG_VT + off128(v0 + q, g)), vb1 = *(const LAS bf16x8*)(L + HG_VT + off128(v0 + q, 4 + g));
#pragma unroll
    for (int kt = 0; kt < 8; ++kt) { const f32x4 d4 = *(const LAS f32x4*)(sDec + 16 * kt + 4 * g); f32x4 acc = S[kt] * d4;
        const bf16x8 a0 = *(const LAS bf16x8*)(L + HG_KET + off128(16 * kt + q, g)), a1 = *(const LAS bf16x8*)(L + HG_KET + off128(16 * kt + q, 4 + g));
        acc = __builtin_amdgcn_mfma_f32_16x16x32_bf16(a0, vb0, acc, 0, 0, 0); S[kt] = __builtin_amdgcn_mfma_f32_16x16x32_bf16(a1, vb1, acc, 0, 0, 0); }
}

__device__ __forceinline__ void phase_hg_agg(const Ctx& C) {
    const float* LFF = wsp<float>(C, WS_LFF); const float* LFB = wsp<float>(C, WS_LFB); const bf16 *QH = wsp<bf16>(C, WS_QH), *IH = wsp<bf16>(C, WS_IH);
    float* DSEG = wsp<float>(C, WS_DSEG); float* KVSEG = wsp<float>(C, WS_KVSEG);
    const int UPB = (512 + C.G - 1) / C.G, u_lo = blockIdx.x * UPB, u_hi = min(512, u_lo + UPB);
    const int q = C.lane & 15, g = C.lane >> 4;
    const int nsteps = (u_hi - u_lo) * 4;
    HgRaw raw;
    if (nsteps > 0) { const int bhd = u_lo >> 5, seg = u_lo & 31; hg_load<false>(C, bhd >> 3, (bhd >> 1) & 3, bhd & 1, 4 * seg, (bhd & 1) ? LFB : LFF, QH, IH, raw); }
    f32x4 S[8]; float total = 0.f;
#pragma unroll 1
    for (int t = 0; t < nsteps; ++t) {
        const int u = u_lo + (t >> 2), cc = t & 3;
        if (cc == 0) { total = 0.f;
#pragma unroll
            for (int kt = 0; kt < 8; ++kt) S[kt] = (f32x4){0.f, 0.f, 0.f, 0.f}; }
        total += hg_prep<false>(C, raw);
        if (t + 1 < nsteps) { const int un = u_lo + ((t + 1) >> 2), bhd = un >> 5, seg = un & 31; hg_load<false>(C, bhd >> 3, (bhd >> 1) & 3, bhd & 1, 4 * seg + ((t + 1) & 3), (bhd & 1) ? LFB : LFF, QH, IH, raw); }
        __syncthreads();
        hg_update(C, S);
        if (cc == 3) {
            if (C.tid < 128) DSEG[(size_t)u * 128 + C.tid] = __expf(total);
            float* kv = KVSEG + (size_t)u * 16384 + 16 * C.wave + q;
#pragma unroll
            for (int kt = 0; kt < 8; ++kt)
#pragma unroll
                for (int i = 0; i < 4; ++i) kv[(16 * kt + 4 * g + i) * 128] = S[kt][i];
        }
    }
}
__device__ __forceinline__ void phase_hg_scan(const Ctx& C) {
    const float* DSEG = wsp<float>(C, WS_DSEG); const float* KVSEG = wsp<float>(C, WS_KVSEG); float* SIN = wsp<float>(C, WS_SINS);
    for (int e2 = blockIdx.x * NTHR + C.tid; e2 < 16 * 8192; e2 += C.G * NTHR) {
        const int bhd = e2 >> 13, el = (e2 & 8191) * 2, k = el >> 7;
        const float* kv = KVSEG + (size_t)bhd * 32 * 16384 + el; const float* ds = DSEG + (size_t)bhd * 32 * 128 + k; float* so = SIN + (size_t)bhd * 32 * 16384 + el;
        f32x2 cur = *(const f32x2*)kv; *(f32x2*)so = cur;
        f32x2 kvn[8]; float dn[8];
#pragma unroll 1
        for (int s0 = 1; s0 < 32; s0 += 8) {
#pragma unroll
            for (int i = 0; i < 8; ++i) { const int s = min(s0 + i, 31); kvn[i] = *(const f32x2*)(kv + (size_t)s * 16384); dn[i] = ds[s * 128]; }
#pragma unroll
            for (int i = 0; i < 8; ++i) if (s0 + i < 32) { cur = dn[i] * cur + kvn[i]; *(f32x2*)(so + (size_t)(s0 + i) * 16384) = cur; }
        }
    }
}
constexpr int HG_OFS = HG_END;
constexpr int HG_OS = HG_QD;
static_assert(HG_OFS + 256 * 128 * 2 + LDSCTL_BYTES <= LDS_BYTES && 64 * 128 * 4 <= HG_KET, "hg_out LDS map");
__device__ __forceinline__ void phase_hg_out(const Ctx& C) {
    const Args& a = C.a;
    const float* LFF = wsp<float>(C, WS_LFF); const float* LFB = wsp<float>(C, WS_LFB); const bf16 *QH = wsp<bf16>(C, WS_QH), *IH = wsp<bf16>(C, WS_IH), *GH = wsp<bf16>(C, WS_GH);
    const float* SIN = wsp<float>(C, WS_SINS); const float* hgn = a.in[I_HGN]; bf16* MIXIN = wsp<bf16>(C, WS_MIXIN);
    LAS unsigned char* L = C.lds;
    const int UPB = (256 + C.G - 1) / C.G, u_lo = blockIdx.x * UPB, u_hi = min(256, u_lo + UPB);
    const int q = C.lane & 15, g = C.lane >> 4, v0 = 16 * C.wave;
    for (int u = u_lo; u < u_hi; ++u) {
        const int bh = u >> 5, ls = u & 31, b = bh >> 2, h = bh & 3;
        HgRaw raw;
        hg_load<true>(C, b, h, 0, 4 + 4 * ls, LFF, QH, IH, raw);
        f32x4 S[8];
#pragma unroll 1
        for (int step = 0; step < 8; ++step) {
            const int dir = step >> 2, cc = step & 3;
            {
                const int bhd = bh * 2 + dir, segl = dir ? 31 - ls : ls;
                if (cc == 0) { const float* si = SIN + ((size_t)bhd * 32 + segl) * 16384 + v0 + q;
#pragma unroll
                  for (int kt = 0; kt < 8; ++kt)
#pragma unroll
                      for (int i = 0; i < 4; ++i) S[kt][i] = si[(16 * kt + 4 * g + i) * 128]; }
                (void)hg_prep<true>(C, raw);
                if (step < 7) { const int dn = (step + 1) >> 2, sn = dn ? 31 - ls : ls; hg_load<true>(C, b, h, dn, 4 + 4 * sn + ((step + 1) & 3), dn ? LFB : LFF, QH, IH, raw); }
                __syncthreads();
#pragma unroll
                for (int t2 = 0; t2 < 2; ++t2) { const int id = 2 * C.wave + t2, st = id >> 2, jt = id & 3;
                    f32x4 acc = {0.f, 0.f, 0.f, 0.f};
                    if (st <= jt) {
#pragma unroll
                        for (int ks = 0; ks < 4; ++ks) { const bf16x8 ka = *(const LAS bf16x8*)(L + HG_KD + off256(16 * st + q, 4 * ks + g)), qb = *(const LAS bf16x8*)(L + HG_QD + off256(16 * jt + q, 4 * ks + g));
                            acc = __builtin_amdgcn_mfma_f32_16x16x32_bf16(ka, qb, acc, 0, 0, 0); }
#pragma unroll
                        for (int i = 0; i < 4; ++i) if (16 * st + 4 * g + i > 16 * jt + q) acc[i] = 0.f;
                    }
                    u32x2 w; w.x = pk2(acc[0], acc[1]); w.y = pk2(acc[2], acc[3]);
                    *(LAS u32x2*)(L + HG_AT + off128(16 * jt + q, 2 * st + (g >> 1)) + (g & 1) * 8) = w; }
                __syncthreads();
                f32x4 o[4];
#pragma unroll
                for (int jt = 0; jt < 4; ++jt) o[jt] = (f32x4){0.f, 0.f, 0.f, 0.f};
                { const bf16x8 vb0 = *(const LAS bf16x8*)(L + HG_VT + off128(v0 + q, g)), vb1 = *(const LAS bf16x8*)(L + HG_VT + off128(v0 + q, 4 + g));
#pragma unroll
                  for (int jt = 0; jt < 4; ++jt) { const bf16x8 a0 = *(const LAS bf16x8*)(L + HG_AT + off128(16 * jt + q, g)), a1 = *(const LAS bf16x8*)(L + HG_AT + off128(16 * jt + q, 4 + g));
                      o[jt] = __builtin_amdgcn_mfma_f32_16x16x32_bf16(a0, vb0, o[jt], 0, 0, 0); o[jt] = __builtin_amdgcn_mfma_f32_16x16x32_bf16(a1, vb1, o[jt], 0, 0, 0); } }
#pragma unroll
                for (int sp = 0; sp < 4; ++sp) { const bf16x8 sb = pack8(S[2 * sp], S[2 * sp + 1]);
#pragma unroll
                    for (int jt = 0; jt < 4; ++jt) { const int row = 16 * jt + q;
                        const s16x4 lo = *(const LAS s16x4*)(L + HG_QD + off256(row, 4 * sp + (g >> 1)) + (g & 1) * 8), hi = *(const LAS s16x4*)(L + HG_QD + off256(row, 4 * sp + 2 + (g >> 1)) + (g & 1) * 8);
                        const bf16x8 af = {lo[0], lo[1], lo[2], lo[3], hi[0], hi[1], hi[2], hi[3]};
                        o[jt] = __builtin_amdgcn_mfma_f32_16x16x32_bf16(af, sb, o[jt], 0, 0, 0); } }
                if (dir == 0) {
#pragma unroll
                    for (int jt = 0; jt < 4; ++jt)
#pragma unroll
                        for (int i = 0; i < 4; ++i) *(LAS unsigned short*)(L + HG_OFS + (64 * cc + 16 * jt + 4 * g + i) * 256 + (v0 + q) * 2) = (unsigned short)f2bf(o[jt][i]);
                    if (cc < 3) hg_update(C, S);
                } else {
#pragma unroll
                    for (int jt = 0; jt < 4; ++jt)
#pragma unroll
                        for (int i = 0; i < 4; ++i) o[jt][i] += bf2f(*(const LAS unsigned short*)(L + HG_OFS + (255 - 64 * cc - (16 * jt + 4 * g + i)) * 256 + (v0 + q) * 2));
                    if (cc < 3) hg_update(C, S);
                    __syncthreads();
#pragma unroll
                    for (int jt = 0; jt < 4; ++jt)
#pragma unroll
                        for (int i = 0; i < 4; ++i) *(LAS float*)(L + HG_OS + ((16 * jt + 4 * g + i) * 128 + v0 + q) * 4) = o[jt][i];
                    unsigned gwp[8];
#pragma unroll
                    for (int jj = 0; jj < 8; ++jj) { const size_t row = (size_t)b * SEQ + 256 * ls + 255 - 64 * cc - (8 * C.wave + jj); gwp[jj] = *(const unsigned*)(GH + row * 512 + h * 128 + 2 * C.lane); }
                    __syncthreads();
#pragma unroll
                    for (int jj = 0; jj < 8; ++jj) { const int j = 8 * C.wave + jj; const size_t row = (size_t)b * SEQ + 256 * ls + 255 - 64 * cc - j;
                        const f32x2 ov = *(const LAS f32x2*)(L + HG_OS + (j * 128 + 2 * C.lane) * 4);
                        const float rstd = 1.0f / sqrtf(wave_sum(ov.x * ov.x + ov.y * ov.y) * (1.0f / 128.0f) + RMS_EPS);
                        const unsigned gw2 = gwp[jj]; const f32x2 nn = *(const f32x2*)(hgn + 2 * C.lane);
                        *(unsigned*)(MIXIN + row * DM + 512 + h * 128 + 2 * C.lane) = pk2(ov.x * rstd * nn.x * sigmoidf_(bflo(gw2)), ov.y * rstd * nn.y * sigmoidf_(bfhi(gw2))); }
                }
            }
        }
    }
}

__device__ __forceinline__ void phase_rowpass(const Ctx& C) {
    const Args& a = C.a;
    LAS float* sW = (LAS float*)C.lds;
    LAS float* sC = sW + 16 * 1024;
    const float* modf = wsp<float>(C, WS_MODF);
    { const float* WRT = wsp<float>(C, WS_WRT);
#pragma unroll 4
      for (int i = 0; i < 8; ++i) { const int idx = C.tid + 512 * i; *(LAS f32x4*)(sW + 4 * idx) = *(const f32x4*)(WRT + 4 * idx); }
      for (int j4 = C.tid; j4 < 1536; j4 += NTHR) { const int bb = j4 / 768, rem = j4 % 768, wh = rem >> 8, ch = (rem & 255) * 4; const float* mf = modf + bb * 6144;
          f32x4 v;
          if (wh == 0) v = *(const f32x4*)(a.in[I_GPOST1] + ch) * *(const f32x4*)(mf + 2048 + ch);
          else if (wh == 1) v = *(const f32x4*)(a.in[I_GPRE2] + ch) * (1.0f + *(const f32x4*)(mf + 4096 + ch));
          else v = *(const f32x4*)(mf + 3072 + ch);
          *(LAS f32x4*)(sC + (bb * 3 + wh) * 1024 + ch) = v; } }
    __syncthreads();
    const float* MIX = wsp<float>(C, WS_MIX); float* AFF = wsp<float>(C, WS_AFF); unsigned char* H2 = C.ws + WS_H2;
    const int gw = blockIdx.x * NWAVES + C.wave, NGW = C.G * NWAVES;
    const int b5 = (C.lane >> 5) & 1, b4 = (C.lane >> 4) & 1, b3 = (C.lane >> 3) & 1, b2 = (C.lane >> 2) & 1, myexp = 8 * b5 + 4 * b4 + 2 * b3 + b2;
    if (2 * gw >= MROWS) return;
    f32x4 mx[2][4], xv[2][4], mxn[2][4], xvn[2][4], po[2][4]; unsigned ph[2][4]; float paff[2] = {0.f, 0.f};
    auto loadn = [&](int row0) {
#pragma unroll
        for (int r = 0; r < 2; ++r)
#pragma unroll
            for (int j = 0; j < 4; ++j) { const size_t o = (size_t)(row0 + r) * DM + 4 * (C.lane + 64 * j); mxn[r][j] = *(const f32x4*)(MIX + o); xvn[r][j] = *(const f32x4*)(a.in[I_X] + o); }
    };
    auto storep = [&](int row0) {
        const int b = row0 >> 13;
#pragma unroll
        for (int r = 0; r < 2; ++r) {
#pragma unroll
            for (int j = 0; j < 4; ++j) { const int ch = 4 * (C.lane + 64 * j); *(f32x4*)(a.out + (size_t)(row0 + r) * DM + ch) = po[r][j]; *(unsigned*)(H2 + (size_t)(row0 + r) * DM + ch) = ph[r][j]; }
            if ((C.lane & 3) == 0) AFF[((size_t)b * 16 + myexp) * SEQ + ((row0 + r) & 8191)] = paff[r]; }
    };
#pragma unroll
    for (int r = 0; r < 2; ++r)
#pragma unroll
        for (int j = 0; j < 4; ++j) { po[r][j] = (f32x4){0.f, 0.f, 0.f, 0.f}; ph[r][j] = 0u; }
    loadn(2 * gw);
    int prow = 2 * gw;
    for (int row0 = 2 * gw; row0 < MROWS; row0 += 2 * NGW) {
        const int b = row0 >> 13; const LAS float* cc = sC + b * 3072;
        float ss[2];
#pragma unroll
        for (int r = 0; r < 2; ++r) { ss[r] = 0.f;
#pragma unroll
            for (int j = 0; j < 4; ++j) { mx[r][j] = mxn[r][j]; xv[r][j] = xvn[r][j]; } }
        storep(prow); prow = row0;
        loadn(row0 + 2 * NGW < MROWS ? row0 + 2 * NGW : row0);
#pragma unroll
        for (int r = 0; r < 2; ++r)
#pragma unroll
            for (int j = 0; j < 4; ++j) ss[r] += (mx[r][j].x * mx[r][j].x + mx[r][j].y * mx[r][j].y) + (mx[r][j].z * mx[r][j].z + mx[r][j].w * mx[r][j].w);
#pragma unroll
        for (int o = 1; o < 64; o <<= 1) { ss[0] += __shfl_xor(ss[0], o); ss[1] += __shfl_xor(ss[1], o); }
        float ss2[2] = {0.f, 0.f};
#pragma unroll
        for (int j = 0; j < 4; ++j) { const int ch = 4 * (C.lane + 64 * j); const f32x4 c1 = *(const LAS f32x4*)(cc + ch);
#pragma unroll
            for (int r = 0; r < 2; ++r) { const float rstd1 = 1.0f / sqrtf(ss[r] * (1.0f / DM) + RMS_EPS);
                xv[r][j] = xv[r][j] + c1 * (mx[r][j] * rstd1); po[r][j] = xv[r][j];
                ss2[r] += (xv[r][j].x * xv[r][j].x + xv[r][j].y * xv[r][j].y) + (xv[r][j].z * xv[r][j].z + xv[r][j].w * xv[r][j].w); } }
#pragma unroll
        for (int o = 1; o < 64; o <<= 1) { ss2[0] += __shfl_xor(ss2[0], o); ss2[1] += __shfl_xor(ss2[1], o); }
#pragma unroll
        for (int j = 0; j < 4; ++j) { const int ch = 4 * (C.lane + 64 * j); const f32x4 c2 = *(const LAS f32x4*)(cc + 1024 + ch), sh = *(const LAS f32x4*)(cc + 2048 + ch);
#pragma unroll
            for (int r = 0; r < 2; ++r) { const float rstd2 = 1.0f / sqrtf(ss2[r] * (1.0f / DM) + RMS_EPS);
                xv[r][j] = xv[r][j] * (rstd2 * c2) + sh; ph[r][j] = pk4_fp8(xv[r][j].x * H2_SCALE, xv[r][j].y * H2_SCALE, xv[r][j].z * H2_SCALE, xv[r][j].w * H2_SCALE); } }
#pragma unroll
        for (int r = 0; r < 2; ++r) {
            float lg[16];
#pragma unroll
            for (int e = 0; e < 16; ++e) { float p = 0.f;
#pragma unroll
                for (int j = 0; j < 4; ++j) { const f32x4 w = *(const LAS f32x4*)(sW + e * 1024 + 4 * (C.lane + 64 * j)); const f32x4 h = xv[r][j]; p += (h.x * w.x + h.y * w.y) + (h.z * w.z + h.w * w.w); }
                lg[e] = p; if ((e & 3) == 3) asm volatile("" ::: "memory"); }
            float l8[8], l4[4], l2[2], l1;
#pragma unroll
            for (int e = 0; e < 8; ++e) { const float keep = b5 ? lg[e + 8] : lg[e], send = b5 ? lg[e] : lg[e + 8]; l8[e] = keep + __shfl_xor(send, 32); }
#pragma unroll
            for (int e = 0; e < 4; ++e) { const float keep = b4 ? l8[e + 4] : l8[e], send = b4 ? l8[e] : l8[e + 4]; l4[e] = keep + __shfl_xor(send, 16); }
#pragma unroll
            for (int e = 0; e < 2; ++e) { const float keep = b3 ? l4[e + 2] : l4[e], send = b3 ? l4[e] : l4[e + 2]; l2[e] = keep + __shfl_xor(send, 8); }
            { const float keep = b2 ? l2[1] : l2[0], send = b2 ? l2[0] : l2[1]; l1 = keep + __shfl_xor(send, 4); }
            l1 += __shfl_xor(l1, 2); l1 += __shfl_xor(l1, 1);
            float mxl = l1;
#pragma unroll
            for (int o = 4; o < 64; o <<= 1) mxl = fmaxf(mxl, __shfl_xor(mxl, o));
            const float p = expf(l1 - mxl); float den = p;
#pragma unroll
            for (int o = 4; o < 64; o <<= 1) den += __shfl_xor(den, o);
            paff[r] = p / den;
        }
    }
    storep(prow);
}

__device__ __forceinline__ void phase_topk(const Ctx& C) {
    if (blockIdx.x >= 32) { convert_tiles(C, CV_D1_END, CV_NT, (int)blockIdx.x - 32, C.G - 32); return; }
    const int list = blockIdx.x, b = list >> 4, e = list & 15;
    LAS unsigned* keys = (LAS unsigned*)C.lds;
    LAS unsigned* hist = keys + 8192;
    volatile LAS unsigned* misc = hist + 256;
    LAS unsigned* wtot = hist + 256 + 8;
    const float* AFF = wsp<float>(C, WS_AFF) + (size_t)list * SEQ;
#pragma unroll
    for (int i = 0; i < 4; ++i) *(LAS u32x4*)(keys + 4 * (C.tid + 512 * i)) = *(const u32x4*)(AFF + 4 * (C.tid + 512 * i));
    if (C.tid == 0) { misc[0] = 0u; misc[1] = (unsigned)CAP; }
    __syncthreads();
    unsigned prefix = 0u, mask = 0u;
    for (int pass = 3; pass >= 0; --pass) {
        if (C.tid < 256) hist[C.tid] = 0u;
        __syncthreads();
#pragma unroll
        for (int i = 0; i < 16; ++i) { const unsigned key = keys[C.tid + 512 * i]; if ((key & mask) == prefix) atomicAdd((unsigned*)&hist[(key >> (8 * pass)) & 255u], 1u); }
        __syncthreads();
        if (C.wave == 0) {
            const u32x4 h4 = *(const LAS u32x4*)(hist + 4 * C.lane); const unsigned s = h4.x + h4.y + h4.z + h4.w; unsigned inc = s;
#pragma unroll
            for (int o = 1; o < 64; o <<= 1) { const unsigned t = __shfl_down(inc, o); if (C.lane + o < 64) inc += t; }
            const unsigned need = misc[1]; unsigned cum = inc - s;
            int chosen = -1; unsigned nn = 0u;
            if (cum < need && need <= cum + h4.w) { chosen = 4 * C.lane + 3; nn = need - cum; } cum += h4.w;
            if (cum < need && need <= cum + h4.z) { chosen = 4 * C.lane + 2; nn = need - cum; } cum += h4.z;
            if (cum < need && need <= cum + h4.y) { chosen = 4 * C.lane + 1; nn = need - cum; } cum += h4.y;
            if (cum < need && need <= cum + h4.x) { chosen = 4 * C.lane + 0; nn = need - cum; }
            if (chosen >= 0) { misc[0] = prefix | ((unsigned)chosen << (8 * pass)); misc[1] = nn; }
        }
        __syncthreads();
        prefix = misc[0]; mask |= 0xFFu << (8 * pass);
    }
    const unsigned T = prefix, need_eq = misc[1];
    const int base = C.tid * 16; unsigned cgt = 0u, ceq = 0u; unsigned kk[16];
#pragma unroll
    for (int i = 0; i < 4; ++i) { const u32x4 k4 = *(const LAS u32x4*)(keys + base + 4 * i); kk[4 * i] = k4.x; kk[4 * i + 1] = k4.y; kk[4 * i + 2] = k4.z; kk[4 * i + 3] = k4.w; }
#pragma unroll
    for (int i = 0; i < 16; ++i) { cgt += kk[i] > T ? 1u : 0u; ceq += kk[i] == T ? 1u : 0u; }
    unsigned ig = cgt, ie = ceq;
#pragma unroll
    for (int o = 1; o < 64; o <<= 1) { const unsigned tg = __shfl_up(ig, o), te = __shfl_up(ie, o); if (C.lane >= o) { ig += tg; ie += te; } }
    if (C.lane == 63) { wtot[C.wave] = ig; wtot[8 + C.wave] = ie; }
    __syncthreads();
    unsigned gpre = ig - cgt, epre = ie - ceq;
    for (int w = 0; w < C.wave; ++w) { gpre += wtot[w]; epre += wtot[8 + w]; }
    int* IDX = wsp<int>(C, WS_IDX) + list * CAP; float* GATEV = wsp<float>(C, WS_GATEV) + (e * 2 + b) * CAP; int* SLOT = wsp<int>(C, WS_SLOT);
#pragma unroll
    for (int i = 0; i < 16; ++i) { const int t = base + i; const unsigned key = kk[i]; int pos = -1;
        if (key > T) { pos = (int)(gpre + min(epre, need_eq)); ++gpre; }
        else if (key == T) { if (epre < need_eq) pos = (int)(gpre + epre); ++epre; }
        if (pos >= 0) { IDX[pos] = t; GATEV[pos] = __builtin_bit_cast(float, key); }
        SLOT[((size_t)b * SEQ + t) * 16 + e] = pos; }
}

__device__ __forceinline__ void phase_final(const Ctx& C) {
    const Args& a = C.a;
    const int gw = blockIdx.x * NWAVES + C.wave, NGW = C.G * NWAVES;
    const int* SLOT = wsp<int>(C, WS_SLOT); const bf16* YS = wsp<bf16>(C, WS_YS); const float* modf = wsp<float>(C, WS_MODF);
    LAS float* sG = (LAS float*)C.lds;
    for (int j4 = C.tid; j4 < 512; j4 += NTHR) { const int bb = j4 >> 8, ch = (j4 & 255) * 4; *(LAS f32x4*)(sG + bb * 1024 + ch) = *(const f32x4*)(a.in[I_GPOST2] + ch) * *(const f32x4*)(modf + bb * 6144 + 5120 + ch); }
    __syncthreads();
    if (gw >= MROWS) return;
    const int rlast = gw + ((MROWS - 1 - gw) / NGW) * NGW;
    auto pair = [&](int sv, int b, const bf16*& y0, const bf16*& y1, float& f0, float& f1, unsigned long long& rest) {
        unsigned long long m = __ballot(sv >= 0) & 0xFFFFull;
        const bool any = m != 0ull; const int e0 = any ? __builtin_ctzll(m) : 0; m &= m - 1;
        const bool two = m != 0ull; const int e1 = two ? __builtin_ctzll(m) : e0; m &= m - 1;
        const int s0 = any ? __builtin_amdgcn_readlane(sv, e0) : 0, s1 = two ? __builtin_amdgcn_readlane(sv, e1) : s0;
        y0 = YS + ((size_t)(e0 * 2 + b) * CAP + s0) * DM; y1 = YS + ((size_t)(e1 * 2 + b) * CAP + s1) * DM;
        f0 = any ? 1.f : 0.f; f1 = two ? 1.f : 0.f; rest = m;
    };
    int svA = SLOT[(size_t)gw * 16 + (C.lane & 15)];
    int svB = SLOT[(size_t)min(gw + NGW, rlast) * 16 + (C.lane & 15)];
    f32x4 x1n[4], po[4]; u32x2 w0n[4], w1n[4];
#pragma unroll
    for (int j = 0; j < 4; ++j) { x1n[j] = *(const f32x4*)(a.out + (size_t)gw * DM + 4 * (C.lane + 64 * j)); po[j] = (f32x4){0.f, 0.f, 0.f, 0.f}; }
    { const bf16 *y0, *y1; float f0, f1; unsigned long long rest; pair(svA, gw >> 13, y0, y1, f0, f1, rest);
#pragma unroll
      for (int j = 0; j < 4; ++j) { w0n[j] = *(const u32x2*)(y0 + 4 * (C.lane + 64 * j)); w1n[j] = *(const u32x2*)(y1 + 4 * (C.lane + 64 * j)); } }
    int prow = gw;
    for (int row = gw; row < MROWS; row += NGW) {
        const int b = row >> 13;
        const int sv = svA;
        f32x4 x1[4]; u32x2 w0[4], w1[4];
#pragma unroll
        for (int j = 0; j < 4; ++j) { x1[j] = x1n[j]; w0[j] = w0n[j]; w1[j] = w1n[j]; }
#pragma unroll
        for (int j = 0; j < 4; ++j) *(f32x4*)(a.out + (size_t)prow * DM + 4 * (C.lane + 64 * j)) = po[j];
        prow = row;
        { const int rn = min(row + NGW, rlast), rnn = min(row + 2 * NGW, rlast);
          svA = svB;
          svB = SLOT[(size_t)rnn * 16 + (C.lane & 15)];
#pragma unroll
          for (int j = 0; j < 4; ++j) x1n[j] = *(const f32x4*)(a.out + (size_t)rn * DM + 4 * (C.lane + 64 * j));
          const bf16 *y0, *y1; float f0, f1; unsigned long long rest; pair(svA, rn >> 13, y0, y1, f0, f1, rest);
#pragma unroll
          for (int j = 0; j < 4; ++j) { w0n[j] = *(const u32x2*)(y0 + 4 * (C.lane + 64 * j)); w1n[j] = *(const u32x2*)(y1 + 4 * (C.lane + 64 * j)); } }
        f32x4 acc[4];
        unsigned long long mask;
        { const bf16 *y0, *y1; float f0, f1; pair(sv, b, y0, y1, f0, f1, mask);
#pragma unroll
          for (int j = 0; j < 4; ++j) { acc[j].x = f0 * bflo(w0[j].x) + f1 * bflo(w1[j].x); acc[j].y = f0 * bfhi(w0[j].x) + f1 * bfhi(w1[j].x); acc[j].z = f0 * bflo(w0[j].y) + f1 * bflo(w1[j].y); acc[j].w = f0 * bfhi(w0[j].y) + f1 * bfhi(w1[j].y); } }
        while (mask) {
            const int e0 = __builtin_ctzll(mask); mask &= mask - 1; const bool two = mask != 0ull; const int e1 = two ? __builtin_ctzll(mask) : e0; mask &= mask - 1;
            const bf16* y0 = YS + ((size_t)(e0 * 2 + b) * CAP + __builtin_amdgcn_readlane(sv, e0)) * DM; const bf16* y1 = YS + ((size_t)(e1 * 2 + b) * CAP + __builtin_amdgcn_readlane(sv, e1)) * DM;
            u32x2 v0[4], v1[4];
#pragma unroll
            for (int j = 0; j < 4; ++j) { v0[j] = *(const u32x2*)(y0 + 4 * (C.lane + 64 * j)); v1[j] = *(const u32x2*)(y1 + 4 * (C.lane + 64 * j)); }
            const float f1 = two ? 1.f : 0.f;
#pragma unroll
            for (int j = 0; j < 4; ++j) { acc[j].x += bflo(v0[j].x) + f1 * bflo(v1[j].x); acc[j].y += bfhi(v0[j].x) + f1 * bfhi(v1[j].x); acc[j].z += bflo(v0[j].y) + f1 * bflo(v1[j].y); acc[j].w += bfhi(v0[j].y) + f1 * bfhi(v1[j].y); } }
        float ss = 0.f;
#pragma unroll
        for (int j = 0; j < 4; ++j) ss += (acc[j].x * acc[j].x + acc[j].y * acc[j].y) + (acc[j].z * acc[j].z + acc[j].w * acc[j].w);
        const float rstd = 1.0f / sqrtf(wave_sum(ss) * (1.0f / DM) + RMS_EPS);
#pragma unroll
        for (int j = 0; j < 4; ++j) { const int ch = 4 * (C.lane + 64 * j);
            const f32x4 gg = *(const LAS f32x4*)(sG + b * 1024 + ch);
            po[j] = x1[j] + gg * (acc[j] * rstd); }
    }
#pragma unroll
    for (int j = 0; j < 4; ++j) *(f32x4*)(a.out + (size_t)prow * DM + 4 * (C.lane + 64 * j)) = po[j];
}

constexpr int GTAB_OFF = 131072;
__device__ __forceinline__ void phase_gemm_in(const Ctx& C) {
    const int Mg = MTOT;
    pg8::Gemm g{wsp<bf16>(C, WS_H), wsp<bf16>(C, WS_WINT), Mg, NINC, DM, 0, 0, 0}; pg8::StaticOrder S; S.init(Mg, NINC, C.G, (int)blockIdx.x);
    LAS float* tb = (LAS float*)(C.lds + GTAB_OFF);
    for (int i = C.tid; i < 2048; i += NTHR) { tb[i] = wsp<float>(C, WS_COS)[i]; tb[2048 + i] = wsp<float>(C, WS_SIN)[i]; }
    if (C.tid < 512) tb[4096 + C.tid] = wsp<float>(C, WS_LB)[C.tid];
    __syncthreads();
    EpiIn E{wsp<bf16>(C, WS_QP), wsp<bf16>(C, WS_QR), wsp<bf16>(C, WS_KR), wsp<bf16>(C, WS_V), wsp<bf16>(C, WS_QH), wsp<bf16>(C, WS_IH), wsp<bf16>(C, WS_GH),
            wsp<float>(C, WS_LFF), wsp<float>(C, WS_LFB), tb + 4096, tb, tb + 2048};
    const int nt_ = (Mg / 256) * (NINC / 256), rounds = (nt_ + C.G - 1) / C.G, lrt = nt_ - (rounds - 1) * C.G; const bool allc = lrt >= C.G;
    const bool conv = C.G > 32 && (allc || (int)blockIdx.x >= lrt); const int widx = allc ? (int)blockIdx.x : (int)blockIdx.x - lrt, nconv = allc ? C.G : C.G - lrt;
    if (conv && (widx & 1) == 0) { convert_tiles(C, CV_P0_END, CV_D1_END, widx, nconv); __syncthreads(); }
    pg8::gemm_phase<EpiIn, pg8::StaticOrder, true, true>(C.lds, g, S, E);
    if (conv && (widx & 1) == 1) convert_tiles(C, CV_P0_END, CV_D1_END, widx, nconv);
}
__device__ __forceinline__ void phase_gemm_out(const Ctx& C) {
    pg8::Gemm g{wsp<bf16>(C, WS_MIXIN), wsp<bf16>(C, WS_WOUTT), MROWS, DM, DM, 0, 0, 0}; pg8::StaticOrder S; S.init(MROWS, DM, C.G, (int)blockIdx.x);
    EpiF32 E{wsp<float>(C, WS_MIX), DM};
    pg8::gemm_phase<EpiF32, pg8::StaticOrder, true, true>(C.lds, g, S, E);
}
static_assert(LDSCTL_BYTES + GTAB_OFF + 23 * 1024 <= LDS_BYTES, "gather table");
__device__ __forceinline__ void phase_gemm1(const Ctx& C) {
    pg8::StaticOrder S; S.init(MEXP, N1P, C.G, (int)blockIdx.x);
    {
        const int* IDX = wsp<int>(C, WS_IDX); LAS int* tab = (LAS int*)(C.lds + GTAB_OFF); pg8::Unit u;
        for (int i = 0; i < 23 && S.next(i, u); ++i)
            if (C.tid < 256) { const int e = u.pm >> 3, b = (u.pm >> 2) & 1; tab[i * 256 + C.tid] = b * SEQ + IDX[(b * 16 + e) * CAP + (u.pm & 3) * 256 + C.tid]; }
        __syncthreads();
    }
    pg8::Gemm g{wsp<bf16>(C, WS_H2), wsp<bf16>(C, WS_W1T), MEXP, N1P, DM / 2, 3, (size_t)N1P * DM, GTAB_OFF};
    EpiHid E{C.ws + WS_HID};
    pg8::gemm_phase<EpiHid, pg8::StaticOrder, true, true, true, true>(C.lds, g, S, E);
}
__device__ __forceinline__ void phase_gemm2(const Ctx& C) {
    pg8::Gemm g{wsp<bf16>(C, WS_HID), wsp<bf16>(C, WS_W2T), MEXP, DM, FEP / 2, 3, (size_t)DM * FEP, 0}; pg8::StaticOrder S; S.init(MEXP, DM, C.G, (int)blockIdx.x);
    EpiYs E{wsp<bf16>(C, WS_YS), wsp<float>(C, WS_GATEV)};
    pg8::gemm_phase<EpiYs, pg8::StaticOrder, true, true, false, true>(C.lds, g, S, E);
}

__global__ void __launch_bounds__(NTHR, 2) fwd_kernel(Args args) {
    extern __shared__ __attribute__((aligned(16))) unsigned char lds_raw[];
    Ctx C; C.lds = (LAS unsigned char*)lds_raw + LDSCTL_BYTES; C.tid = threadIdx.x; C.lane = C.tid & 63; C.wave = __builtin_amdgcn_readfirstlane(C.tid >> 6); C.G = gridDim.x; C.a = args; C.ws = args.ws;
    if (C.tid < LDSCTL_BYTES / 4) ((LAS unsigned*)lds_raw)[C.tid] = 0u;
    __syncthreads();
    const bool multi = (args.ph_hi - args.ph_lo) > 1;
    XcdBarrier bar; bar.bar = (unsigned*)(C.ws + WS_CTL) + CW_BAR; bar.x = 0; bar.st = nullptr;
    if (multi) bar = xcd_barrier_post((unsigned*)(C.ws + WS_CTL) + CW_BAR, (volatile LAS unsigned*)((LAS unsigned char*)lds_raw) + 8);
    const int lo = args.ph_lo, hi = args.ph_hi;
#define IN(k) (lo <= (k) && (k) < hi)
#define SEAM(k) do { if ((k) + 1 < hi) xcd_barrier(bar); } while (0)
#if PH_ON(0)
    if (IN(0)) { for (int rep = 0; rep < 1 + REP_ON(0); ++rep) { phase_prologue(C); __syncthreads(); } SEAM(0); }
#endif
#if PH_ON(1)
    if (IN(1)) { for (int rep = 0; rep < 1 + REP_ON(1); ++rep) { phase_hrows(C); __syncthreads(); } SEAM(1); }
#endif
#if PH_ON(2)
    if (IN(2)) { for (int rep = 0; rep < 1 + REP_ON(2); ++rep) { phase_gemm_in(C); __syncthreads(); } SEAM(2); }
#endif
#if PH_ON(3)
    if (IN(3)) { for (int rep = 0; rep < 1 + REP_ON(3); ++rep) { phase_na(C); __syncthreads(); phase_hg_agg(C); __syncthreads(); } SEAM(3); }
#endif
#if PH_ON(4)
    if (IN(4)) { for (int rep = 0; rep < 1 + REP_ON(4); ++rep) { phase_hg_scan(C); __syncthreads(); } SEAM(4); }
#endif
#if PH_ON(5)
    if (IN(5)) { for (int rep = 0; rep < 1 + REP_ON(5); ++rep) { phase_hg_out(C); __syncthreads(); } SEAM(5); }
#endif
#if PH_ON(6)
    if (IN(6)) { for (int rep = 0; rep < 1 + REP_ON(6); ++rep) { phase_gemm_out(C); __syncthreads(); } SEAM(6); }
#endif
#if PH_ON(7)
    if (IN(7)) { for (int rep = 0; rep < 1 + REP_ON(7); ++rep) { phase_rowpass(C); __syncthreads(); } SEAM(7); }
#endif
#if PH_ON(8)
    if (IN(8)) { for (int rep = 0; rep < 1 + REP_ON(8); ++rep) { phase_topk(C); __syncthreads(); } SEAM(8); }
#endif
#if PH_ON(9)
    if (IN(9)) { for (int rep = 0; rep < 1 + REP_ON(9); ++rep) { phase_gemm1(C); __syncthreads(); } SEAM(9); }
#endif
#if PH_ON(10)
    if (IN(10)) { for (int rep = 0; rep < 1 + REP_ON(10); ++rep) { phase_gemm2(C); __syncthreads(); } SEAM(10); }
#endif
#if PH_ON(11)
    if (IN(11)) { for (int rep = 0; rep < 1 + REP_ON(11); ++rep) { phase_final(C); __syncthreads(); } SEAM(11); }
#endif
#undef IN
#undef SEAM
}

extern "C" void kernel_launch(void* const* d_in, const int* in_sizes, int n_in, void* d_out, int out_size, void* d_ws, size_t ws_size, hipStream_t stream) {
    static int grid = 0;
    if (grid == 0) {
        if (n_in != 19 || out_size != MROWS * DM || ws_size < WS_END) { fprintf(stderr, "kernel_launch: unexpected problem (n_in %d out %d ws %zu)\n", n_in, out_size, ws_size); grid = -1; return; }
        int dev = 0, cus = 0, per_cu = 0;
        if (hipGetDevice(&dev) != hipSuccess || hipDeviceGetAttribute(&cus, hipDeviceAttributeMultiprocessorCount, dev) != hipSuccess) { grid = -1; return; }
        if (hipFuncSetAttribute((const void*)fwd_kernel, hipFuncAttributeMaxDynamicSharedMemorySize, LDS_BYTES) != hipSuccess) { fprintf(stderr, "kernel_launch: hipFuncSetAttribute failed\n"); grid = -1; return; }
        if (hipOccupancyMaxActiveBlocksPerMultiprocessor(&per_cu, (const void*)fwd_kernel, NTHR, LDS_BYTES) != hipSuccess || per_cu < 1) { fprintf(stderr, "kernel_launch: occupancy query says %d\n", per_cu); }
        (void)hipGetLastError();
        grid = cus;
    }
    if (grid < 0) return;
    (void)hipMemsetAsync((char*)d_ws + WS_CTL, 0, CTL_ZERO_BYTES, stream);
    Args a{};
    for (int i = 0; i < 19; ++i) a.in[i] = (const float*)d_in[i];
    a.out = (float*)d_out; a.ws = (unsigned char*)d_ws;
#if MK_N_LAUNCHES == 1
    a.ph_lo = 0; a.ph_hi = NPHASE;
    hipLaunchKernelGGL(fwd_kernel, dim3(grid), dim3(NTHR), LDS_BYTES, stream, a);
#else
    for (int ph = 0; ph < NPHASE; ++ph) { a.ph_lo = ph; a.ph_hi = ph + 1; hipLaunchKernelGGL(fwd_kernel, dim3(grid), dim3(NTHR), LDS_BYTES, stream, a); }
#endif
}
```

```cpp
#include <hip/hip_runtime.h>
#include <cstdio>
#include <cstdint>
#include <cmath>
namespace pg8 {
#define PG8_LAS __attribute__((address_space(3)))
typedef unsigned short bf16_t;
typedef short bf16x8 __attribute__((ext_vector_type(8)));
typedef float f32x4 __attribute__((ext_vector_type(4)));
typedef unsigned u32x4 __attribute__((ext_vector_type(4)));
constexpr int BM = 256, BK = 64, HALF = 128, HTB = HALF * BK * 2  , STAGE_BYTES = 8 * HTB, NXCD = 8, WGM = 4;

__host__ __device__ __forceinline__ int lds_byte(int r, int c) { const int st = (r >> 4) * 2 + (c >> 5), rr = r & 15, cc = c & 31, ob = rr * 64 + cc * 2; return st * 1024 + (ob ^ (((ob >> 9) & 1) << 5)); }
__host__ __device__ __forceinline__ void stage_rc(int b, int& R, int& C) { const int st = b / 1024, sb = b % 1024, swz = sb ^ (((sb >> 9) & 1) << 5); R = (st >> 1) * 16 + swz / 64; C = (st & 1) * 32 + (swz % 64) / 2; }
__host__ __device__ __forceinline__ int perm32(int rho) { const int n = rho >> 4, i = rho & 15; return 8 * (i >> 2) + 4 * n + (i & 3); }

struct Unit { int pm, pn; };
struct Gemm { const bf16_t* A; const bf16_t* Bt; int M, N, K; int gshift; size_t gstride; int glds; };

struct StaticOrder {
    int nM, nN, nwg, G, c;
    __host__ __device__ void init(int M, int N, int G_, int c_) { nM = M / BM; nN = N / BM; nwg = nM * nN; G = G_; c = c_; }
    __host__ __device__ bool next(int i, Unit& u) const {
        const long L = (long)i * G + c; if (L >= nwg) return false;
        int wgid = (int)L; { const int q = nwg / NXCD, r = nwg % NXCD, xcd = wgid % NXCD, off = wgid / NXCD; wgid = (xcd < r ? xcd * (q + 1) : r * (q + 1) + (xcd - r) * q) + off; }
        const int nig = WGM * nN, gid = wgid / nig, fm = gid * WGM, gsz = (nM - fm) < WGM ? (nM - fm) : WGM;
        u.pm = fm + ((wgid % nig) % gsz); u.pn = (wgid % nig) / gsz; return true;
    }
    __device__ __forceinline__ void a_ready(const Unit&) const {}
    __device__ __forceinline__ void done(const Unit&) const {}
};


typedef int i32x4 __attribute__((ext_vector_type(4)));
typedef int i32x8 __attribute__((ext_vector_type(8)));
__device__ __forceinline__ i32x8 cat8(bf16x8 a, bf16x8 b) { return __builtin_shufflevector(__builtin_bit_cast(i32x4, a), __builtin_bit_cast(i32x4, b), 0, 1, 2, 3, 4, 5, 6, 7); }
template <class Epi, class Sched, bool ALIGN_EPI = false, bool SP2 = false, bool GATHER = false, bool FP8 = false>
__device__ __forceinline__ void gemm_phase(PG8_LAS unsigned char* lds, const Gemm g, const Sched& S, const Epi& E) {
    const int tid = threadIdx.x, wid = __builtin_amdgcn_readfirstlane(tid >> 6), lane = tid & 63, wr = wid >> 2, wc = wid & 3, fr = lane & 15, fq = lane >> 4;
    const int K = g.K, nt = K / BK;
    unsigned voffA[2], voffB[2];
#pragma unroll
    for (int i = 0; i < 2; ++i) { int R, C; stage_rc(tid * 16 + i * 8192, R, C); const int Rb = Epi::PERM ? ((R & ~31) + perm32(R & 31)) : R;
        voffA[i] = (unsigned)(R * K + C) * 2u; voffB[i] = (unsigned)(Rb * K + C) * 2u; }
    unsigned vc0[2] = {0u, 0u}, vc1[2] = {0u, 0u}, vn0[2] = {0u, 0u}, vn1[2] = {0u, 0u}; int gR[2] = {0, 0}; unsigned gC2[2] = {0u, 0u};
    if constexpr (GATHER) {
#pragma unroll
        for (int i = 0; i < 2; ++i) { int R, C; stage_rc(tid * 16 + i * 8192, R, C); gR[i] = R; gC2[i] = (unsigned)C * 2u; } }
#define PG8_GATHER_OFFS(ui_, o0, o1) do { const PG8_LAS int* ip_ = (const PG8_LAS int*)(lds + g.glds) + (ui_) * 256; \
        _Pragma("unroll") for (int i_ = 0; i_ < 2; ++i_) { o0[i_] = (unsigned)ip_[gR[i_]] * (unsigned)(K * 2) + gC2[i_]; o1[i_] = (unsigned)ip_[128 + gR[i_]] * (unsigned)(K * 2) + gC2[i_]; } } while (0)
#define PG8_STAGE_A0(bufoff, gbase, nx) do { if constexpr (GATHER) { if (nx) PG8_STAGE(bufoff, gbase, vn0); else PG8_STAGE(bufoff, gbase, vc0); } else PG8_STAGE(bufoff, gbase, voffA); } while (0)
#define PG8_STAGE_A1(bufoff, gbase, nx) do { if constexpr (GATHER) { if (nx) PG8_STAGE(bufoff, gbase, vn1); else PG8_STAGE(bufoff, gbase, vc1); } else PG8_STAGE(bufoff, (gbase) + hstep, voffA); } while (0)
    const size_t kstep = (size_t)(BK * 2);
    const size_t hstep = (size_t)HALF * K * 2;
    const size_t tstep = 2 * hstep;
    const unsigned ldsw = (unsigned)wid * 1024u;
    const int aoff = lds_byte(wr * 64 + fr, fq * 8), boff = lds_byte(wc * 32 + fr, fq * 8);
#define PG8_SA(b, h) (((b) * 2 + (h)) * HTB)
#define PG8_SB(b, h) ((4 + (b) * 2 + (h)) * HTB)
#define PG8_STAGE(bufoff, gbase, voff) do { _Pragma("unroll") for (int _i = 0; _i < 2; ++_i) \
        __builtin_amdgcn_global_load_lds((const unsigned*)((const char*)(gbase) + (voff)[_i]), (PG8_LAS unsigned*)(lds + (bufoff) + ldsw + _i * 8192), 16, 0, 0); } while (0)
#define PG8_LDA(dst, b, h) do { _Pragma("unroll") for (int m = 0; m < 4; ++m) { dst[m].lo = *(const PG8_LAS i32x4*)(lds + PG8_SA(b, h) + aoff + m * 2048); dst[m].hi = *(const PG8_LAS i32x4*)(lds + PG8_SA(b, h) + aoff + m * 2048 + 1024); } } while (0)
#define PG8_LDB(dst, b, h) do { _Pragma("unroll") for (int n = 0; n < 2; ++n) { dst[n].lo = *(const PG8_LAS i32x4*)(lds + PG8_SB(b, h) + boff + n * 2048); dst[n].hi = *(const PG8_LAS i32x4*)(lds + PG8_SB(b, h) + boff + n * 2048 + 1024); } } while (0)
#define PG8_MMA(ai, bj, At, Bt) do { __builtin_amdgcn_s_setprio(1); _Pragma("unroll") for (int m = 0; m < 4; ++m) _Pragma("unroll") for (int n = 0; n < 2; ++n) { \
        if constexpr (FP8) asm volatile("v_mfma_scale_f32_16x16x128_f8f6f4 %0, %1, %2, %0, %3, %3 op_sel_hi:[0,0,0]" : "+v"(acc[ai][bj][m][n]) : "v"(Bt[n]), "v"(At[m]), "v"(sc1));   \
        else { acc[ai][bj][m][n] = __builtin_amdgcn_mfma_f32_16x16x32_bf16(__builtin_bit_cast(bf16x8, (i32x4)Bt[n].lo), __builtin_bit_cast(bf16x8, (i32x4)At[m].lo), acc[ai][bj][m][n], 0, 0, 0); \
               acc[ai][bj][m][n] = __builtin_amdgcn_mfma_f32_16x16x32_bf16(__builtin_bit_cast(bf16x8, (i32x4)Bt[n].hi), __builtin_bit_cast(bf16x8, (i32x4)At[m].hi), acc[ai][bj][m][n], 0, 0, 0); } } \
        __builtin_amdgcn_s_setprio(0); } while (0)
#define PG8_WAIT_V(n) asm volatile("s_waitcnt vmcnt(" #n ")" ::: "memory")
#define PG8_WAIT_L(n) asm volatile("s_waitcnt lgkmcnt(" #n ")" ::: "memory")
#define PG8_BAR __builtin_amdgcn_s_barrier()
#define PG8_SCHED __builtin_amdgcn_sched_barrier(0)
    Unit cur, nxt; int ui = 0;
    if (!S.next(0, cur)) return;
    f32x4 acc[2][2][4][2];
#pragma unroll
    for (int a = 0; a < 2; ++a)
#pragma unroll
        for (int b = 0; b < 2; ++b)
#pragma unroll
            for (int m = 0; m < 4; ++m)
#pragma unroll
                for (int n = 0; n < 2; ++n) acc[a][b][m][n] = (f32x4){0.f, 0.f, 0.f, 0.f};
    int sc1 = 0x7f7f7f7f; asm volatile("" : "+v"(sc1));
    i32x8 At[4], B0[2], B1[2];
    const char* cA = (const char*)g.A + (GATHER ? (size_t)0 : (size_t)cur.pm * tstep); if constexpr (GATHER) PG8_GATHER_OFFS(0, vc0, vc1);
    const char* cB = (const char*)g.Bt + (size_t)cur.pn * tstep + (size_t)(cur.pm >> g.gshift) * g.gstride;
    S.a_ready(cur);
    if constexpr (SP2) {
        PG8_STAGE(PG8_SB(0, 0), cB, voffB); PG8_STAGE(PG8_SB(0, 1), cB + hstep, voffB); PG8_STAGE_A0(PG8_SA(0, 0), cA, false); PG8_STAGE_A1(PG8_SA(0, 1), cA, false);
        if (wr == 1) PG8_BAR;
        PG8_WAIT_V(2); PG8_BAR;
        PG8_STAGE(PG8_SB(1, 0), cB + kstep, voffB); PG8_STAGE_A0(PG8_SA(1, 0), cA + kstep, false); PG8_STAGE(PG8_SB(1, 1), cB + hstep + kstep, voffB);
        PG8_WAIT_V(6); PG8_BAR;
    } else {
        PG8_STAGE(PG8_SB(0, 0), cB, voffB); PG8_STAGE(PG8_SA(0, 0), cA, voffA); PG8_STAGE(PG8_SB(0, 1), cB + hstep, voffB); PG8_STAGE(PG8_SA(0, 1), cA + hstep, voffA);
        if (wr == 1) PG8_BAR;
        PG8_WAIT_V(4); PG8_BAR;
        PG8_STAGE(PG8_SB(1, 0), cB + kstep, voffB); PG8_STAGE(PG8_SA(1, 0), cA + kstep, voffA); PG8_STAGE(PG8_SB(1, 1), cB + hstep + kstep, voffB);
        PG8_WAIT_V(6); PG8_BAR;
    }
    for (;;) {
        const bool has_next = S.next(ui + 1, nxt);
        const char* nA = (has_next && !GATHER) ? (const char*)g.A + (size_t)nxt.pm * tstep : cA;
        if constexpr (GATHER) { if (has_next) PG8_GATHER_OFFS(ui + 1, vn0, vn1); else { vn0[0] = vc0[0]; vn0[1] = vc0[1]; vn1[0] = vc1[0]; vn1[1] = vc1[1]; } } const char* nB = has_next ? (const char*)g.Bt + (size_t)nxt.pn * tstep + (size_t)(nxt.pm >> g.gshift) * g.gstride : cB;
        for (int t = 0; t < nt; t += 2) {
            const bool last = (t == nt - 2);
            const char* a1 = cA + (size_t)(t + 1) * kstep;
            const char* a2 = last ? nA : cA + (size_t)(t + 2) * kstep; const char* b2 = last ? nB : cB + (size_t)(t + 2) * kstep;
            const char* a3 = a2 + kstep; const char* b3 = b2 + kstep;
            if (last && has_next) S.a_ready(nxt);
            if constexpr (SP2) {
            PG8_LDB(B0, 0, 0); PG8_LDB(B1, 0, 1); PG8_SCHED; PG8_LDA(At, 0, 0); PG8_STAGE_A1(PG8_SA(1, 1), a1, false);
            PG8_WAIT_V(8); PG8_WAIT_L(0); PG8_BAR; PG8_MMA(0, 0, At, B0); PG8_MMA(0, 1, At, B1); PG8_BAR; PG8_SCHED;
            PG8_LDA(At, 0, 1); PG8_STAGE(PG8_SB(0, 0), b2, voffB); PG8_STAGE(PG8_SB(0, 1), b2 + hstep, voffB); PG8_STAGE_A0(PG8_SA(0, 0), a2, last);
            PG8_WAIT_V(8); PG8_WAIT_L(0); PG8_BAR; PG8_MMA(1, 0, At, B0); PG8_MMA(1, 1, At, B1); PG8_BAR; PG8_SCHED;
            PG8_LDB(B0, 1, 0); PG8_LDB(B1, 1, 1); PG8_SCHED; PG8_LDA(At, 1, 0); PG8_STAGE_A1(PG8_SA(0, 1), a2, last);
            PG8_WAIT_V(8); PG8_WAIT_L(0); PG8_BAR; PG8_MMA(0, 0, At, B0); PG8_MMA(0, 1, At, B1); PG8_BAR; PG8_SCHED;
            PG8_LDA(At, 1, 1); PG8_STAGE(PG8_SB(1, 0), b3, voffB); PG8_STAGE(PG8_SB(1, 1), b3 + hstep, voffB); PG8_STAGE_A0(PG8_SA(1, 0), a3, last);
            PG8_WAIT_V(8); PG8_WAIT_L(0); PG8_BAR; PG8_MMA(1, 0, At, B0); PG8_MMA(1, 1, At, B1); PG8_BAR; PG8_SCHED;
            } else {
            PG8_LDB(B0, 0, 0); PG8_SCHED; PG8_LDA(At, 0, 0); PG8_STAGE(PG8_SA(1, 1), a1 + hstep, voffA);
            PG8_WAIT_L(8); PG8_BAR; PG8_WAIT_L(0); PG8_MMA(0, 0, At, B0); PG8_BAR; PG8_SCHED;
            PG8_LDB(B1, 0, 1); PG8_STAGE(PG8_SB(0, 0), b2, voffB);
            PG8_BAR; PG8_WAIT_L(0); PG8_MMA(0, 1, At, B1); PG8_BAR;
            PG8_LDA(At, 0, 1); PG8_STAGE(PG8_SA(0, 0), a2, voffA);
            PG8_BAR; PG8_WAIT_L(0); PG8_MMA(1, 0, At, B0); PG8_BAR; PG8_SCHED;
            PG8_STAGE(PG8_SB(0, 1), b2 + hstep, voffB);
            PG8_WAIT_V(6); PG8_BAR; PG8_MMA(1, 1, At, B1); PG8_BAR;
            PG8_LDB(B0, 1, 0); PG8_SCHED; PG8_LDA(At, 1, 0); PG8_STAGE(PG8_SA(0, 1), a2 + hstep, voffA);
            PG8_WAIT_L(8); PG8_BAR; PG8_WAIT_L(0); PG8_MMA(0, 0, At, B0); PG8_BAR; PG8_SCHED;
            PG8_LDB(B1, 1, 1); PG8_STAGE(PG8_SB(1, 0), b3, voffB);
            PG8_BAR; PG8_WAIT_L(0); PG8_MMA(0, 1, At, B1); PG8_BAR;
            PG8_LDA(At, 1, 1); PG8_STAGE(PG8_SA(1, 0), a3, voffA);
            PG8_BAR; PG8_WAIT_L(0); PG8_MMA(1, 0, At, B0); PG8_BAR; PG8_SCHED;
            PG8_STAGE(PG8_SB(1, 1), b3 + hstep, voffB);
            PG8_WAIT_V(6); PG8_BAR; PG8_MMA(1, 1, At, B1); PG8_BAR;
            }
        }
        if constexpr (ALIGN_EPI) { if (wr == 0) PG8_BAR; }
        if constexpr (FP8) asm volatile("s_nop 15\n\ts_nop 15" ::: "memory");
        if constexpr (!Epi::AFTER_DRAIN) { E(acc, cur, wr, wc, fr, fq); S.done(cur); }
        if (!has_next) break;
#pragma unroll
        for (int a = 0; a < 2; ++a)
#pragma unroll
            for (int b = 0; b < 2; ++b)
#pragma unroll
                for (int m = 0; m < 4; ++m)
#pragma unroll
                    for (int n = 0; n < 2; ++n) acc[a][b][m][n] = (f32x4){0.f, 0.f, 0.f, 0.f};
        cur = nxt; cA = nA; cB = nB; ++ui;
        if constexpr (GATHER) { vc0[0] = vn0[0]; vc0[1] = vn0[1]; vc1[0] = vn1[0]; vc1[1] = vn1[1]; }
        if constexpr (ALIGN_EPI) { if (wr == 1) PG8_BAR; }
    }
    PG8_WAIT_V(0);
    if constexpr (!ALIGN_EPI) { if (wr == 0) PG8_BAR; }
    PG8_BAR;
    if constexpr (Epi::AFTER_DRAIN) { E.fused(acc, cur, wr, wc, fr, fq, lds, wid, lane); S.done(cur); }
#undef PG8_SA
#undef PG8_SB
#undef PG8_STAGE
#undef PG8_STAGE_A0
#undef PG8_STAGE_A1
#undef PG8_GATHER_OFFS
#undef PG8_LDA
#undef PG8_LDB
#undef PG8_MMA
#undef PG8_WAIT_V
#undef PG8_WAIT_L
#undef PG8_BAR
#undef PG8_SCHED
}
}

#define LAS __attribute__((address_space(3)))
typedef unsigned short bf16;
typedef unsigned u32x4 __attribute__((ext_vector_type(4)));
typedef unsigned u32x2 __attribute__((ext_vector_type(2)));
typedef float f32x4 __attribute__((ext_vector_type(4)));
typedef float f32x2 __attribute__((ext_vector_type(2)));

constexpr int NWAVES = 8, NTHR = 512;
constexpr int DM = 1024, NB = 2, SEQ = 8192, CTXL = 256;
constexpr int MROWS = NB * SEQ;
constexpr int MCTX = NB * CTXL;
constexpr int MTOT = MROWS + MCTX;
constexpr int NINC = 4096;
constexpr int NE = 16, CAP = 1024, FE = 2752, FEP = 2816, N1P = 5632;
constexpr int MEXP = NE * NB * CAP;
constexpr float RMS_EPS = 1e-6f;
constexpr int NPHASE = 12;
#ifndef PHMASK
#define PHMASK 0xFFF
#endif
#define PH_ON(k) ((PHMASK >> (k)) & 1)
#ifndef REPMASK
#define REPMASK 0x0
#endif
#define REP_ON(k) ((REPMASK >> (k)) & 1)
#ifndef MK_N_LAUNCHES
#define MK_N_LAUNCHES 1
#endif

constexpr size_t MiB = 1u << 20, KiB = 1u << 10;
constexpr size_t WS_CTL = 0, CTL_ZERO_BYTES = 64 * KiB;
constexpr size_t WS_MODP = 1 * MiB;
constexpr size_t WS_MODF = 1 * MiB + 640 * KiB;
constexpr size_t WS_LB = 1 * MiB + 768 * KiB;
constexpr size_t WS_COS = 1 * MiB + 800 * KiB;
constexpr size_t WS_SIN = 1 * MiB + 808 * KiB;
constexpr size_t WS_WRT = 1 * MiB + 832 * KiB;
constexpr size_t WS_AFF = 2 * MiB;
constexpr size_t WS_IDX = 3 * MiB;
constexpr size_t WS_GATEV = 3 * MiB + 256 * KiB;
constexpr size_t WS_SLOT = 4 * MiB;
constexpr size_t WS_H2 = 8 * MiB;
constexpr size_t WS_WINT = 72 * MiB;
constexpr size_t WS_WOUTT = 80 * MiB;
constexpr size_t WS_W1T = 82 * MiB;
constexpr size_t WS_W2T = 258 * MiB;
constexpr size_t WS_H = 346 * MiB;
constexpr size_t WS_QP = 379 * MiB;
constexpr size_t WS_QR = 395 * MiB;
constexpr size_t WS_KR = 411 * MiB;
constexpr size_t WS_V = 428 * MiB;
constexpr size_t WS_QH = 445 * MiB;
constexpr size_t WS_LFF = 462 * MiB;
constexpr size_t WS_LFB = 495 * MiB;
constexpr size_t WS_IH = 528 * MiB;
constexpr size_t WS_GH = 545 * MiB;
constexpr size_t WS_MIXIN = 561 * MiB;
constexpr size_t WS_HID = 346 * MiB;
constexpr size_t WS_MIX = 593 * MiB;
constexpr size_t WS_YS = 593 * MiB;
constexpr size_t WS_END = 657 * MiB;
static_assert(WS_HID + (size_t)MEXP * FEP * 2 <= WS_MIXIN + 32 * MiB, "hid overlay");
static_assert(WS_W1T + (size_t)NE * N1P * DM * 2 <= WS_W2T && WS_W2T + (size_t)NE * DM * FEP * 2 <= WS_H, "weights");

constexpr int CW_BAR = 4096;
constexpr int LDSCTL_BYTES = 512, LDS_BYTES = 155648;

#define LDS_WAIT() asm volatile("s_waitcnt lgkmcnt(0)" ::: "memory")
#define VM_WAIT() asm volatile("s_waitcnt vmcnt(0)" ::: "memory")
typedef __bf16 hwbf16x2 __attribute__((ext_vector_type(2)));
__device__ __forceinline__ unsigned pk2(float lo, float hi) { const hwbf16x2 v = {(__bf16)lo, (__bf16)hi}; return __builtin_bit_cast(unsigned, v); }
__device__ __forceinline__ unsigned f2bf(float f) { return pk2(f, 0.f) & 0xffffu; }
__device__ __forceinline__ float bf2f(unsigned h) { return __builtin_bit_cast(float, h << 16); }
__device__ __forceinline__ float bflo(unsigned w) { return __builtin_bit_cast(float, w << 16); }
__device__ __forceinline__ float bfhi(unsigned w) { return __builtin_bit_cast(float, w & 0xffff0000u); }
typedef _Float16 hwf16x2 __attribute__((ext_vector_type(2)));
__device__ __forceinline__ unsigned pkh2(float lo, float hi) { const hwf16x2 v = {(_Float16)lo, (_Float16)hi}; return __builtin_bit_cast(unsigned, v); }
__device__ __forceinline__ float h2f(unsigned h) { return (float)__builtin_bit_cast(_Float16, (unsigned short)h); }
template <int CTRL> __device__ __forceinline__ float dppf(float x) { return __builtin_bit_cast(float, __builtin_amdgcn_update_dpp(0, __builtin_bit_cast(int, x), CTRL, 0xF, 0xF, true)); }
__device__ __forceinline__ void swap16(unsigned& a, unsigned& b) { asm volatile("s_nop 1\n\tv_permlane16_swap_b32 %0, %1" : "+v"(a), "+v"(b)); }
__device__ __forceinline__ void swap32(unsigned& a, unsigned& b) { asm volatile("s_nop 1\n\tv_permlane32_swap_b32 %0, %1" : "+v"(a), "+v"(b)); }
template <int M> __device__ __forceinline__ float xadd(float x) {
    if constexpr (M == 1) return x + dppf<0xB1>(x);
    else if constexpr (M == 2) return x + dppf<0x4E>(x);
    else if constexpr (M == 4) return x + dppf<0x1B>(dppf<0x141>(x));
    else if constexpr (M == 8) return x + dppf<0x128>(x);
    else { unsigned a_ = __builtin_bit_cast(unsigned, x), b_ = a_; if constexpr (M == 16) swap16(a_, b_); else swap32(a_, b_); return __builtin_bit_cast(float, a_) + __builtin_bit_cast(float, b_); }
}
template <int M> __device__ __forceinline__ float xmax(float x) {
    if constexpr (M == 1) return fmaxf(x, dppf<0xB1>(x));
    else if constexpr (M == 2) return fmaxf(x, dppf<0x4E>(x));
    else if constexpr (M == 4) return fmaxf(x, dppf<0x1B>(dppf<0x141>(x)));
    else if constexpr (M == 8) return fmaxf(x, dppf<0x128>(x));
    else { unsigned a_ = __builtin_bit_cast(unsigned, x), b_ = a_; if constexpr (M == 16) swap16(a_, b_); else swap32(a_, b_); return fmaxf(__builtin_bit_cast(float, a_), __builtin_bit_cast(float, b_)); }
}
__device__ __forceinline__ float wave_sum(float v) { v = xadd<1>(v); v = xadd<2>(v); v = xadd<4>(v); v = xadd<8>(v); v = xadd<16>(v); v = xadd<32>(v); return v; }
__device__ __forceinline__ float wave_max(float v) { v = xmax<1>(v); v = xmax<2>(v); v = xmax<4>(v); v = xmax<8>(v); v = xmax<16>(v); v = xmax<32>(v); return v; }
__device__ __forceinline__ unsigned pk4_fp8(float a, float b, float c, float d) { int w = 0; w = __builtin_amdgcn_cvt_pk_fp8_f32(a, b, w, false); w = __builtin_amdgcn_cvt_pk_fp8_f32(c, d, w, true); return (unsigned)w; }
constexpr float W2_SCALE = 32.f, HID_SCALE = 8.f;
constexpr float W1_SCALE = 32.f, H2_SCALE = 4.f;
__device__ __forceinline__ float sigmoidf_(float x) { return __builtin_amdgcn_rcpf(1.0f + __expf(-x)); }

#define XB_TMO      128
#define XB_XCNT(j)  (256  + 64 * (j))
#define XB_XSUB(j)  (1280 + 64 * (j))
#define XB_XGEN(j)  (2304 + 64 * (j))
#define XB_TOP      3328
#define XB_TOPGEN   3392
#define XCD_BAR_WORDS 3456
#define XB_SPIN_CAP (1u << 20)
__device__ __forceinline__ unsigned xb_ld(unsigned* p)              { return __hip_atomic_load(p, __ATOMIC_RELAXED, __HIP_MEMORY_SCOPE_AGENT); }
__device__ __forceinline__ unsigned xb_add(unsigned* p, unsigned v) { return __hip_atomic_fetch_add(p, v, __ATOMIC_RELAXED, __HIP_MEMORY_SCOPE_AGENT); }
__device__ __forceinline__ unsigned xb_xcc_id() { return (unsigned)__builtin_amdgcn_s_getreg((3 << 11) | 20) & 0xFu; }
#define XB_SPIN(cond, bar) do { unsigned _sp = 0; while (cond) { __builtin_amdgcn_s_sleep(1); \
    if ((++_sp & 255u) == 0u) { if (xb_ld(&(bar)[XB_TMO])) break; if (_sp > XB_SPIN_CAP) { atomicAdd(&(bar)[XB_TMO], 1u); break; } } } } while (0)
struct XcdBarrier { unsigned* bar; unsigned x; volatile LAS unsigned* st; };
__device__ __forceinline__ XcdBarrier xcd_barrier_post(unsigned* bar, volatile LAS unsigned* st) {
    XcdBarrier b; b.bar = bar; b.x = xb_xcc_id(); b.st = st;
    if (threadIdx.x == 0) (void)xb_add(&bar[XB_XCNT(b.x)], 1u);
    return b;
}
#define XB_FLAG(j)  (3456 + (j))
__device__ __forceinline__ void xcd_barrier_complete(unsigned* bar, unsigned x, unsigned& nloc, unsigned& mask) {
    const unsigned G = gridDim.x * gridDim.y * gridDim.z;
    unsigned sum, mine, m, sp = 0u;
    for (;;) {
        sum = 0u; mine = 0u; m = 0u;
#pragma unroll
        for (unsigned j = 0; j < 16; ++j) { const unsigned c = xb_ld(&bar[XB_XCNT(j)]); sum += c; m |= (c > 0u) ? (1u << j) : 0u; mine = (j == x) ? c : mine; }
        if (sum == G) break;
        __builtin_amdgcn_s_sleep(1);
        if ((++sp & 255u) == 0u) { if (xb_ld(&bar[XB_TMO])) break; if (sp > XB_SPIN_CAP) { atomicAdd(&bar[XB_TMO], 1u); break; } }
    }
    nloc = mine > 0u ? mine : 1u; mask = m ? m : (1u << x);
}
__device__ __forceinline__ void xcd_barrier(const XcdBarrier& b) {
    asm volatile("s_waitcnt vmcnt(0)" ::: "memory");
    __syncthreads();
    if (threadIdx.x == 0) {
        unsigned* bar = b.bar;
        __builtin_amdgcn_s_waitcnt(0);
        asm volatile("buffer_inv sc1" ::: "memory");
        unsigned nloc = b.st[0], mask = b.st[1];
        if (nloc == 0u) { xcd_barrier_complete(bar, b.x, nloc, mask); b.st[0] = nloc; b.st[1] = mask; }
        const unsigned old = xb_add(&bar[XB_XSUB(b.x)], 1u);
        const unsigned gen = old / nloc;
        if (old + 1u == (gen + 1u) * nloc) {
            __builtin_amdgcn_fence(__ATOMIC_RELEASE, "agent");
            asm volatile("s_waitcnt vmcnt(0)" ::: "memory");
            __hip_atomic_store((unsigned char*)&bar[XB_FLAG(0)] + b.x, (unsigned char)(gen + 1u), __ATOMIC_RELAXED, __HIP_MEMORY_SCOPE_AGENT);
        }
        unsigned sp = 0u;
        for (;;) {
            u32x4 fa; bool ok = true;
            asm volatile("global_load_dwordx4 %0, %1, off sc1\n\ts_waitcnt vmcnt(0)" : "=&v"(fa) : "v"(&bar[XB_FLAG(0)]) : "memory");
            const unsigned fw[4] = {fa.x, fa.y, fa.z, fa.w};
#pragma unroll
            for (unsigned j = 0; j < 16; ++j) ok = ok && (((mask >> j) & 1u) == 0u || ((fw[j >> 2] >> (8u * (j & 3u))) & 0xFFu) >= gen + 1u);
            if (ok) break;
            __builtin_amdgcn_s_sleep(1);
            if ((++sp & 255u) == 0u) { if (xb_ld(&bar[XB_TMO])) break; if (sp > XB_SPIN_CAP) { atomicAdd(&bar[XB_TMO], 1u); break; } }
        }
        asm volatile("s_waitcnt vmcnt(0)" ::: "memory");
    }
    __syncthreads();
}

struct Args { const float* in[19]; float* out; unsigned char* ws; int ph_lo, ph_hi; };
enum { I_X = 0, I_C, I_CTX, I_CCTX, I_WMOD, I_BMOD, I_GPRE1, I_GPOST1, I_GPRE2, I_GPOST2, I_WIN, I_WOUT, I_RPB, I_LBL, I_HGN, I_WROUTER, I_WGATE, I_WUP, I_WDOWN };

struct Ctx {
    LAS unsigned char* lds; int tid, lane, wave, G;
    Args a; unsigned char* ws;
};
template <class T> __device__ __forceinline__ T* wsp(const Ctx& C, size_t off) { return (T*)(C.ws + off); }

constexpr int CV_T_IN = 8 * 32, CV_T_OUT = 8 * 8, CV_T_G = 8 * 22, CV_T_D = 22 * 8, CV_T_E = 2 * CV_T_G + CV_T_D, CV_NT = CV_T_IN + CV_T_OUT + NE * CV_T_E;
constexpr int CV_D2 = 1568;
constexpr int CV_P0_END = CV_T_IN + CV_T_OUT, CV_D1_END = CV_NT - CV_D2;
__device__ __forceinline__ void convert_tiles(const Ctx& C, int first, int last, int start, int stride) {
    const Args& a = C.a;
    int tid_ = C.tid; asm volatile("" : "+v"(tid_));
    constexpr int T_IN = CV_T_IN, T_OUT = CV_T_OUT, T_G = CV_T_G, T_E = CV_T_E;
    {
        LAS float* scr = (LAS float*)C.lds;
#define SCR(k_, n_) (*(const LAS float*)((const LAS unsigned char*)scr + (k_) * 512 + (((((n_) >> 2) ^ (k_) ^ ((k_) >> 4)) & 31) << 4) + ((n_) & 3) * 4))
        struct Item { const float* src; bf16* dst; int N, ldk, k0, n0, kval, nval, which; float f8scale; };
        auto decode = [&](int it, Item& I) {
            int r = it;
            if (r < T_IN) { I = Item{a.in[I_WIN], wsp<bf16>(C, WS_WINT), NINC, DM, 128 * (r >> 5), 128 * (r & 31), DM, NINC, -1, 0.f}; return; }
            r -= T_IN;
            if (r < T_OUT) { I = Item{a.in[I_WOUT], wsp<bf16>(C, WS_WOUTT), DM, DM, 128 * (r >> 3), 128 * (r & 7), DM, DM, -1, 0.f}; return; }
            r -= T_OUT;
            const int e = r / T_E; r %= T_E;
            if (r < 2 * T_G) { const int which = r / T_G; r %= T_G;
                I = Item{(which ? a.in[I_WUP] : a.in[I_WGATE]) + (size_t)e * DM * FE, (bf16*)(C.ws + WS_W1T + (size_t)e * N1P * DM), FE, DM, 128 * (r / 22), 128 * (r % 22), DM, FE, which, W1_SCALE}; return; }
            r -= 2 * T_G;
            I = Item{a.in[I_WDOWN] + (size_t)e * FE * DM, (bf16*)(C.ws + WS_W2T + (size_t)e * DM * FEP), DM, FEP, 128 * (r >> 3), 128 * (r & 7), FE, DM, -1, W2_SCALE};
        };
        auto loadt = [&](const Item& I, f32x4 (&v)[8]) {
#pragma unroll
            for (int i = 0; i < 8; ++i) { const int idx = tid_ + 512 * i, row = idx >> 5, c4 = idx & 31; const int k = I.k0 + row, n = I.n0 + 4 * c4;
                v[i] = (k < I.kval && n < I.nval) ? __builtin_nontemporal_load((const f32x4*)(I.src + (size_t)k * I.N + n)) : (f32x4){0.f, 0.f, 0.f, 0.f}; }
        };
        Item I0, I1; f32x4 v0[8], v1[8];
        int it = first + start;
        if (it < last) { decode(it, I0); loadt(I0, v0); }
        if (it + stride < last) { decode(it + stride, I1); loadt(I1, v1); }
        auto step = [&](Item& I, f32x4 (&v)[8], int itn) {
            __syncthreads();
#pragma unroll
            for (int i = 0; i < 8; ++i) { const int idx = tid_ + 512 * i, row = idx >> 5, c4 = idx & 31; *(LAS f32x4*)((LAS unsigned char*)scr + row * 512 + (((c4 ^ row ^ (row >> 4)) & 31) << 4)) = v[i]; }
            const Item cur = I;
            if (itn < last) { decode(itn, I); loadt(I, v); }
            __syncthreads();
            if (cur.f8scale != 0.f) {
#pragma unroll
                for (int i = 0; i < 2; ++i) { const int idx = tid_ + 512 * i, nl = idx >> 3, c = idx & 7; const float sc = cur.f8scale; float t[16];
#pragma unroll
                    for (int kk = 0; kk < 16; ++kk) { t[kk] = SCR(16 * c + kk, nl) * sc; if ((kk & 7) == 7) asm volatile("" ::: "memory"); }
                    u32x4 o;
                    o.x = pk4_fp8(t[0], t[1], t[2], t[3]); o.y = pk4_fp8(t[4], t[5], t[6], t[7]); o.z = pk4_fp8(t[8], t[9], t[10], t[11]); o.w = pk4_fp8(t[12], t[13], t[14], t[15]);
                    const int f = cur.n0 + nl; const int rowd = cur.which < 0 ? f : 32 * (f >> 4) + 16 * cur.which + (f & 15);
                    __builtin_nontemporal_store(o, (u32x4*)((unsigned char*)cur.dst + (size_t)rowd * cur.ldk + cur.k0 + 16 * c)); }
            } else {
#pragma unroll
                for (int i = 0; i < 4; ++i) { const int idx = tid_ + 512 * i, nl = idx >> 4, c = idx & 15;
                    u32x4 o; o.x = pk2(SCR(8 * c, nl), SCR(8 * c + 1, nl)); o.y = pk2(SCR(8 * c + 2, nl), SCR(8 * c + 3, nl)); o.z = pk2(SCR(8 * c + 4, nl), SCR(8 * c + 5, nl)); o.w = pk2(SCR(8 * c + 6, nl), SCR(8 * c + 7, nl));
                    const int f = cur.n0 + nl; const int rowd = cur.which < 0 ? f : 32 * (f >> 4) + 16 * cur.which + (f & 15);
                    *(u32x4*)(cur.dst + (size_t)rowd * cur.ldk + cur.k0 + 8 * c) = o; }
            }
        };
        for (; it < last; it += 2 * stride) { step(I0, v0, it + 2 * stride); if (it + stride < last) step(I1, v1, it + 3 * stride); }
#undef SCR
    }
}

__device__ __forceinline__ void convert_f8(const Ctx& C, int first, int last, int start, int stride) {
    const Args& a = C.a;
    int tid_ = C.tid; asm volatile("" : "+v"(tid_));
    LAS unsigned char* scr = (LAS unsigned char*)C.lds;
    struct Item { const float* src; unsigned char* dst; int N, ldk, k0, n0, kval, nval, which; };
    auto decode = [&](int it, Item& I) {
        int r = it - (CV_T_IN + CV_T_OUT);
        const int e = r / CV_T_E; r %= CV_T_E;
        if (r < 2 * CV_T_G) { const int which = r / CV_T_G; r %= CV_T_G;
            I = Item{(which ? a.in[I_WUP] : a.in[I_WGATE]) + (size_t)e * DM * FE, C.ws + WS_W1T + (size_t)e * N1P * DM, FE, DM, 128 * (r / 22), 128 * (r % 22), DM, FE, which}; }
        else { r -= 2 * CV_T_G; I = Item{a.in[I_WDOWN] + (size_t)e * FE * DM, C.ws + WS_W2T + (size_t)e * DM * FEP, DM, FEP, 128 * (r >> 3), 128 * (r & 7), FE, DM, -1}; }
    };
    const int lr = tid_ >> 5, c4 = tid_ & 31;
    auto loadt = [&](const Item& I, f32x4 (&v)[8]) {
        const float* p = I.src + (size_t)(I.k0 + lr) * I.N + I.n0 + 4 * c4; const size_t st = (size_t)16 * I.N;
        if (I.k0 + 128 <= I.kval && I.n0 + 128 <= I.nval) {
#pragma unroll
            for (int i = 0; i < 8; ++i) v[i] = __builtin_nontemporal_load((const f32x4*)(p + i * st));
        } else {
#pragma unroll
            for (int i = 0; i < 8; ++i) v[i] = (I.k0 + lr + 16 * i < I.kval && I.n0 + 4 * c4 < I.nval) ? __builtin_nontemporal_load((const f32x4*)(p + i * st)) : (f32x4){0.f, 0.f, 0.f, 0.f};
        }
    };
    Item I0, I1; f32x4 v0[8], v1[8];
    int it = first + start;
    if (it < last) { decode(it, I0); loadt(I0, v0); }
    if (it + stride < last) { decode(it + stride, I1); loadt(I1, v1); }
    auto step = [&](Item& I, f32x4 (&v)[8], int itn) {
        __syncthreads();
        { LAS unsigned char* wb = scr + lr * 512;
#pragma unroll
          for (int i = 0; i < 8; ++i) *(LAS f32x4*)(wb + i * 8192 + ((c4 << 4) ^ (32 * i))) = v[i]; }
        const Item cur = I;
        if (itn < last) { decode(itn, I); loadt(I, v); }
        __syncthreads();
        const float sc = cur.which < 0 ? W2_SCALE : W1_SCALE;
#pragma unroll
        for (int i = 0; i < 2; ++i) { const int idx = tid_ + 512 * i, nl = idx >> 3, c = idx & 7;
            const LAS unsigned char* rb = scr + c * 8192 + ((((nl >> 2) ^ (2 * c)) & 31) << 4) + (nl & 3) * 4;
            f32x2 t[8];
#pragma unroll
            for (int kk = 0; kk < 8; ++kk) t[kk] = (f32x2){*(const LAS float*)(rb + (2 * kk) * 512), *(const LAS float*)(rb + (2 * kk + 1) * 512)} * sc;
            u32x4 o;
            o.x = pk4_fp8(t[0].x, t[0].y, t[1].x, t[1].y); o.y = pk4_fp8(t[2].x, t[2].y, t[3].x, t[3].y); o.z = pk4_fp8(t[4].x, t[4].y, t[5].x, t[5].y); o.w = pk4_fp8(t[6].x, t[6].y, t[7].x, t[7].y);
            const int f = cur.n0 + nl; const int rowd = cur.which < 0 ? f : 32 * (f >> 4) + 16 * cur.which + (f & 15);
            __builtin_nontemporal_store(o, (u32x4*)(cur.dst + (size_t)rowd * cur.ldk + cur.k0 + 16 * c)); }
    };
    for (; it < last; it += 2 * stride) { step(I0, v0, it + 2 * stride); if (it + stride < last) step(I1, v1, it + 3 * stride); }
}

__device__ __forceinline__ void phase_prologue(const Ctx& C) {
    const Args& a = C.a;
    if (blockIdx.x < 192) {
        const int cc = blockIdx.x % 24, ks = blockIdx.x / 24;
        LAS float* sv = (LAS float*)C.lds;
        LAS float* red = sv + 384;
        if (C.tid < 384) { const int i = C.tid >> 7, k = C.tid & 127; const float cv = (i < 2) ? a.in[I_C][i * DM + ks * 128 + k] : a.in[I_CCTX][ks * 128 + k]; sv[C.tid] = cv / (1.0f + expf(-cv)); }
        __syncthreads();
        const int cl = C.tid & 255, col = cc * 256 + cl, kh = C.tid >> 8;
        float a0 = 0.f, a1 = 0.f, a2 = 0.f;
        const float* wp = a.in[I_WMOD] + (size_t)(ks * 128 + kh * 64) * 6144 + col;
#pragma unroll 8
        for (int kk = 0; kk < 64; ++kk) { const float w = __builtin_nontemporal_load(wp + (size_t)kk * 6144); const int k = kh * 64 + kk; a0 += sv[k] * w; a1 += sv[128 + k] * w; a2 += sv[256 + k] * w; }
        if (kh == 1) { red[cl] = a0; red[256 + cl] = a1; red[512 + cl] = a2; }
        __syncthreads();
        if (kh == 0) { float* mp = wsp<float>(C, WS_MODP) + (size_t)ks * 18432 + col; mp[0] = a0 + red[cl]; mp[6144] = a1 + red[256 + cl]; mp[12288] = a2 + red[512 + cl]; }
        __syncthreads();
    }
    if (blockIdx.x == 255 % C.G) {
        const float* lg = a.in[I_LBL]; float* lb = wsp<float>(C, WS_LB);
        if (C.tid < 512) { const float l0 = lg[C.tid], l1 = lg[512 + C.tid]; lb[C.tid] = 1.0f / (1.0f + expf(l1 - l0)); }
    }
    { const int nb = C.G >= 64 ? 8 : 1, b0 = C.G >= 64 ? C.G - 24 : 253 % C.G, wb = (int)blockIdx.x - b0;
      if (wb >= 0 && wb < nb) { float* wrt = wsp<float>(C, WS_WRT);
          for (int idx = wb * NTHR + C.tid; idx < 16384; idx += nb * NTHR) wrt[(idx & 15) * 1024 + (idx >> 4)] = a.in[I_WROUTER][idx]; } }
    { const int nb = C.G >= 64 ? 4 : 1, b0 = C.G >= 64 ? C.G - 16 : 254 % C.G, wb = (int)blockIdx.x - b0;
      if (wb >= 0 && wb < nb) { float* ct = wsp<float>(C, WS_COS); float* st = wsp<float>(C, WS_SIN);
          for (int idx = wb * NTHR + C.tid; idx < 2048; idx += nb * NTHR) { const int pos = idx >> 4, i = idx & 15; const float inv = powf(10000.0f, -(float)i / 16.0f); const float ang = (float)pos * inv; ct[idx] = cosf(ang); st[idx] = sinf(ang); } } }
    if (C.G == 256) {
        if (blockIdx.x < 192) convert_tiles(C, 0, 192, (int)blockIdx.x, 192); else convert_tiles(C, 192, CV_P0_END, (int)blockIdx.x - 192, 64);
    } else convert_tiles(C, 0, C.G > 32 ? CV_P0_END : CV_NT, (int)blockIdx.x, C.G);
}

__device__ __forceinline__ void phase_hrows(const Ctx& C) {
    const Args& a = C.a;
    const float* modp = wsp<float>(C, WS_MODP); const float* bmod = a.in[I_BMOD];
    { float* modf = wsp<float>(C, WS_MODF);
      for (int idx = blockIdx.x * NTHR + C.tid; idx < 18432; idx += C.G * NTHR) { float s = bmod[idx % 6144];
#pragma unroll
          for (int ks = 0; ks < 8; ++ks) s += modp[ks * 18432 + idx];
          modf[idx] = s; } }
    LAS float* sm = (LAS float*)C.lds;
    for (int j4 = C.tid; j4 < 1536; j4 += NTHR) { const int i = j4 >> 9, ci = (j4 & 511) * 4; f32x4 s = *(const f32x4*)(bmod + ci);
#pragma unroll
        for (int ks = 0; ks < 8; ++ks) s = s + *(const f32x4*)(modp + ks * 18432 + i * 6144 + ci);
        if (ci >= 1024) s = *(const f32x4*)(a.in[I_GPRE1] + ci - 1024) * (1.0f + s);
        *(LAS f32x4*)(sm + i * 2048 + ci) = s; }
    __syncthreads();
    const int gw = blockIdx.x * NWAVES + C.wave, NGW = C.G * NWAVES;
    bf16* H = wsp<bf16>(C, WS_H);
    auto load3 = [&](int row0, f32x4 (&v)[3][4]) {
#pragma unroll
        for (int r = 0; r < 3; ++r) { const int row = row0 + r; const float* src = row < MROWS ? a.in[I_X] + (size_t)row * DM : a.in[I_CTX] + (size_t)(row - MROWS) * DM;
#pragma unroll
            for (int j = 0; j < 4; ++j) v[r][j] = __builtin_nontemporal_load((const f32x4*)(src + 4 * (C.lane + 64 * j))); }
    };
    auto calc3 = [&](int row0, const f32x4 (&v)[3][4], u32x2 (&o)[3][4]) {
        float ss[3];
#pragma unroll
        for (int r = 0; r < 3; ++r) { float s_ = 0.f;
#pragma unroll
            for (int j = 0; j < 4; ++j) s_ += (v[r][j].x * v[r][j].x + v[r][j].y * v[r][j].y) + (v[r][j].z * v[r][j].z + v[r][j].w * v[r][j].w);
            ss[r] = s_; }
#pragma unroll
        for (int r = 0; r < 3; ++r) ss[r] = wave_sum(ss[r]);
#pragma unroll
        for (int r = 0; r < 3; ++r) { const int row = row0 + r; const int vi = row < MROWS ? (row >> 13) : 2; const float rstd = 1.0f / sqrtf(ss[r] * (1.0f / DM) + RMS_EPS);
#pragma unroll
            for (int j = 0; j < 4; ++j) { const int ch = 4 * (C.lane + 64 * j);
                const f32x4 sh = *(const LAS f32x4*)(sm + vi * 2048 + ch), gs = *(const LAS f32x4*)(sm + vi * 2048 + 1024 + ch);
                const f32x4 h = v[r][j] * rstd * gs + sh;
                o[r][j].x = pk2(h.x, h.y); o[r][j].y = pk2(h.z, h.w); } }
    };
    auto store3 = [&](int row0, const u32x2 (&o)[3][4]) {
#pragma unroll
        for (int r = 0; r < 3; ++r)
#pragma unroll
            for (int j = 0; j < 4; ++j) *(u32x2*)(H + (size_t)(row0 + r) * DM + 4 * (C.lane + 64 * j)) = o[r][j];
    };
    int row0 = 3 * gw;
    if (row0 < MTOT) {
        f32x4 v[3][4], vn[3][4]; u32x2 o[3][4];
        load3(row0, v);
        { const int rn = row0 + 3 * NGW < MTOT ? row0 + 3 * NGW : row0; load3(rn, vn); }
        calc3(row0, v, o);
        int prow = row0;
        for (row0 += 3 * NGW; row0 < MTOT; row0 += 3 * NGW) {
#pragma unroll
            for (int r = 0; r < 3; ++r)
#pragma unroll
                for (int j = 0; j < 4; ++j) v[r][j] = vn[r][j];
            store3(prow, o);
            { const int rn = row0 + 3 * NGW < MTOT ? row0 + 3 * NGW : row0; load3(rn, vn); }
            calc3(row0, v, o);
            prow = row0;
        }
        store3(prow, o);
    }
}

__device__ __forceinline__ void st_bf4(bf16* p, f32x4 v) { u32x2 o; o.x = pk2(v.x, v.y); o.y = pk2(v.z, v.w); *(u32x2*)p = o; }

__device__ __forceinline__ void st_bf8p(bf16* gb, int fq, f32x4 a, f32x4 b) {
    const unsigned a0 = pk2(a.x, a.y), a1 = pk2(a.z, a.w), b0 = pk2(b.x, b.y), b1 = pk2(b.z, b.w);
    const auto r0 = __builtin_amdgcn_permlane16_swap(a0, b0, false, false); const auto r1 = __builtin_amdgcn_permlane16_swap(a1, b1, false, false);
    *(u32x4*)(gb + 16 * (fq & 1) + 4 * (fq & 2)) = (u32x4){r0[0], r1[0], r0[1], r1[1]};
}
struct EpiIn {
    static constexpr bool PERM = false, AFTER_DRAIN = false;
    bf16 *QP, *QR, *KR, *V, *QH, *IH, *GH; unsigned short *LFF, *LFB; const LAS float *lb, *cosT, *sinT;
    __device__ __forceinline__ void operator()(const f32x4 (&acc)[2][2][4][2], const pg8::Unit& u, int wr, int wc, int fr, int fq) const {
        const int stream = u.pn >> 1; const bool isctx = u.pm >= 64;
        if (isctx && (stream == 0 || stream == 7)) return;
#pragma unroll
        for (int ai = 0; ai < 2; ++ai)
#pragma unroll
            for (int m = 0; m < 4; ++m) {
                const int row = u.pm * 256 + ai * 128 + wr * 64 + m * 16 + fr;
#pragma unroll
                for (int bj = 0; bj < 2; ++bj) {
                    const int cs = (u.pn & 1) * 256 + bj * 128 + wc * 32 + 4 * fq;
                    const f32x4 x1 = acc[ai][bj][m][0], x2 = acc[ai][bj][m][1];
                    const size_t o = (size_t)row * 512 + cs, ob = o - 4 * fq;
                    if (stream <= 1) {
                        const int t = row & 8191, pos = (wc & 1) ? (t & 63) : (t >> 6);
                        const f32x4 c4 = *(const LAS f32x4*)(cosT + pos * 16 + 4 * fq), s4 = *(const LAS f32x4*)(sinT + pos * 16 + 4 * fq);
                        const f32x4 r1 = x1 * c4 - x2 * s4, r2 = x1 * s4 + x2 * c4;
                        if (stream == 0) { constexpr float QS = 0.125f * 1.4426950408889634f;
                            st_bf8p(QP + ob, fq, x1 * QS, x2 * QS); st_bf8p(QR + ob, fq, r1 * QS, r2 * QS); }
                        else if (isctx) { st_bf8p(KR + ob, fq, x1, x2); }
                        else { st_bf8p(KR + ob, fq, r1, r2); }
                    } else if (stream == 2) { st_bf8p(V + ob, fq, x1, x2); }
                    else if (stream == 3) { st_bf8p(QH + ob, fq, x1, x2); }
                    else if (stream == 4 || stream == 5) {
                        unsigned short* LF = stream == 4 ? LFF : LFB;
                        const f32x4 l1 = *(const LAS f32x4*)(lb + cs), l2 = *(const LAS f32x4*)(lb + cs + 16);
                        f32x4 y1, y2;
#pragma unroll
                        for (int j = 0; j < 4; ++j) { y1[j] = __logf(l1[j] + (1.0f - l1[j]) * sigmoidf_(x1[j])); y2[j] = __logf(l2[j] + (1.0f - l2[j]) * sigmoidf_(x2[j])); }
                        { const unsigned a0 = pkh2(y1[0], y1[1]), a1 = pkh2(y1[2], y1[3]), b0 = pkh2(y2[0], y2[1]), b1 = pkh2(y2[2], y2[3]);
                          const auto r0 = __builtin_amdgcn_permlane16_swap(a0, b0, false, false); const auto r1 = __builtin_amdgcn_permlane16_swap(a1, b1, false, false);
                          *(u32x4*)(LF + ob + 16 * (fq & 1) + 4 * (fq & 2)) = (u32x4){r0[0], r1[0], r0[1], r1[1]}; }
                    } else if (stream == 6) { st_bf8p(IH + ob, fq, x1, x2); }
                    else { st_bf8p(GH + ob, fq, x1, x2); }
                }
            }
    }
};
struct EpiF32 {
    static constexpr bool PERM = false, AFTER_DRAIN = false;
    float* O; int ldc;
    __device__ __forceinline__ void operator()(const f32x4 (&acc)[2][2][4][2], const pg8::Unit& u, int wr, int wc, int fr, int fq) const {
#pragma unroll
        for (int ai = 0; ai < 2; ++ai)
#pragma unroll
            for (int m = 0; m < 4; ++m) { float* rp = O + (size_t)(u.pm * 256 + ai * 128 + wr * 64 + m * 16 + fr) * ldc + u.pn * 256 + wc * 32 + 4 * fq;
#pragma unroll
                for (int bj = 0; bj < 2; ++bj)
#pragma unroll
                    for (int n = 0; n < 2; ++n) *(f32x4*)(rp + bj * 128 + n * 16) = acc[ai][bj][m][n]; }
    }
};
struct EpiBf {
    static constexpr bool PERM = false, AFTER_DRAIN = false;
    bf16* O; int ldc;
    __device__ __forceinline__ void operator()(const f32x4 (&acc)[2][2][4][2], const pg8::Unit& u, int wr, int wc, int fr, int fq) const {
#pragma unroll
        for (int ai = 0; ai < 2; ++ai)
#pragma unroll
            for (int m = 0; m < 4; ++m) { bf16* rp = O + (size_t)(u.pm * 256 + ai * 128 + wr * 64 + m * 16 + fr) * ldc + u.pn * 256 + wc * 32 + 4 * fq;
#pragma unroll
                for (int bj = 0; bj < 2; ++bj)
                    st_bf8p(rp - 4 * fq + bj * 128, fq, acc[ai][bj][m][0], acc[ai][bj][m][1]); }
    }
};
struct EpiHid {
    static constexpr bool PERM = false, AFTER_DRAIN = false;
    unsigned char* HID;
    __device__ __forceinline__ void operator()(const f32x4 (&acc)[2][2][4][2], const pg8::Unit& u, int wr, int wc, int fr, int fq) const {
#pragma unroll
        for (int ai = 0; ai < 2; ++ai)
#pragma unroll
            for (int bj = 0; bj < 2; ++bj) {
                unsigned w[4];
#pragma unroll
                for (int m = 0; m < 4; ++m) { const f32x4 g = acc[ai][bj][m][0] * (1.0f / (W1_SCALE * H2_SCALE)), up = acc[ai][bj][m][1] * (HID_SCALE / (W1_SCALE * H2_SCALE)); f32x4 hv;
#pragma unroll
                    for (int j = 0; j < 4; ++j) hv[j] = __builtin_amdgcn_fmed3f(g[j] * sigmoidf_(g[j]) * up[j], -448.f, 448.f);
                    w[m] = pk4_fp8(hv[0], hv[1], hv[2], hv[3]); }
                const auto p02 = __builtin_amdgcn_permlane32_swap(w[0], w[2], false, false); const auto p13 = __builtin_amdgcn_permlane32_swap(w[1], w[3], false, false);
                const auto q01 = __builtin_amdgcn_permlane16_swap(p02[0], p13[0], false, false); const auto q23 = __builtin_amdgcn_permlane16_swap(p02[1], p13[1], false, false);
                unsigned char* rp = HID + (size_t)(u.pm * 256 + ai * 128 + wr * 64 + fq * 16 + fr) * FEP + u.pn * 128 + wc * 16 + bj * 64;
                *(u32x4*)rp = (u32x4){q01[0], q01[1], q23[0], q23[1]};
            }
    }
};
struct EpiYs {
    static constexpr bool PERM = false, AFTER_DRAIN = false;
    bf16* YS; const LAS float* gtab; mutable int ui;
    __device__ __forceinline__ void operator()(const f32x4 (&acc)[2][2][4][2], const pg8::Unit& u, int wr, int wc, int fr, int fq) const {
        const LAS float* gt = gtab + ui * 256; ++ui;
#pragma unroll
        for (int ai = 0; ai < 2; ++ai)
#pragma unroll
            for (int m = 0; m < 4; ++m) { const int lr = ai * 128 + wr * 64 + m * 16 + fr, row = u.pm * 256 + lr; const float gv = gt[lr];
                bf16* rp = YS + (size_t)row * DM + u.pn * 256 + wc * 32 + 4 * fq;
#pragma unroll
                for (int bj = 0; bj < 2; ++bj)
                    st_bf8p(rp - 4 * fq + bj * 128, fq, acc[ai][bj][m][0] * gv, acc[ai][bj][m][1] * gv); }
    }
};

typedef short bf16x8 __attribute__((ext_vector_type(8)));
typedef short s16x4 __attribute__((ext_vector_type(4)));
constexpr int NA_KW = 0, NA_VW = NA_KW + 5 * 64 * 128, NA_KC = NA_VW + 5 * 64 * 128, NA_VC = NA_KC + 256 * 128, NA_SB = NA_VC + 256 * 128, NA_END = NA_SB + 15 * 64 * 4;
static_assert(NA_END + LDSCTL_BYTES <= LDS_BYTES, "NA LDS map");
__device__ __forceinline__ int voff(int key, int c  ) { return (key >> 3) * 1024 + (c >> 1) * 256 + (key & 7) * 32 + (c & 1) * 16; }
__device__ __forceinline__ int kswz(int row, int chunk) { return row * 128 + ((chunk ^ (row & 7)) << 4); }
__device__ __forceinline__ s16x4 lds_tr16(const LAS unsigned char* p) { return __builtin_bit_cast(s16x4, __builtin_amdgcn_ds_read_tr16_b64_v4i16((LAS s16x4*)p)); }
__device__ __forceinline__ int clampi(int v, int lo, int hi) { return min(max(v, lo), hi); }
__device__ __forceinline__ bf16x8 pack8(f32x4 a, f32x4 b) { u32x4 w; w.x = pk2(a.x, a.y); w.y = pk2(a.z, a.w); w.z = pk2(b.x, b.y); w.w = pk2(b.z, b.w); return __builtin_bit_cast(bf16x8, w); }

__device__ __forceinline__ void phase_na(const Ctx& C) {
    const Args& a_ = C.a;
    const bf16 *QP = wsp<bf16>(C, WS_QP), *QR = wsp<bf16>(C, WS_QR), *KR = wsp<bf16>(C, WS_KR), *V = wsp<bf16>(C, WS_V);
    bf16* MIXIN = wsp<bf16>(C, WS_MIXIN); const float* rpb = a_.in[I_RPB];
    LAS unsigned char* L = C.lds; LAS float* sB = (LAS float*)(L + NA_SB);
    const int UPB = (1024 + C.G - 1) / C.G, u_lo = blockIdx.x * UPB, u_hi = min(1024, u_lo + UPB);
    const int q = C.lane & 15, g = C.lane >> 4;
    int cur_bh = -1;
    for (int u = u_lo; u < u_hi; ++u) {
        const int bh = u >> 6, b = bh >> 3, h = bh & 7, r = 2 * (u & 63);
        const int rlo = clampi(r - 4, 0, 120);
        const int rr = r + (C.wave >> 2), j = C.wave & 3;
        const int r0q = clampi(rr - 4, 0, 120), c0 = clampi(16 * j - 8, 0, 32), cq = 16 * j + q, wc0 = clampi(cq - 8, 0, 48);
        const size_t mq = (size_t)b * SEQ + rr * 64 + cq;
        const bf16x8 qr0 = __builtin_nontemporal_load((const bf16x8*)(QR + mq * 512 + h * 64 + 8 * g)), qr1 = __builtin_nontemporal_load((const bf16x8*)(QR + mq * 512 + h * 64 + 32 + 8 * g));
        const bf16x8 qp0 = __builtin_nontemporal_load((const bf16x8*)(QP + mq * 512 + h * 64 + 8 * g)), qp1 = __builtin_nontemporal_load((const bf16x8*)(QP + mq * 512 + h * 64 + 32 + 8 * g));
        float mrun = -INFINITY;
        f32x4 o[5];
        const bf16x8 ones = {(short)0x3F80, (short)0x3F80, (short)0x3F80, (short)0x3F80, (short)0x3F80, (short)0x3F80, (short)0x3F80, (short)0x3F80};
#pragma unroll
        for (int dt = 0; dt < 5; ++dt) o[dt] = (f32x4){0.f, 0.f, 0.f, 0.f};
        const int slot0 = r0q - rlo;
        const int kw = slot0 * 64 + c0 + 4 * g + (q >> 2);
        const LAS unsigned char* vwb = L + NA_VW + (kw >> 3) * 1024 + (kw & 7) * 32 + (q & 3) * 8;
        const LAS unsigned char* kwb0 = L + NA_KW + kswz(slot0 * 64 + c0 + q, g), *kwb1 = L + NA_KW + kswz(slot0 * 64 + c0 + q, 4 + g);
        const int kx = 4 * g + (q >> 2);
        const LAS unsigned char* vcb = L + NA_VC + (kx >> 3) * 1024 + (kx & 7) * 32 + (q & 3) * 8;
        const LAS unsigned char* kc0 = L + NA_KC + kswz(q, g), *kc1 = L + NA_KC + kswz(q, 4 + g);
        const LAS float* bl = sB + (r0q - rr + 7) * 64 + (c0 + 4 * g - cq + 15 + 16);
        const int kcl = c0 + 4 * g - wc0;
        __syncthreads();
        if (bh != cur_bh) {
            cur_bh = bh;
            { u32x4 tk[4], tv[4];
#pragma unroll
              for (int i = 0; i < 4; ++i) { const int idx = C.tid + NTHR * i, l = idx >> 3, c = idx & 7; const size_t row = (size_t)MROWS + b * CTXL + l;
                  tk[i] = *(const u32x4*)(KR + row * 512 + h * 64 + 8 * c); tv[i] = *(const u32x4*)(V + row * 512 + h * 64 + 8 * c); }
#pragma unroll
              for (int i = 0; i < 4; ++i) { const int idx = C.tid + NTHR * i, l = idx >> 3, c = idx & 7;
                  *(LAS u32x4*)(L + NA_KC + kswz(l, c)) = tk[i]; *(LAS u32x4*)(L + NA_VC + voff(l, c)) = tv[i]; } }
            for (int idx = C.tid; idx < 15 * 64; idx += NTHR) { const int dr = idx >> 6, dc = (idx & 63) - 16; sB[idx] = (dc >= 0 && dc < 31) ? rpb[(h * 15 + dr) * 31 + dc] * 1.4426950408889634f : 0.f; }
        }
#pragma unroll 1
        for (int grp = 0; grp < 2; ++grp) {
            if (grp == 1) __syncthreads();
            { const int row0 = rlo + 4 * grp;
              u32x4 tk[5], tv[5];
#pragma unroll
              for (int i = 0; i < 5; ++i) { const int idx = C.tid + NTHR * i, kidx = idx >> 3, c = idx & 7; const size_t tok = (size_t)b * SEQ + min(row0 * 64 + kidx, SEQ - 1);
                  tk[i] = *(const u32x4*)(KR + tok * 512 + h * 64 + 8 * c); tv[i] = *(const u32x4*)(V + tok * 512 + h * 64 + 8 * c); }
#pragma unroll
              for (int i = 0; i < 5; ++i) { const int idx = C.tid + NTHR * i, kidx = idx >> 3, c = idx & 7;
                  *(LAS u32x4*)(L + NA_KW + kswz(kidx, c)) = tk[i]; *(LAS u32x4*)(L + NA_VW + voff(kidx, c)) = tv[i]; } }
            __syncthreads();
            if (grp == 0) {
                f32x4 sc[16];
#pragma unroll
                for (int tt = 0; tt < 16; ++tt) {
                    const bf16x8 k0 = *(const LAS bf16x8*)(kc0 + 2048 * tt), k1 = *(const LAS bf16x8*)(kc1 + 2048 * tt);
                    f32x4 z = {0.f, 0.f, 0.f, 0.f}; z = __builtin_amdgcn_mfma_f32_16x16x32_bf16(k0, qp0, z, 0, 0, 0); sc[tt] = __builtin_amdgcn_mfma_f32_16x16x32_bf16(k1, qp1, z, 0, 0, 0); }
                float mx = -INFINITY;
#pragma unroll
                for (int tt = 0; tt < 16; ++tt)
#pragma unroll
                    for (int i = 0; i < 4; ++i) mx = fmaxf(mx, sc[tt][i]);
                mx = xmax<16>(mx); mx = xmax<32>(mx);
#pragma unroll
                for (int tt = 0; tt < 16; ++tt)
#pragma unroll
                    for (int i = 0; i < 4; ++i) sc[tt][i] = __builtin_amdgcn_exp2f(sc[tt][i] - mx);
                mrun = mx;
#pragma unroll
                for (int uu = 0; uu < 8; ++uu) { const bf16x8 pf = pack8(sc[2 * uu], sc[2 * uu + 1]);
                    o[4] = __builtin_amdgcn_mfma_f32_16x16x32_bf16(ones, pf, o[4], 0, 0, 0);
#pragma unroll
                    for (int dt = 0; dt < 4; ++dt) { const s16x4 lo = lds_tr16(vcb + uu * 4096 + dt * 256), hi = lds_tr16(vcb + uu * 4096 + 2048 + dt * 256);
                        const bf16x8 af = {lo[0], lo[1], lo[2], lo[3], hi[0], hi[1], hi[2], hi[3]}; o[dt] = __builtin_amdgcn_mfma_f32_16x16x32_bf16(af, pf, o[dt], 0, 0, 0); } }
            }
            f32x4 sw[8];
#pragma unroll
            for (int tt = 0; tt < 8; ++tt) { const int al = tt >> 1, cg = tt & 1;
                const bf16x8 k0 = *(const LAS bf16x8*)(kwb0 + (al * 64 + 16 * cg) * 128), k1 = *(const LAS bf16x8*)(kwb1 + (al * 64 + 16 * cg) * 128);
                f32x4 z = {0.f, 0.f, 0.f, 0.f}; z = __builtin_amdgcn_mfma_f32_16x16x32_bf16(k0, qr0, z, 0, 0, 0); sw[tt] = __builtin_amdgcn_mfma_f32_16x16x32_bf16(k1, qr1, z, 0, 0, 0); }
            float mx = mrun;
            const LAS float* blg = bl + grp * 256;
#pragma unroll
            for (int tt = 0; tt < 8; ++tt) { const int al = tt >> 1, cg = tt & 1;
#pragma unroll
                for (int i = 0; i < 4; ++i) { const unsigned rel = (unsigned)(kcl + 16 * cg + i); const float s = rel < 16u ? sw[tt][i] + blg[al * 64 + 16 * cg + i] : -INFINITY; sw[tt][i] = s; mx = fmaxf(mx, s); } }
            mx = xmax<16>(mx); mx = xmax<32>(mx);
            const float scale = __builtin_amdgcn_exp2f(mrun - mx); mrun = mx;
#pragma unroll
            for (int tt = 0; tt < 8; ++tt)
#pragma unroll
                for (int i = 0; i < 4; ++i) sw[tt][i] = __builtin_amdgcn_exp2f(sw[tt][i] - mx);
#pragma unroll
            for (int dt = 0; dt < 5; ++dt) o[dt] = o[dt] * scale;
#pragma unroll
            for (int al = 0; al < 4; ++al) { const bf16x8 pf = pack8(sw[2 * al], sw[2 * al + 1]);
                o[4] = __builtin_amdgcn_mfma_f32_16x16x32_bf16(ones, pf, o[4], 0, 0, 0);
#pragma unroll
                for (int dt = 0; dt < 4; ++dt) { const s16x4 lo = lds_tr16(vwb + al * 8192 + dt * 256), hi = lds_tr16(vwb + al * 8192 + 2048 + dt * 256);
                    const bf16x8 af = {lo[0], lo[1], lo[2], lo[3], hi[0], hi[1], hi[2], hi[3]}; o[dt] = __builtin_amdgcn_mfma_f32_16x16x32_bf16(af, pf, o[dt], 0, 0, 0); } }
        }
        const float inv = 1.0f / o[4][0];
#pragma unroll
        for (int dt = 0; dt < 4; ++dt) st_bf4(MIXIN + mq * DM + h * 64 + 16 * dt + 4 * g, o[dt] * inv);
    }
}

__device__ __forceinline__ int hg_row(int b, int dir, int c, int j) {
    const int tt = (c < 4 ? 64 * c : 64 * (c - 4)) + j;
    return c < 4 ? MROWS + b * CTXL + (dir ? 255 - tt : tt) : b * SEQ + (dir ? 8191 - tt : tt);
}

constexpr size_t WS_DSEG = 5 * MiB;
constexpr size_t WS_KVSEG = 8 * MiB;
constexpr size_t WS_SINS = 40 * MiB;
constexpr int HG_QD = 0, HG_KD = 16384, HG_KET = 32768, HG_VT = 49152, HG_AT = 65536, HG_ST = 73728, HG_DEC = 77824, HG_END = 78336;
__device__ __forceinline__ int off256(int row, int c) { return row * 256 + ((c ^ (row & 15)) << 4); }
__device__ __forceinline__ int off128(int row, int c) { return row * 128 + ((c ^ ((row >> 1) & 7)) << 4); }

struct HgRaw { unsigned lf[8], qv[8], vv[8]; };
template <bool FULL>
__device__ __forceinline__ void hg_load(const Ctx& C, int b, int h, int dir, int c, const unsigned short* LF, const bf16* QH, const bf16* IH, HgRaw& r) {
    const int cp = C.tid & 63, te = C.tid >> 6;
#pragma unroll
    for (int i = 0; i < 8; ++i) { const size_t o = (size_t)hg_row(b, dir, c, 8 * te + i) * 512 + h * 128 + 2 * cp;
        if (FULL) { r.lf[i] = __builtin_nontemporal_load((const unsigned*)(LF + o)); r.vv[i] = __builtin_nontemporal_load((const unsigned*)(IH + o)); r.qv[i] = __builtin_nontemporal_load((const unsigned*)(QH + o)); }
        else { r.lf[i] = *(const unsigned*)(LF + o); r.vv[i] = *(const unsigned*)(IH + o); r.qv[i] = 0u; } }
}
template <bool FULL>
__device__ __forceinline__ f32x2 hg_prep(const Ctx& C, const HgRaw& r) {
    LAS unsigned char* L = C.lds; LAS float* sT = (LAS float*)(L + HG_ST); LAS float* sDec = (LAS float*)(L + HG_DEC);
    const int cp = C.tid & 63, te = C.tid >> 6, c0 = 2 * cp;
    f32x2 bl[8], lfv[8]; f32x2 run = {0.f, 0.f};
#pragma unroll
    for (int i = 0; i < 8; ++i) { lfv[i] = (f32x2){h2f(r.lf[i] & 0xffffu), h2f(r.lf[i] >> 16)}; run = run + lfv[i]; bl[i] = run; }
    *(LAS f32x2*)(sT + te * 128 + c0) = run;
    __syncthreads();
    f32x2 off = {0.f, 0.f}, tot = {0.f, 0.f};
#pragma unroll
    for (int t = 0; t < 8; ++t) { const f32x2 x = *(const LAS f32x2*)(sT + t * 128 + c0); if (t < te) off = off + x; tot = tot + x; }
    unsigned ke0[4], ke1[4], vt0[4], vt1[4];
#pragma unroll
    for (int i = 0; i < 8; i += 2) {
        const f32x2 b0 = off + bl[i], b1 = off + bl[i + 1];
        const float k0x = 1.0f - __expf(lfv[i].x), k0y = 1.0f - __expf(lfv[i].y), k1x = 1.0f - __expf(lfv[i + 1].x), k1y = 1.0f - __expf(lfv[i + 1].y);
        ke0[i >> 1] = pk2(k0x * __expf(tot.x - b0.x), k1x * __expf(tot.x - b1.x));
        ke1[i >> 1] = pk2(k0y * __expf(tot.y - b0.y), k1y * __expf(tot.y - b1.y));
        vt0[i >> 1] = (r.vv[i] & 0xffffu) | (r.vv[i + 1] << 16);
        vt1[i >> 1] = (r.vv[i] >> 16) | (r.vv[i + 1] & 0xffff0000u);
        if (FULL) {
            const int t0 = 8 * te + i;
            *(LAS unsigned*)(L + HG_QD + off256(t0, c0 >> 3) + (c0 & 7) * 2) = pk2(bflo(r.qv[i]) * __expf(b0.x), bfhi(r.qv[i]) * __expf(b0.y));
            *(LAS unsigned*)(L + HG_QD + off256(t0 + 1, c0 >> 3) + (c0 & 7) * 2) = pk2(bflo(r.qv[i + 1]) * __expf(b1.x), bfhi(r.qv[i + 1]) * __expf(b1.y));
            *(LAS unsigned*)(L + HG_KD + off256(t0, c0 >> 3) + (c0 & 7) * 2) = pk2(k0x * __expf(-b0.x), k0y * __expf(-b0.y));
            *(LAS unsigned*)(L + HG_KD + off256(t0 + 1, c0 >> 3) + (c0 & 7) * 2) = pk2(k1x * __expf(-b1.x), k1y * __expf(-b1.y));
        }
    }
    *(LAS u32x4*)(L + HG_KET + off128(c0, te)) = (u32x4){ke0[0], ke0[1], ke0[2], ke0[3]};
    *(LAS u32x4*)(L + HG_KET + off128(c0 + 1, te)) = (u32x4){ke1[0], ke1[1], ke1[2], ke1[3]};
    *(LAS u32x4*)(L + HG_VT + off128(c0, te)) = (u32x4){vt0[0], vt0[1], vt0[2], vt0[3]};
    *(LAS u32x4*)(L + HG_VT + off128(c0 + 1, te)) = (u32x4){vt1[0], vt1[1], vt1[2], vt1[3]};
    if (te == 0) *(LAS f32x2*)(sDec + c0) = (f32x2){__expf(tot.x), __expf(tot.y)};
    return tot;
}
__device__ __forceinline__ void hg_update(const Ctx& C, f32x4 (&S)[8]) {
    LAS unsigned char* L = C.lds; const LAS float* sDec = (const LAS float*)(L + HG_DEC);
    const int q = C.lane & 15, g = C.lane >> 4, v0 = 16 * C.wave;
    const bf16x8 vb0 = *(const LAS bf16x8*)(L + HG_VT + off128(v0 + q, g)), vb1 = *(const LAS bf16x8*)(L + HG_VT + off128(v0 + q, 4 + g));
#pragma unroll
    for (int kt = 0; kt < 8; ++kt) { const f32x4 d4 = *(const LAS f32x4*)(sDec + 16 * kt + 4 * g); f32x4 acc = S[kt] * d4;
        const bf16x8 a0 = *(const LAS bf16x8*)(L + HG_KET + off128(16 * kt + q, g)), a1 = *(const LAS bf16x8*)(L + HG_KET + off128(16 * kt + q, 4 + g));
        acc = __builtin_amdgcn_mfma_f32_16x16x32_bf16(a0, vb0, acc, 0, 0, 0); S[kt] = __builtin_amdgcn_mfma_f32_16x16x32_bf16(a1, vb1, acc, 0, 0, 0); }
}

__device__ __forceinline__ void phase_hg_agg(const Ctx& C) {
    const unsigned short* LFF = wsp<unsigned short>(C, WS_LFF); const unsigned short* LFB = wsp<unsigned short>(C, WS_LFB); const bf16 *QH = wsp<bf16>(C, WS_QH), *IH = wsp<bf16>(C, WS_IH);
    float* DSEG = wsp<float>(C, WS_DSEG); float* KVSEG = wsp<float>(C, WS_KVSEG);
    const int UPB = (512 + C.G - 1) / C.G, u_lo = blockIdx.x * UPB, u_hi = min(512, u_lo + UPB);
    const int q = C.lane & 15, g = C.lane >> 4;
    const int nsteps = (u_hi - u_lo) * 4;
    HgRaw raw;
    if (nsteps > 0) { const int bhd = u_lo >> 5, seg = u_lo & 31; hg_load<false>(C, bhd >> 3, (bhd >> 1) & 3, bhd & 1, 4 * seg, (bhd & 1) ? LFB : LFF, QH, IH, raw); }
    f32x4 S[8]; f32x2 total = {0.f, 0.f};
#pragma unroll 1
    for (int t = 0; t < nsteps; ++t) {
        const int u = u_lo + (t >> 2), cc = t & 3;
        if (cc == 0) { total = (f32x2){0.f, 0.f};
#pragma unroll
            for (int kt = 0; kt < 8; ++kt) S[kt] = (f32x4){0.f, 0.f, 0.f, 0.f}; }
        total = total + hg_prep<false>(C, raw);
        if (t + 1 < nsteps) { const int un = u_lo + ((t + 1) >> 2), bhd = un >> 5, seg = un & 31; hg_load<false>(C, bhd >> 3, (bhd >> 1) & 3, bhd & 1, 4 * seg + ((t + 1) & 3), (bhd & 1) ? LFB : LFF, QH, IH, raw); }
        __syncthreads();
        hg_update(C, S);
        if (cc == 3) {
            if (C.tid < 64) *(f32x2*)(DSEG + (size_t)u * 128 + 2 * C.tid) = (f32x2){__expf(total.x), __expf(total.y)};
            u32x2* kv = (u32x2*)((bf16*)KVSEG + (size_t)u * 16384 + C.wave * 2048 + C.lane * 4);
#pragma unroll
            for (int kt = 0; kt < 8; ++kt) kv[kt * 64] = (u32x2){pk2(S[kt][0], S[kt][1]), pk2(S[kt][2], S[kt][3])};
        }
    }
}
__device__ __forceinline__ void phase_hg_scan(const Ctx& C) {
    const float* DSEG = wsp<float>(C, WS_DSEG); const bf16* KVSEG = wsp<bf16>(C, WS_KVSEG); bf16* SIN = wsp<bf16>(C, WS_SINS);
    for (int e2 = blockIdx.x * NTHR + C.tid; e2 < 16 * 8192; e2 += C.G * NTHR) {
        const int bhd = e2 >> 13, el = (e2 & 8191) * 2, k = 16 * ((el >> 8) & 7) + 4 * ((el >> 6) & 3) + (el & 3);
        const bf16* kv = KVSEG + (size_t)bhd * 32 * 16384 + el; const float* ds = DSEG + (size_t)bhd * 32 * 128 + k; bf16* so = SIN + (size_t)bhd * 32 * 16384 + el;
        const unsigned w0 = __builtin_nontemporal_load((const unsigned*)kv); f32x2 cur = {bflo(w0), bfhi(w0)}; *(unsigned*)so = w0;
        unsigned kvn[16]; f32x2 dn[16];
#pragma unroll 1
        for (int s0 = 1; s0 < 32; s0 += 16) {
#pragma unroll
            for (int i = 0; i < 16; ++i) { const int s = min(s0 + i, 31); kvn[i] = __builtin_nontemporal_load((const unsigned*)(kv + (size_t)s * 16384)); dn[i] = *(const f32x2*)(ds + s * 128); }
#pragma unroll
            for (int i = 0; i < 16; ++i) if (s0 + i < 32) { cur = dn[i] * cur + (f32x2){bflo(kvn[i]), bfhi(kvn[i])}; *(unsigned*)(so + (size_t)(s0 + i) * 16384) = pk2(cur.x, cur.y); }
        }
    }
}
constexpr int HG_OFS = HG_END;
constexpr int HG_OS = HG_QD;
static_assert(HG_OFS + 256 * 128 * 2 + LDSCTL_BYTES <= LDS_BYTES && 64 * 128 * 4 <= HG_KET, "hg_out LDS map");
__device__ __forceinline__ void phase_hg_out(const Ctx& C) {
    const Args& a = C.a;
    const unsigned short* LFF = wsp<unsigned short>(C, WS_LFF); const unsigned short* LFB = wsp<unsigned short>(C, WS_LFB); const bf16 *QH = wsp<bf16>(C, WS_QH), *IH = wsp<bf16>(C, WS_IH), *GH = wsp<bf16>(C, WS_GH);
    const float* SIN = wsp<float>(C, WS_SINS); const float* hgn = a.in[I_HGN]; bf16* MIXIN = wsp<bf16>(C, WS_MIXIN);
    LAS unsigned char* L = C.lds;
    const int UPB = (256 + C.G - 1) / C.G, u_lo = blockIdx.x * UPB, u_hi = min(256, u_lo + UPB);
    const int q = C.lane & 15, g = C.lane >> 4, v0 = 16 * C.wave;
    for (int u = u_lo; u < u_hi; ++u) {
        const int bh = u >> 5, ls = u & 31, b = bh >> 2, h = bh & 3;
        HgRaw raw;
        hg_load<true>(C, b, h, 0, 4 + 4 * ls, LFF, QH, IH, raw);
        f32x4 S[8];
        unsigned pw[8]; int pcc = -1;
        const f32x2 nn = *(const f32x2*)(hgn + 2 * C.lane);
#pragma unroll 1
        for (int step = 0; step < 8; ++step) {
            const int dir = step >> 2, cc = step & 3;
            {
                const int bhd = bh * 2 + dir, segl = dir ? 31 - ls : ls;
                if (cc == 0) { const u32x2* si = (const u32x2*)((const bf16*)SIN + ((size_t)bhd * 32 + segl) * 16384 + C.wave * 2048 + C.lane * 4);
#pragma unroll
                  for (int kt = 0; kt < 8; ++kt) { const u32x2 w = __builtin_nontemporal_load(si + kt * 64); S[kt] = (f32x4){bflo(w.x), bfhi(w.x), bflo(w.y), bfhi(w.y)}; } }
                (void)hg_prep<true>(C, raw);
                if (pcc >= 0) {
#pragma unroll
                    for (int jj = 0; jj < 8; ++jj) { const size_t row = (size_t)b * SEQ + 256 * ls + 255 - 64 * pcc - (8 * C.wave + jj); *(unsigned*)(MIXIN + row * DM + 512 + h * 128 + 2 * C.lane) = pw[jj]; }
                    pcc = -1; }
                if (step < 7) { const int dn = (step + 1) >> 2, sn = dn ? 31 - ls : ls; hg_load<true>(C, b, h, dn, 4 + 4 * sn + ((step + 1) & 3), dn ? LFB : LFF, QH, IH, raw); }
                __syncthreads();
#pragma unroll
                for (int t2 = 0; t2 < 2; ++t2) { const int id = 2 * C.wave + t2, st = id >> 2, jt = id & 3;
                    f32x4 acc = {0.f, 0.f, 0.f, 0.f};
                    if (st <= jt) {
#pragma unroll
                        for (int ks = 0; ks < 4; ++ks) { const bf16x8 ka = *(const LAS bf16x8*)(L + HG_KD + off256(16 * st + q, 4 * ks + g)), qb = *(const LAS bf16x8*)(L + HG_QD + off256(16 * jt + q, 4 * ks + g));
                            acc = __builtin_amdgcn_mfma_f32_16x16x32_bf16(ka, qb, acc, 0, 0, 0); }
#pragma unroll
                        for (int i = 0; i < 4; ++i) if (16 * st + 4 * g + i > 16 * jt + q) acc[i] = 0.f;
                    }
                    u32x2 w; w.x = pk2(acc[0], acc[1]); w.y = pk2(acc[2], acc[3]);
                    *(LAS u32x2*)(L + HG_AT + off128(16 * jt + q, 2 * st + (g >> 1)) + (g & 1) * 8) = w; }
                __syncthreads();
                f32x4 o[4];
#pragma unroll
                for (int jt = 0; jt < 4; ++jt) o[jt] = (f32x4){0.f, 0.f, 0.f, 0.f};
                { const bf16x8 vb0 = *(const LAS bf16x8*)(L + HG_VT + off128(v0 + q, g)), vb1 = *(const LAS bf16x8*)(L + HG_VT + off128(v0 + q, 4 + g));
#pragma unroll
                  for (int jt = 0; jt < 4; ++jt) { const bf16x8 a0 = *(const LAS bf16x8*)(L + HG_AT + off128(16 * jt + q, g)), a1 = *(const LAS bf16x8*)(L + HG_AT + off128(16 * jt + q, 4 + g));
                      o[jt] = __builtin_amdgcn_mfma_f32_16x16x32_bf16(a0, vb0, o[jt], 0, 0, 0); o[jt] = __builtin_amdgcn_mfma_f32_16x16x32_bf16(a1, vb1, o[jt], 0, 0, 0); } }
#pragma unroll
                for (int sp = 0; sp < 4; ++sp) { const bf16x8 sb = pack8(S[2 * sp], S[2 * sp + 1]);
#pragma unroll
                    for (int jt = 0; jt < 4; ++jt) { const int row = 16 * jt + q;
                        const s16x4 lo = *(const LAS s16x4*)(L + HG_QD + off256(row, 4 * sp + (g >> 1)) + (g & 1) * 8), hi = *(const LAS s16x4*)(L + HG_QD + off256(row, 4 * sp + 2 + (g >> 1)) + (g & 1) * 8);
                        const bf16x8 af = {lo[0], lo[1], lo[2], lo[3], hi[0], hi[1], hi[2], hi[3]};
                        o[jt] = __builtin_amdgcn_mfma_f32_16x16x32_bf16(af, sb, o[jt], 0, 0, 0); } }
                if (dir == 0) {
#pragma unroll
                    for (int jt = 0; jt < 4; ++jt)
#pragma unroll
                        for (int i = 0; i < 4; ++i) *(LAS unsigned short*)(L + HG_OFS + (64 * cc + 16 * jt + 4 * g + i) * 256 + (v0 + q) * 2) = (unsigned short)f2bf(o[jt][i]);
                    if (cc < 3) hg_update(C, S);
                } else {
                    unsigned gwp[8];
#pragma unroll
                    for (int jj = 0; jj < 8; ++jj) { const size_t row = (size_t)b * SEQ + 256 * ls + 255 - 64 * cc - (8 * C.wave + jj); gwp[jj] = __builtin_nontemporal_load((const unsigned*)(GH + row * 512 + h * 128 + 2 * C.lane)); }
#pragma unroll
                    for (int jt = 0; jt < 4; ++jt)
#pragma unroll
                        for (int i = 0; i < 4; ++i) o[jt][i] += bf2f(*(const LAS unsigned short*)(L + HG_OFS + (255 - 64 * cc - (16 * jt + 4 * g + i)) * 256 + (v0 + q) * 2));
                    if (cc < 3) hg_update(C, S);
                    __syncthreads();
#pragma unroll
                    for (int jt = 0; jt < 4; ++jt)
#pragma unroll
                        for (int i = 0; i < 4; ++i) *(LAS float*)(L + HG_OS + ((16 * jt + 4 * g + i) * 128 + v0 + q) * 4) = o[jt][i];
                    __syncthreads();
#pragma unroll
                    for (int jj = 0; jj < 8; ++jj) { const int j = 8 * C.wave + jj; const size_t row = (size_t)b * SEQ + 256 * ls + 255 - 64 * cc - j;
                        const f32x2 ov = *(const LAS f32x2*)(L + HG_OS + (j * 128 + 2 * C.lane) * 4);
                        const float rstd = 1.0f / sqrtf(wave_sum(ov.x * ov.x + ov.y * ov.y) * (1.0f / 128.0f) + RMS_EPS);
                        const unsigned gw2 = gwp[jj];
                        pw[jj] = pk2(ov.x * rstd * nn.x * sigmoidf_(bflo(gw2)), ov.y * rstd * nn.y * sigmoidf_(bfhi(gw2))); }
                    pcc = cc;
                }
            }
        }
        if (pcc >= 0) {
#pragma unroll
            for (int jj = 0; jj < 8; ++jj) { const size_t row = (size_t)b * SEQ + 256 * ls + 255 - 64 * pcc - (8 * C.wave + jj); *(unsigned*)(MIXIN + row * DM + 512 + h * 128 + 2 * C.lane) = pw[jj]; } }
    }
}

__device__ __forceinline__ void phase_rowpass(const Ctx& C) {
    const Args& a = C.a;
    LAS float* sW = (LAS float*)C.lds;
    LAS float* sC = sW + 16 * 1024;
    const float* modf = wsp<float>(C, WS_MODF);
    { const float* WRT = wsp<float>(C, WS_WRT);
#pragma unroll 4
      for (int i = 0; i < 8; ++i) { const int idx = C.tid + 512 * i; *(LAS f32x4*)(sW + 4 * idx) = *(const f32x4*)(WRT + 4 * idx); }
      for (int j4 = C.tid; j4 < 1536; j4 += NTHR) { const int bb = j4 / 768, rem = j4 % 768, wh = rem >> 8, ch = (rem & 255) * 4; const float* mf = modf + bb * 6144;
          f32x4 v;
          if (wh == 0) v = *(const f32x4*)(a.in[I_GPOST1] + ch) * *(const f32x4*)(mf + 2048 + ch);
          else if (wh == 1) v = *(const f32x4*)(a.in[I_GPRE2] + ch) * (1.0f + *(const f32x4*)(mf + 4096 + ch));
          else v = *(const f32x4*)(mf + 3072 + ch);
          *(LAS f32x4*)(sC + (bb * 3 + wh) * 1024 + ch) = v; } }
    __syncthreads();
    const bf16* MIX = wsp<bf16>(C, WS_MIX); bf16* X1B = wsp<bf16>(C, WS_MIXIN);
    float* AFF = wsp<float>(C, WS_AFF); unsigned char* H2 = C.ws + WS_H2;
    const int gw = blockIdx.x * NWAVES + C.wave, NGW = C.G * NWAVES;
    const int b5 = (C.lane >> 5) & 1, b4 = (C.lane >> 4) & 1, b3 = (C.lane >> 3) & 1, b2 = (C.lane >> 2) & 1, myexp = 8 * b5 + 4 * b4 + 2 * b3 + b2;
    if (2 * gw >= MROWS) return;
    f32x4 mx[2][4], xv[2][4], xvn[2][4]; u32x2 mxn[2][4], po[2][4]; unsigned ph[2][4]; float paff[2] = {0.f, 0.f};
    auto loadn = [&](int row0) {
#pragma unroll
        for (int r = 0; r < 2; ++r)
#pragma unroll
            for (int j = 0; j < 4; ++j) { const size_t o = (size_t)(row0 + r) * DM + 4 * (C.lane + 64 * j); mxn[r][j] = __builtin_nontemporal_load((const u32x2*)(MIX + o)); xvn[r][j] = __builtin_nontemporal_load((const f32x4*)(a.in[I_X] + o)); }
    };
    auto storep = [&](int row0) {
        const int b = row0 >> 13;
#pragma unroll
        for (int r = 0; r < 2; ++r) {
#pragma unroll
            for (int j = 0; j < 4; ++j) { const int ch = 4 * (C.lane + 64 * j); *(u32x2*)(X1B + (size_t)(row0 + r) * DM + ch) = po[r][j]; *(unsigned*)(H2 + (size_t)(row0 + r) * DM + ch) = ph[r][j]; }
            if ((C.lane & 3) == 0) AFF[((size_t)b * 16 + myexp) * SEQ + ((row0 + r) & 8191)] = paff[r]; }
    };
#pragma unroll
    for (int r = 0; r < 2; ++r)
#pragma unroll
        for (int j = 0; j < 4; ++j) { po[r][j] = (u32x2){0u, 0u}; ph[r][j] = 0u; }
    loadn(2 * gw);
    int prow = 2 * gw;
    for (int row0 = 2 * gw; row0 < MROWS; row0 += 2 * NGW) {
        const int b = row0 >> 13; const LAS float* cc = sC + b * 3072;
        float ss[2];
#pragma unroll
        for (int r = 0; r < 2; ++r) { ss[r] = 0.f;
#pragma unroll
            for (int j = 0; j < 4; ++j) { mx[r][j] = (f32x4){bflo(mxn[r][j].x), bfhi(mxn[r][j].x), bflo(mxn[r][j].y), bfhi(mxn[r][j].y)}; xv[r][j] = xvn[r][j]; } }
        storep(prow); prow = row0;
        loadn(row0 + 2 * NGW < MROWS ? row0 + 2 * NGW : row0);
#pragma unroll
        for (int r = 0; r < 2; ++r)
#pragma unroll
            for (int j = 0; j < 4; ++j) ss[r] += (mx[r][j].x * mx[r][j].x + mx[r][j].y * mx[r][j].y) + (mx[r][j].z * mx[r][j].z + mx[r][j].w * mx[r][j].w);
        ss[0] = wave_sum(ss[0]); ss[1] = wave_sum(ss[1]);
        float ss2[2] = {0.f, 0.f};
#pragma unroll
        for (int j = 0; j < 4; ++j) { const int ch = 4 * (C.lane + 64 * j); const f32x4 c1 = *(const LAS f32x4*)(cc + ch);
#pragma unroll
            for (int r = 0; r < 2; ++r) { const float rstd1 = 1.0f / sqrtf(ss[r] * (1.0f / DM) + RMS_EPS);
                xv[r][j] = xv[r][j] + c1 * (mx[r][j] * rstd1); po[r][j] = (u32x2){pk2(xv[r][j].x, xv[r][j].y), pk2(xv[r][j].z, xv[r][j].w)};
                ss2[r] += (xv[r][j].x * xv[r][j].x + xv[r][j].y * xv[r][j].y) + (xv[r][j].z * xv[r][j].z + xv[r][j].w * xv[r][j].w); } }
        ss2[0] = wave_sum(ss2[0]); ss2[1] = wave_sum(ss2[1]);
#pragma unroll
        for (int j = 0; j < 4; ++j) { const int ch = 4 * (C.lane + 64 * j); const f32x4 c2 = *(const LAS f32x4*)(cc + 1024 + ch), sh = *(const LAS f32x4*)(cc + 2048 + ch);
#pragma unroll
            for (int r = 0; r < 2; ++r) { const float rstd2 = 1.0f / sqrtf(ss2[r] * (1.0f / DM) + RMS_EPS);
                xv[r][j] = xv[r][j] * (rstd2 * c2) + sh; ph[r][j] = pk4_fp8(xv[r][j].x * H2_SCALE, xv[r][j].y * H2_SCALE, xv[r][j].z * H2_SCALE, xv[r][j].w * H2_SCALE); } }
#pragma unroll
        for (int r = 0; r < 2; ++r) {
            float lg[16];
#pragma unroll
            for (int e = 0; e < 16; ++e) { float p = 0.f;
#pragma unroll
                for (int j = 0; j < 4; ++j) { const f32x4 w = *(const LAS f32x4*)(sW + e * 1024 + 4 * (C.lane + 64 * j)); const f32x4 h = xv[r][j]; p += (h.x * w.x + h.y * w.y) + (h.z * w.z + h.w * w.w); }
                lg[e] = p; if ((e & 3) == 3) asm volatile("" ::: "memory"); }
            float l8[8], l4[4], l2[2], l1;
#pragma unroll
            for (int e = 0; e < 8; ++e) { unsigned a_ = __builtin_bit_cast(unsigned, lg[e]), b_ = __builtin_bit_cast(unsigned, lg[e + 8]); swap32(a_, b_);
                l8[e] = __builtin_bit_cast(float, a_) + __builtin_bit_cast(float, b_); }
#pragma unroll
            for (int e = 0; e < 4; ++e) { unsigned a_ = __builtin_bit_cast(unsigned, l8[e]), b_ = __builtin_bit_cast(unsigned, l8[e + 4]); swap16(a_, b_);
                l4[e] = __builtin_bit_cast(float, a_) + __builtin_bit_cast(float, b_); }
#pragma unroll
            for (int e = 0; e < 2; ++e) { const float keep = b3 ? l4[e + 2] : l4[e], send = b3 ? l4[e] : l4[e + 2]; l2[e] = keep + dppf<0x128>(send); }
            { const float keep = b2 ? l2[1] : l2[0], send = b2 ? l2[0] : l2[1]; l1 = keep + dppf<0x1B>(dppf<0x141>(send)); }
            l1 = xadd<2>(l1); l1 = xadd<1>(l1);
            float mxl = l1;
            mxl = xmax<4>(mxl); mxl = xmax<8>(mxl); mxl = xmax<16>(mxl); mxl = xmax<32>(mxl);
            const float p = expf(l1 - mxl); float den = p;
            den = xadd<4>(den); den = xadd<8>(den); den = xadd<16>(den); den = xadd<32>(den);
            paff[r] = p / den;
        }
    }
    storep(prow);
}

__device__ __forceinline__ void phase_topk(const Ctx& C) {
    if (blockIdx.x >= 32) { convert_f8(C, CV_D1_END, CV_NT, (int)blockIdx.x - 32, C.G - 32); return; }
    const int list = blockIdx.x, b = list >> 4, e = list & 15;
    LAS unsigned* keys = (LAS unsigned*)C.lds;
    LAS unsigned* hist = keys + 8192;
    volatile LAS unsigned* misc = hist + 256;
    LAS unsigned* wtot = hist + 256 + 8;
    const float* AFF = wsp<float>(C, WS_AFF) + (size_t)list * SEQ;
#pragma unroll
    for (int i = 0; i < 4; ++i) *(LAS u32x4*)(keys + 4 * (C.tid + 512 * i)) = *(const u32x4*)(AFF + 4 * (C.tid + 512 * i));
    if (C.tid == 0) { misc[0] = 0u; misc[1] = (unsigned)CAP; }
    __syncthreads();
    unsigned prefix = 0u, mask = 0u;
    for (int pass = 3; pass >= 0; --pass) {
        if (C.tid < 256) hist[C.tid] = 0u;
        __syncthreads();
#pragma unroll
        for (int i = 0; i < 16; ++i) { const unsigned key = keys[C.tid + 512 * i]; if ((key & mask) == prefix) atomicAdd((unsigned*)&hist[(key >> (8 * pass)) & 255u], 1u); }
        __syncthreads();
        if (C.wave == 0) {
            const u32x4 h4 = *(const LAS u32x4*)(hist + 4 * C.lane); const unsigned s = h4.x + h4.y + h4.z + h4.w; unsigned inc = s;
#pragma unroll
            for (int o = 1; o < 64; o <<= 1) { const unsigned t = __shfl_down(inc, o); if (C.lane + o < 64) inc += t; }
            const unsigned need = misc[1]; unsigned cum = inc - s;
            int chosen = -1; unsigned nn = 0u;
            if (cum < need && need <= cum + h4.w) { chosen = 4 * C.lane + 3; nn = need - cum; } cum += h4.w;
            if (cum < need && need <= cum + h4.z) { chosen = 4 * C.lane + 2; nn = need - cum; } cum += h4.z;
            if (cum < need && need <= cum + h4.y) { chosen = 4 * C.lane + 1; nn = need - cum; } cum += h4.y;
            if (cum < need && need <= cum + h4.x) { chosen = 4 * C.lane + 0; nn = need - cum; }
            if (chosen >= 0) { misc[0] = prefix | ((unsigned)chosen << (8 * pass)); misc[1] = nn; }
        }
        __syncthreads();
        prefix = misc[0]; mask |= 0xFFu << (8 * pass);
    }
    const unsigned T = prefix, need_eq = misc[1];
    const int base = C.tid * 16; unsigned cgt = 0u, ceq = 0u; unsigned kk[16];
#pragma unroll
    for (int i = 0; i < 4; ++i) { const u32x4 k4 = *(const LAS u32x4*)(keys + base + 4 * i); kk[4 * i] = k4.x; kk[4 * i + 1] = k4.y; kk[4 * i + 2] = k4.z; kk[4 * i + 3] = k4.w; }
#pragma unroll
    for (int i = 0; i < 16; ++i) { cgt += kk[i] > T ? 1u : 0u; ceq += kk[i] == T ? 1u : 0u; }
    unsigned ig = cgt, ie = ceq;
#pragma unroll
    for (int o = 1; o < 64; o <<= 1) { const unsigned tg = __shfl_up(ig, o), te = __shfl_up(ie, o); if (C.lane >= o) { ig += tg; ie += te; } }
    if (C.lane == 63) { wtot[C.wave] = ig; wtot[8 + C.wave] = ie; }
    __syncthreads();
    unsigned gpre = ig - cgt, epre = ie - ceq;
    for (int w = 0; w < C.wave; ++w) { gpre += wtot[w]; epre += wtot[8 + w]; }
    int* IDX = wsp<int>(C, WS_IDX) + list * CAP; float* GATEV = wsp<float>(C, WS_GATEV) + (e * 2 + b) * CAP; int* SLOT = wsp<int>(C, WS_SLOT);
#pragma unroll
    for (int i = 0; i < 16; ++i) { const int t = base + i; const unsigned key = kk[i]; int pos = -1;
        if (key > T) { pos = (int)(gpre + min(epre, need_eq)); ++gpre; }
        else if (key == T) { if (epre < need_eq) pos = (int)(gpre + epre); ++epre; }
        if (pos >= 0) { IDX[pos] = t; GATEV[pos] = __builtin_bit_cast(float, key); }
        SLOT[((size_t)b * SEQ + t) * 16 + e] = pos; }
}

__device__ __forceinline__ void phase_final(const Ctx& C) {
    const Args& a = C.a;
    const int gw = blockIdx.x * NWAVES + C.wave, NGW = C.G * NWAVES;
    const int* SLOT = wsp<int>(C, WS_SLOT); const bf16* YS = wsp<bf16>(C, WS_YS); const float* modf = wsp<float>(C, WS_MODF);
    LAS float* sG = (LAS float*)C.lds;
    for (int j4 = C.tid; j4 < 512; j4 += NTHR) { const int bb = j4 >> 8, ch = (j4 & 255) * 4; *(LAS f32x4*)(sG + bb * 1024 + ch) = *(const f32x4*)(a.in[I_GPOST2] + ch) * *(const f32x4*)(modf + bb * 6144 + 5120 + ch); }
    __syncthreads();
    if (gw >= MROWS) return;
    const int rlast = gw + ((MROWS - 1 - gw) / NGW) * NGW;
    auto pair = [&](int sv, int b, const bf16*& y0, const bf16*& y1, float& f0, float& f1, unsigned long long& rest) {
        unsigned long long m = __ballot(sv >= 0) & 0xFFFFull;
        const bool any = m != 0ull; const int e0 = any ? __builtin_ctzll(m) : 0; m &= m - 1;
        const bool two = m != 0ull; const int e1 = two ? __builtin_ctzll(m) : e0; m &= m - 1;
        const int s0 = any ? __builtin_amdgcn_readlane(sv, e0) : 0, s1 = two ? __builtin_amdgcn_readlane(sv, e1) : s0;
        y0 = YS + ((size_t)(e0 * 2 + b) * CAP + s0) * DM; y1 = YS + ((size_t)(e1 * 2 + b) * CAP + s1) * DM;
        f0 = any ? 1.f : 0.f; f1 = two ? 1.f : 0.f; rest = m;
    };
    int svA = SLOT[(size_t)gw * 16 + (C.lane & 15)];
    int svB = SLOT[(size_t)min(gw + NGW, rlast) * 16 + (C.lane & 15)];
    f32x4 po[4]; u32x2 x1n[4], w0n[4], w1n[4]; const bf16* X1B = wsp<bf16>(C, WS_MIXIN);
#pragma unroll
    for (int j = 0; j < 4; ++j) { x1n[j] = *(const u32x2*)(X1B + (size_t)gw * DM + 4 * (C.lane + 64 * j)); po[j] = (f32x4){0.f, 0.f, 0.f, 0.f}; }
    { const bf16 *y0, *y1; float f0, f1; unsigned long long rest; pair(svA, gw >> 13, y0, y1, f0, f1, rest);
#pragma unroll
      for (int j = 0; j < 4; ++j) { w0n[j] = *(const u32x2*)(y0 + 4 * (C.lane + 64 * j)); w1n[j] = *(const u32x2*)(y1 + 4 * (C.lane + 64 * j)); } }
    int prow = gw;
    for (int row = gw; row < MROWS; row += NGW) {
        const int b = row >> 13;
        const int sv = svA;
        f32x4 x1[4]; u32x2 w0[4], w1[4];
#pragma unroll
        for (int j = 0; j < 4; ++j) { x1[j] = (f32x4){bflo(x1n[j].x), bfhi(x1n[j].x), bflo(x1n[j].y), bfhi(x1n[j].y)}; w0[j] = w0n[j]; w1[j] = w1n[j]; }
#pragma unroll
        for (int j = 0; j < 4; ++j) *(f32x4*)(a.out + (size_t)prow * DM + 4 * (C.lane + 64 * j)) = po[j];
        prow = row;
        { const int rn = min(row + NGW, rlast), rnn = min(row + 2 * NGW, rlast);
          svA = svB;
          svB = SLOT[(size_t)rnn * 16 + (C.lane & 15)];
#pragma unroll
          for (int j = 0; j < 4; ++j) x1n[j] = *(const u32x2*)(X1B + (size_t)rn * DM + 4 * (C.lane + 64 * j));
          const bf16 *y0, *y1; float f0, f1; unsigned long long rest; pair(svA, rn >> 13, y0, y1, f0, f1, rest);
#pragma unroll
          for (int j = 0; j < 4; ++j) { w0n[j] = *(const u32x2*)(y0 + 4 * (C.lane + 64 * j)); w1n[j] = *(const u32x2*)(y1 + 4 * (C.lane + 64 * j)); } }
        f32x4 acc[4];
        unsigned long long mask;
        { const bf16 *y0, *y1; float f0, f1; pair(sv, b, y0, y1, f0, f1, mask);
#pragma unroll
          for (int j = 0; j < 4; ++j) { acc[j].x = f0 * bflo(w0[j].x) + f1 * bflo(w1[j].x); acc[j].y = f0 * bfhi(w0[j].x) + f1 * bfhi(w1[j].x); acc[j].z = f0 * bflo(w0[j].y) + f1 * bflo(w1[j].y); acc[j].w = f0 * bfhi(w0[j].y) + f1 * bfhi(w1[j].y); } }
        while (mask) {
            const int e0 = __builtin_ctzll(mask); mask &= mask - 1; const bool two = mask != 0ull; const int e1 = two ? __builtin_ctzll(mask) : e0; mask &= mask - 1;
            const bf16* y0 = YS + ((size_t)(e0 * 2 + b) * CAP + __builtin_amdgcn_readlane(sv, e0)) * DM; const bf16* y1 = YS + ((size_t)(e1 * 2 + b) * CAP + __builtin_amdgcn_readlane(sv, e1)) * DM;
            u32x2 v0[4], v1[4];
#pragma unroll
            for (int j = 0; j < 4; ++j) { v0[j] = *(const u32x2*)(y0 + 4 * (C.lane + 64 * j)); v1[j] = *(const u32x2*)(y1 + 4 * (C.lane + 64 * j)); }
            const float f1 = two ? 1.f : 0.f;
#pragma unroll
            for (int j = 0; j < 4; ++j) { acc[j].x += bflo(v0[j].x) + f1 * bflo(v1[j].x); acc[j].y += bfhi(v0[j].x) + f1 * bfhi(v1[j].x); acc[j].z += bflo(v0[j].y) + f1 * bflo(v1[j].y); acc[j].w += bfhi(v0[j].y) + f1 * bfhi(v1[j].y); } }
        float ss = 0.f;
#pragma unroll
        for (int j = 0; j < 4; ++j) ss += (acc[j].x * acc[j].x + acc[j].y * acc[j].y) + (acc[j].z * acc[j].z + acc[j].w * acc[j].w);
        const float rstd = 1.0f / sqrtf(wave_sum(ss) * (1.0f / DM) + RMS_EPS);
#pragma unroll
        for (int j = 0; j < 4; ++j) { const int ch = 4 * (C.lane + 64 * j);
            const f32x4 gg = *(const LAS f32x4*)(sG + b * 1024 + ch);
            po[j] = x1[j] + gg * (acc[j] * rstd); }
    }
#pragma unroll
    for (int j = 0; j < 4; ++j) *(f32x4*)(a.out + (size_t)prow * DM + 4 * (C.lane + 64 * j)) = po[j];
}

constexpr int GTAB_OFF = 131072;
__device__ __forceinline__ void phase_gemm_in(const Ctx& C) {
    const int Mg = MTOT;
    pg8::Gemm g{wsp<bf16>(C, WS_H), wsp<bf16>(C, WS_WINT), Mg, NINC, DM, 0, 0, 0}; pg8::StaticOrder S; S.init(Mg, NINC, C.G, (int)blockIdx.x);
    LAS float* tb = (LAS float*)(C.lds + GTAB_OFF);
    for (int i = C.tid; i < 2048; i += NTHR) { tb[i] = wsp<float>(C, WS_COS)[i]; tb[2048 + i] = wsp<float>(C, WS_SIN)[i]; }
    if (C.tid < 512) tb[4096 + C.tid] = wsp<float>(C, WS_LB)[C.tid];
    __syncthreads();
    EpiIn E{wsp<bf16>(C, WS_QP), wsp<bf16>(C, WS_QR), wsp<bf16>(C, WS_KR), wsp<bf16>(C, WS_V), wsp<bf16>(C, WS_QH), wsp<bf16>(C, WS_IH), wsp<bf16>(C, WS_GH),
            wsp<unsigned short>(C, WS_LFF), wsp<unsigned short>(C, WS_LFB), tb + 4096, tb, tb + 2048};
    const int nt_ = (Mg / 256) * (NINC / 256), rounds = (nt_ + C.G - 1) / C.G, lrt = nt_ - (rounds - 1) * C.G; const bool allc = lrt >= C.G;
    const bool conv = C.G > 32 && (allc || (int)blockIdx.x >= lrt); const int widx = allc ? (int)blockIdx.x : (int)blockIdx.x - lrt, nconv = allc ? C.G : C.G - lrt;
    if (conv && (widx & 1) == 0) { convert_f8(C, CV_P0_END, CV_D1_END, widx, nconv); __syncthreads(); }
    pg8::gemm_phase<EpiIn, pg8::StaticOrder, true, true>(C.lds, g, S, E);
    if (conv && (widx & 1) == 1) convert_f8(C, CV_P0_END, CV_D1_END, widx, nconv);
}
__device__ __forceinline__ void phase_gemm_out(const Ctx& C) {
    pg8::Gemm g{wsp<bf16>(C, WS_MIXIN), wsp<bf16>(C, WS_WOUTT), MROWS, DM, DM, 0, 0, 0}; pg8::StaticOrder S; S.init(MROWS, DM, C.G, (int)blockIdx.x);
    EpiBf E{wsp<bf16>(C, WS_MIX), DM};
    pg8::gemm_phase<EpiBf, pg8::StaticOrder, true, true>(C.lds, g, S, E);
}
static_assert(LDSCTL_BYTES + GTAB_OFF + 23 * 1024 <= LDS_BYTES, "gather table");
__device__ __forceinline__ void phase_gemm1(const Ctx& C) {
    pg8::StaticOrder S; S.init(MEXP, N1P, C.G, (int)blockIdx.x);
    {
        const int* IDX = wsp<int>(C, WS_IDX); LAS int* tab = (LAS int*)(C.lds + GTAB_OFF); pg8::Unit u;
        for (int i = 0; i < 23 && S.next(i, u); ++i)
            if (C.tid < 256) { const int e = u.pm >> 3, b = (u.pm >> 2) & 1; tab[i * 256 + C.tid] = b * SEQ + IDX[(b * 16 + e) * CAP + (u.pm & 3) * 256 + C.tid]; }
        __syncthreads();
    }
    pg8::Gemm g{wsp<bf16>(C, WS_H2), wsp<bf16>(C, WS_W1T), MEXP, N1P, DM / 2, 3, (size_t)N1P * DM, GTAB_OFF};
    EpiHid E{C.ws + WS_HID};
    pg8::gemm_phase<EpiHid, pg8::StaticOrder, true, true, true, true>(C.lds, g, S, E);
}
__device__ __forceinline__ void phase_gemm2(const Ctx& C) {
    pg8::Gemm g{wsp<bf16>(C, WS_HID), wsp<bf16>(C, WS_W2T), MEXP, DM, FEP / 2, 3, (size_t)DM * FEP, 0}; pg8::StaticOrder S; S.init(MEXP, DM, C.G, (int)blockIdx.x);
    LAS float* gtab = (LAS float*)(C.lds + GTAB_OFF);
    { const float* gate = wsp<float>(C, WS_GATEV); pg8::Unit u;
      for (int i = 0; i < 23 && S.next(i, u); ++i) if (C.tid < 256) gtab[i * 256 + C.tid] = gate[u.pm * 256 + C.tid] * (1.0f / (W2_SCALE * HID_SCALE));
      __syncthreads(); }
    EpiYs E{wsp<bf16>(C, WS_YS), gtab, 0};
    pg8::gemm_phase<EpiYs, pg8::StaticOrder, true, true, false, true>(C.lds, g, S, E);
}

__global__ void __launch_bounds__(NTHR, 2) fwd_kernel(Args args) {
    extern __shared__ __attribute__((aligned(16))) unsigned char lds_raw[];
    Ctx C; C.lds = (LAS unsigned char*)lds_raw + LDSCTL_BYTES; C.tid = threadIdx.x; C.lane = C.tid & 63; C.wave = __builtin_amdgcn_readfirstlane(C.tid >> 6); C.G = gridDim.x; C.a = args; C.ws = args.ws;
    if (C.tid < LDSCTL_BYTES / 4) ((LAS unsigned*)lds_raw)[C.tid] = 0u;
    __syncthreads();
    const bool multi = (args.ph_hi - args.ph_lo) > 1;
    XcdBarrier bar; bar.bar = (unsigned*)(C.ws + WS_CTL) + CW_BAR; bar.x = 0; bar.st = nullptr;
    if (multi) bar = xcd_barrier_post((unsigned*)(C.ws + WS_CTL) + CW_BAR, (volatile LAS unsigned*)((LAS unsigned char*)lds_raw) + 8);
    const int lo = args.ph_lo, hi = args.ph_hi;
#define IN(k) (lo <= (k) && (k) < hi)
#define SEAM(k) do { if ((k) + 1 < hi) xcd_barrier(bar); } while (0)
#if PH_ON(0)
    if (IN(0)) { for (int rep = 0; rep < 1 + REP_ON(0); ++rep) { phase_prologue(C); __syncthreads(); } SEAM(0); }
#endif
#if PH_ON(1)
    if (IN(1)) { for (int rep = 0; rep < 1 + REP_ON(1); ++rep) { phase_hrows(C); __syncthreads(); } SEAM(1); }
#endif
#if PH_ON(2)
    if (IN(2)) { for (int rep = 0; rep < 1 + REP_ON(2); ++rep) { phase_gemm_in(C); __syncthreads(); } SEAM(2); }
#endif
#if PH_ON(3)
    if (IN(3)) { for (int rep = 0; rep < 1 + REP_ON(3); ++rep) { phase_na(C); __syncthreads(); phase_hg_agg(C); __syncthreads(); } SEAM(3); }
#endif
#if PH_ON(4)
    if (IN(4)) { for (int rep = 0; rep < 1 + REP_ON(4); ++rep) { phase_hg_scan(C); __syncthreads(); } SEAM(4); }
#endif
#if PH_ON(5)
    if (IN(5)) { for (int rep = 0; rep < 1 + REP_ON(5); ++rep) { phase_hg_out(C); __syncthreads(); } SEAM(5); }
#endif
#if PH_ON(6)
    if (IN(6)) { for (int rep = 0; rep < 1 + REP_ON(6); ++rep) { phase_gemm_out(C); __syncthreads(); } SEAM(6); }
#endif
#if PH_ON(7)
    if (IN(7)) { for (int rep = 0; rep < 1 + REP_ON(7); ++rep) { phase_rowpass(C); __syncthreads(); } SEAM(7); }
#endif
#if PH_ON(8)
    if (IN(8)) { for (int rep = 0; rep < 1 + REP_ON(8); ++rep) { phase_topk(C); __syncthreads(); } SEAM(8); }
#endif
#if PH_ON(9)
    if (IN(9)) { for (int rep = 0; rep < 1 + REP_ON(9); ++rep) { phase_gemm1(C); __syncthreads(); } SEAM(9); }
#endif
#if PH_ON(10)
    if (IN(10)) { for (int rep = 0; rep < 1 + REP_ON(10); ++rep) { phase_gemm2(C); __syncthreads(); } SEAM(10); }
#endif
#if PH_ON(11)
    if (IN(11)) { for (int rep = 0; rep < 1 + REP_ON(11); ++rep) { phase_final(C); __syncthreads(); } SEAM(11); }
#endif
#undef IN
#undef SEAM
}

extern "C" void kernel_launch(void* const* d_in, const int* in_sizes, int n_in, void* d_out, int out_size, void* d_ws, size_t ws_size, hipStream_t stream) {
    static int grid = 0;
    if (grid == 0) {
        if (n_in != 19 || out_size != MROWS * DM || ws_size < WS_END) { fprintf(stderr, "kernel_launch: unexpected problem (n_in %d out %d ws %zu)\n", n_in, out_size, ws_size); grid = -1; return; }
        int dev = 0, cus = 0, per_cu = 0;
        if (hipGetDevice(&dev) != hipSuccess || hipDeviceGetAttribute(&cus, hipDeviceAttributeMultiprocessorCount, dev) != hipSuccess) { grid = -1; return; }
        if (hipFuncSetAttribute((const void*)fwd_kernel, hipFuncAttributeMaxDynamicSharedMemorySize, LDS_BYTES) != hipSuccess) { fprintf(stderr, "kernel_launch: hipFuncSetAttribute failed\n"); grid = -1; return; }
        if (hipOccupancyMaxActiveBlocksPerMultiprocessor(&per_cu, (const void*)fwd_kernel, NTHR, LDS_BYTES) != hipSuccess || per_cu < 1) { fprintf(stderr, "kernel_launch: occupancy query says %d\n", per_cu); }
        (void)hipGetLastError();
        grid = cus;
    }
    if (grid < 0) return;
    (void)hipMemsetAsync((char*)d_ws + WS_CTL, 0, CTL_ZERO_BYTES, stream);
    Args a{};
    for (int i = 0; i < 19; ++i) a.in[i] = (const float*)d_in[i];
    a.out = (float*)d_out; a.ws = (unsigned char*)d_ws;
#if MK_N_LAUNCHES == 1
    a.ph_lo = 0; a.ph_hi = NPHASE;
    hipLaunchKernelGGL(fwd_kernel, dim3(grid), dim3(NTHR), LDS_BYTES, stream, a);
#else
    for (int ph = 0; ph < NPHASE; ++ph) { a.ph_lo = ph; a.ph_hi = ph + 1; hipLaunchKernelGGL(fwd_kernel, dim3(grid), dim3(NTHR), LDS_BYTES, stream, a); }
#endif
}
```
